# Optimizing an MI355X kernel written in HIP

```python
import jax
import jax.numpy as jnp
from jax import lax
import numpy as np

D_MODEL = 2048
BATCH = 8
SEQ = 2048
DEPTH = 1

GRID_W = 64
HEAD_DIM = 64
NA_WIDTH = D_MODEL // 2
RW_WIDTH = D_MODEL - NA_WIDTH
NA_HEADS = NA_WIDTH // HEAD_DIM
RW_HEADS = RW_WIDTH // HEAD_DIM
NA_WIN_ROWS_MAX = 8
NA_WIN_COLS = 16
N_DIR = 2
DECAY_LORA = 64
ICLR_LORA = 64
GATE_LORA = 160
RW_PROJ = 3 * RW_WIDTH + N_DIR * (DECAY_LORA + ICLR_LORA) + GATE_LORA
IN_PROJ = 3 * NA_WIDTH + RW_PROJ
N_EXPERTS = 16
EC_CAPACITY = 2
EXPERT_FF = D_MODEL
RMS_EPS = 1e-6
LNX_EPS = 64e-5
L2_EPS = 1e-12

kernel_name = 'hybrid_natten_rwkv7_ec_moe_block'


def _rms_norm(x, g, eps):
    xf = x.astype(jnp.float32)
    y = xf * lax.rsqrt(jnp.mean(xf * xf, axis=-1, keepdims=True) + eps)
    return (y * g.astype(jnp.float32)).astype(x.dtype)


def _neighbourhood_attention(q, k, v, q_norm_g, k_norm_g, rpb):
    B, T, _ = q.shape
    R = T // GRID_W
    wr = min(NA_WIN_ROWS_MAX, R)

    def to_grid(t):
        return t.reshape(B, R, GRID_W, NA_HEADS, HEAD_DIM).transpose(0, 3, 1, 2, 4)

    qg = to_grid(_rms_norm(q.reshape(B, T, NA_HEADS, HEAD_DIM), q_norm_g, RMS_EPS))
    kg = to_grid(_rms_norm(k.reshape(B, T, NA_HEADS, HEAD_DIM), k_norm_g, RMS_EPS))
    vg = to_grid(v.reshape(B, T, NA_HEADS, HEAD_DIM))

    rows = jnp.arange(R)
    row_start = jnp.clip(rows - wr // 2, 0, R - wr)
    row_idx = row_start[:, None] + jnp.arange(wr)[None, :]
    cols = jnp.arange(GRID_W)
    col_start = jnp.clip(cols - NA_WIN_COLS // 2, 0, GRID_W - NA_WIN_COLS)
    col_in = (cols[None, :] >= col_start[:, None]) & (cols[None, :] < col_start[:, None] + NA_WIN_COLS)

    kb = kg[:, :, row_idx]
    vb = vg[:, :, row_idx]

    dr = row_idx - rows[:, None] + (NA_WIN_ROWS_MAX - 1)
    dc = jnp.clip(cols[None, :] - cols[:, None], -(NA_WIN_COLS - 1), NA_WIN_COLS - 1) + (NA_WIN_COLS - 1)
    bias = rpb[:, dr][..., dc]
    bias = bias.transpose(0, 1, 3, 2, 4).astype(jnp.float32)

    s = jnp.einsum('bhrqd,bhrpkd->bhrqpk', qg, kb, preferred_element_type=jnp.float32)
    s = s * (HEAD_DIM ** -0.5) + bias
    s = jnp.where(col_in[:, None, :], s, -jnp.inf)
    p = jax.nn.softmax(s.reshape(B, NA_HEADS, R, GRID_W, wr * GRID_W), axis=-1)
    p = p.reshape(s.shape).astype(vb.dtype)
    o = jnp.einsum('bhrqpk,bhrpkd->bhrqd', p, vb)
    return o.transpose(0, 2, 3, 1, 4).reshape(B, T, NA_WIDTH)


def _two_way(t_f, t_b):
    return jnp.stack([t_f, jnp.flip(t_b, axis=1)], axis=0).transpose(2, 0, 1, 3, 4)


def _wkv7_step(state, inp):
    r_t, w_t, k_t, v_t, nkk_t, kka_t = inp
    sa = jnp.einsum('zbhvk,zbhk->zbhv', state, nkk_t)
    state = state * w_t[..., None, :] + sa[..., :, None] * kka_t[..., None, :] + v_t[..., :, None] * k_t[..., None, :]
    out = jnp.einsum('zbhvk,zbhk->zbhv', state, r_t)
    return state, out


def _rwkv7_bidirectional(p, mu_prev, mu_next, w0, w2, a0, a2, g2, k_k, k_a, r_k, lnx_w, lnx_b):
    B, T, _ = p.shape
    out_dtype = p.dtype
    p = p.astype(jnp.float32)
    p_prev = jnp.pad(p[:, :-1], ((0, 0), (1, 0), (0, 0)))
    p_next = jnp.pad(p[:, 1:], ((0, 0), (0, 1), (0, 0)))
    p = p + mu_prev * (p_prev - p) + mu_next * (p_next - p)

    C = RW_WIDTH
    r = p[..., :C]
    k = p[..., C:2 * C]
    v = p[..., 2 * C:3 * C]
    o = 3 * C
    wd = p[..., o:o + N_DIR * DECAY_LORA].reshape(B, T, N_DIR, DECAY_LORA)
    o += N_DIR * DECAY_LORA
    ad = p[..., o:o + N_DIR * ICLR_LORA].reshape(B, T, N_DIR, ICLR_LORA)
    o += N_DIR * ICLR_LORA
    gd = p[..., o:o + GATE_LORA]

    w_raw = w0 + jnp.einsum('btzl,zlc->btzc', jnp.tanh(wd), w2)
    decay = jnp.exp(-jnp.exp(-jax.nn.softplus(-w_raw) - 0.5))
    a = jax.nn.sigmoid(a0 + jnp.einsum('btzl,zlc->btzc', ad, a2))
    g = jnp.einsum('btl,lc->btc', jax.nn.sigmoid(gd), g2)

    hs = (B, T, RW_HEADS, HEAD_DIM)
    hs2 = (B, T, N_DIR, RW_HEADS, HEAD_DIM)
    kk = (k * k_k).reshape(hs)
    kk = kk / jnp.maximum(jnp.sqrt(jnp.sum(kk * kk, axis=-1, keepdims=True)), L2_EPS)
    k_dir = (k[:, :, None, :] * (1.0 + (a - 1.0) * k_a)).reshape(hs2)
    kka = kk[:, :, None] * a.reshape(hs2)
    decay = decay.reshape(hs2)
    r_h = r.reshape(hs)
    v_h = v.reshape(hs)

    xs = (_two_way(r_h, r_h), _two_way(decay[:, :, 0], decay[:, :, 1]),
          _two_way(k_dir[:, :, 0], k_dir[:, :, 1]), _two_way(v_h, v_h),
          _two_way(-kk, -kk), _two_way(kka[:, :, 0], kka[:, :, 1]))
    state0 = jnp.zeros((N_DIR, B, RW_HEADS, HEAD_DIM, HEAD_DIM), jnp.float32)
    _, outs = lax.scan(_wkv7_step, state0, xs)
    wkv = (outs[:, 0] + jnp.flip(outs[:, 1], axis=0)).transpose(1, 0, 2, 3)

    mu = jnp.mean(wkv, axis=-1, keepdims=True)
    var = jnp.mean(jnp.square(wkv - mu), axis=-1, keepdims=True)
    ln = ((wkv - mu) * lax.rsqrt(var + LNX_EPS)).reshape(B, T, C) * lnx_w + lnx_b
    k_mean = jnp.mean(k_dir, axis=2)
    bonus = jnp.sum(r_h * k_mean * r_k, axis=-1, keepdims=True) * v_h
    y = (ln + bonus.reshape(B, T, C)) * g
    return y.astype(out_dtype)


def _expert_choice_ffn(h, w_router, w_gate, w_up, w_down):
    B, T, D = h.shape
    cap = EC_CAPACITY * T // N_EXPERTS
    aff = jax.nn.softmax(jnp.einsum('btd,de->bte', h, w_router, preferred_element_type=jnp.float32), axis=-1)
    gate, idx = lax.top_k(aff.transpose(0, 2, 1), cap)
    xe = jax.vmap(lambda hb, ib: hb[ib])(h, idx)
    hid = jax.nn.silu(jnp.einsum('becd,edf->becf', xe, w_gate)) * jnp.einsum('becd,edf->becf', xe, w_up)
    ye = jnp.einsum('becf,efd->becd', hid, w_down) * gate[..., None].astype(h.dtype)
    y = jax.vmap(lambda yb, ib: jnp.zeros((T, D), h.dtype).at[ib.reshape(-1)].add(yb.reshape(-1, D)))(ye, idx)
    return y


def _hybrid_layer(x, norm1_g, w_in, q_norm_g, k_norm_g, na_rpb, shift_mu_prev, shift_mu_next,
                  decay_w0, decay_w2, iclr_a0, iclr_a2, gate_g2, k_k, k_a, r_k, lnx_w, lnx_b,
                  w_out, norm2_g, w_router, w_gate, w_up, w_down):
    h = _rms_norm(x, norm1_g, RMS_EPS)
    proj = jnp.einsum('btd,dp->btp', h, w_in)
    na = _neighbourhood_attention(proj[..., :NA_WIDTH], proj[..., NA_WIDTH:2 * NA_WIDTH],
                                  proj[..., 2 * NA_WIDTH:3 * NA_WIDTH], q_norm_g, k_norm_g, na_rpb)
    rw = _rwkv7_bidirectional(proj[..., 3 * NA_WIDTH:], shift_mu_prev, shift_mu_next, decay_w0, decay_w2,
                              iclr_a0, iclr_a2, gate_g2, k_k, k_a, r_k, lnx_w, lnx_b)
    mix = jnp.concatenate([na, rw], axis=-1)
    x = x + jnp.einsum('btc,cd->btd', mix, w_out)
    h2 = _rms_norm(x, norm2_g, RMS_EPS)
    return x + _expert_choice_ffn(h2, w_router, w_gate, w_up, w_down)


def setup_inputs(seed: int = 0) -> dict:
    key = jax.random.key(seed)
    ks = jax.random.split(key, 24)
    f32 = jnp.float32
    L = DEPTH

    def nrm(k, shape, scale):
        return jax.random.normal(k, shape, f32) * scale

    def gain(k, shape):
        return 1.0 + 0.02 * jax.random.normal(k, shape, f32)

    return {
        'x': nrm(ks[0], (BATCH, SEQ, D_MODEL), 1.0),
        'norm1_g': gain(ks[1], (L, D_MODEL)),
        'w_in': nrm(ks[2], (L, D_MODEL, IN_PROJ), D_MODEL ** -0.5),
        'q_norm_g': gain(ks[3], (L, HEAD_DIM)),
        'k_norm_g': gain(ks[4], (L, HEAD_DIM)),
        'na_rpb': nrm(ks[5], (L, NA_HEADS, 2 * NA_WIN_ROWS_MAX - 1, 2 * NA_WIN_COLS - 1), 0.5),
        'shift_mu_prev': jax.random.uniform(ks[6], (L, RW_PROJ), f32, 0.0, 0.5),
        'shift_mu_next': jax.random.uniform(ks[7], (L, RW_PROJ), f32, 0.0, 0.5),
        'decay_w0': jax.random.uniform(ks[8], (L, N_DIR, RW_WIDTH), f32, -5.0, 1.0),
        'decay_w2': nrm(ks[9], (L, N_DIR, DECAY_LORA, RW_WIDTH), 0.5 * DECAY_LORA ** -0.5),
        'iclr_a0': nrm(ks[10], (L, N_DIR, RW_WIDTH), 0.5),
        'iclr_a2': nrm(ks[11], (L, N_DIR, ICLR_LORA, RW_WIDTH), 0.5 * ICLR_LORA ** -0.5),
        'gate_g2': nrm(ks[12], (L, GATE_LORA, RW_WIDTH), GATE_LORA ** -0.5),
        'k_k': 0.85 + 0.05 * jax.random.normal(ks[13], (L, RW_WIDTH), f32),
        'k_a': 1.0 + 0.05 * jax.random.normal(ks[14], (L, RW_WIDTH), f32),
        'r_k': nrm(ks[15], (L, RW_HEADS, HEAD_DIM), 0.1),
        'lnx_w': gain(ks[16], (L, RW_WIDTH)),
        'lnx_b': nrm(ks[17], (L, RW_WIDTH), 0.02),
        'w_out': nrm(ks[18], (L, D_MODEL, D_MODEL), D_MODEL ** -0.5),
        'norm2_g': gain(ks[19], (L, D_MODEL)),
        'w_router': nrm(ks[20], (L, D_MODEL, N_EXPERTS), D_MODEL ** -0.5),
        'w_gate': nrm(ks[21], (L, N_EXPERTS, D_MODEL, EXPERT_FF), D_MODEL ** -0.5),
        'w_up': nrm(ks[22], (L, N_EXPERTS, D_MODEL, EXPERT_FF), D_MODEL ** -0.5),
        'w_down': nrm(ks[23], (L, N_EXPERTS, EXPERT_FF, D_MODEL), EXPERT_FF ** -0.5),
    }


def reference(x, norm1_g, w_in, q_norm_g, k_norm_g, na_rpb, shift_mu_prev, shift_mu_next,
              decay_w0, decay_w2, iclr_a0, iclr_a2, gate_g2, k_k, k_a, r_k, lnx_w, lnx_b,
              w_out, norm2_g, w_router, w_gate, w_up, w_down):
    for l in range(DEPTH):
        x = _hybrid_layer(x, norm1_g[l], w_in[l], q_norm_g[l], k_norm_g[l], na_rpb[l],
                          shift_mu_prev[l], shift_mu_next[l], decay_w0[l], decay_w2[l],
                          iclr_a0[l], iclr_a2[l], gate_g2[l], k_k[l], k_a[l], r_k[l],
                          lnx_w[l], lnx_b[l], w_out[l], norm2_g[l], w_router[l],
                          w_gate[l], w_up[l], w_down[l])
    return x
```

```cpp
#include <hip/hip_runtime.h>
#include <hip/hip_cooperative_groups.h>
#include <cstdio>
#include <cstdint>
namespace cg = cooperative_groups;

namespace pg8 {
#define PG8_LAS __attribute__((address_space(3)))
typedef unsigned short bf16_t;
typedef short bf16x8 __attribute__((ext_vector_type(8)));
typedef float f32x4 __attribute__((ext_vector_type(4)));
typedef unsigned u32x4 __attribute__((ext_vector_type(4)));
constexpr int BM = 256, BK = 64, HALF = 128, HTB = HALF * BK * 2  , STAGE_BYTES = 8 * HTB, NXCD = 8, WGM = 8;

__host__ __device__ __forceinline__ int lds_byte(int r, int c) { const int st = (r >> 4) * 2 + (c >> 5), rr = r & 15, cc = c & 31, ob = rr * 64 + cc * 2; return st * 1024 + (ob ^ (((ob >> 9) & 1) << 5)); }
__host__ __device__ __forceinline__ void stage_rc(int b, int& R, int& C) { const int st = b / 1024, sb = b % 1024, swz = sb ^ (((sb >> 9) & 1) << 5); R = (st >> 1) * 16 + swz / 64; C = (st & 1) * 32 + (swz % 64) / 2; }
__host__ __device__ __forceinline__ int perm32(int rho) { const int n = rho >> 4, i = rho & 15; return 8 * (i >> 2) + 4 * n + (i & 3); }

struct Unit { int pm, pn; };
struct Gemm { const bf16_t* A; const bf16_t* Bt; int M, N, K; };

struct StaticOrder {
    int nM, nN, nwg, G, c;
    __host__ __device__ void init(int M, int N, int G_, int c_) { nM = M / BM; nN = N / BM; nwg = nM * nN; G = G_; c = c_; }
    __host__ __device__ bool next(int i, Unit& u) const {
        const long L = (long)i * G + c; if (L >= nwg) return false;
        int wgid = (int)L; { const int q = nwg / NXCD, r = nwg % NXCD, xcd = wgid % NXCD, off = wgid / NXCD; wgid = (xcd < r ? xcd * (q + 1) : r * (q + 1) + (xcd - r) * q) + off; }
        const int nig = WGM * nN, gid = wgid / nig, fm = gid * WGM, gsz = (nM - fm) < WGM ? (nM - fm) : WGM;
        u.pm = fm + ((wgid % nig) % gsz); u.pn = (wgid % nig) / gsz; return true;
    }
    __device__ __forceinline__ void a_ready(const Unit&) const {}
    __device__ __forceinline__ void done(const Unit&) const {}
};

__device__ __forceinline__ unsigned cvt_pk_bf16(float lo, float hi) { unsigned r; asm volatile("v_cvt_pk_bf16_f32 %0, %1, %2" : "=v"(r) : "v"(lo), "v"(hi)); return r; }

struct EpiStoreBf16 {
    static constexpr bool PERM = true, AFTER_DRAIN = false;
    bf16_t* O; int ldc;
    __device__ __forceinline__ void operator()(const f32x4 (&acc)[2][2][4][2], const Unit& u, int wr, int wc, int fr, int fq) const {
        const int row0 = u.pm * BM + wr * 64 + fr, col0 = u.pn * BM + wc * 32 + 8 * fq;
#pragma unroll
        for (int ai = 0; ai < 2; ++ai)
#pragma unroll
            for (int m = 0; m < 4; ++m) { bf16_t* rowp = O + (size_t)(row0 + ai * HALF + m * 16) * ldc + col0;
#pragma unroll
                for (int bj = 0; bj < 2; ++bj) { const f32x4 v0 = acc[ai][bj][m][0], v1 = acc[ai][bj][m][1];
                    u32x4 w; w.x = cvt_pk_bf16(v0[0], v0[1]); w.y = cvt_pk_bf16(v0[2], v0[3]); w.z = cvt_pk_bf16(v1[0], v1[1]); w.w = cvt_pk_bf16(v1[2], v1[3]);
                    *(u32x4*)(rowp + bj * HALF) = w; } }
    }
};
struct EpiResF32 {
    static constexpr bool PERM = false, AFTER_DRAIN = false;
    const float* base; float* out; int ldc;
    __device__ __forceinline__ void operator()(const f32x4 (&acc)[2][2][4][2], const Unit& u, int wr, int wc, int fr, int fq) const {
        const int row0 = u.pm * BM + wr * 64 + fr, col0 = u.pn * BM + wc * 32 + 4 * fq;
#pragma unroll
        for (int ai = 0; ai < 2; ++ai)
#pragma unroll
            for (int m = 0; m < 4; ++m) { const size_t off = (size_t)(row0 + ai * HALF + m * 16) * ldc + col0;
#pragma unroll
                for (int bj = 0; bj < 2; ++bj)
#pragma unroll
                    for (int n = 0; n < 2; ++n) { const f32x4 b = *(const f32x4*)(base + off + bj * HALF + n * 16); *(f32x4*)(out + off + bj * HALF + n * 16) = b + acc[ai][bj][m][n]; } }
    }
};
struct EpiResBf16 {
    static constexpr bool PERM = true, AFTER_DRAIN = false;
    const float* base; bf16_t* out; int ldc;
    __device__ __forceinline__ void operator()(const f32x4 (&acc)[2][2][4][2], const Unit& u, int wr, int wc, int fr, int fq) const {
        const int row0 = u.pm * BM + wr * 64 + fr, col0 = u.pn * BM + wc * 32 + 8 * fq;
#pragma unroll
        for (int ai = 0; ai < 2; ++ai)
#pragma unroll
            for (int m = 0; m < 4; ++m) { const size_t off = (size_t)(row0 + ai * HALF + m * 16) * ldc + col0;
#pragma unroll
                for (int bj = 0; bj < 2; ++bj) { const f32x4 v0 = __builtin_nontemporal_load((const f32x4*)(base + off + bj * HALF)) + acc[ai][bj][m][0], v1 = __builtin_nontemporal_load((const f32x4*)(base + off + bj * HALF + 4)) + acc[ai][bj][m][1];
                    u32x4 w; w.x = cvt_pk_bf16(v0[0], v0[1]); w.y = cvt_pk_bf16(v0[2], v0[3]); w.z = cvt_pk_bf16(v1[0], v1[1]); w.w = cvt_pk_bf16(v1[2], v1[3]);
                    *(u32x4*)(out + off + bj * HALF) = w; } }
    }
};
struct EpiSwiGLU {
    static constexpr bool PERM = true, AFTER_DRAIN = false;
    unsigned char* O;
    __device__ __forceinline__ void operator()(const f32x4 (&acc)[2][2][4][2], const Unit& u, int wr, int wc, int fr, int fq) const {
        const int row0 = u.pm * BM + wr * 64 + fr, col0 = (u.pn & 15) * HALF + wc * 32 + 8 * fq;
#pragma unroll
        for (int ai = 0; ai < 2; ++ai)
#pragma unroll
            for (int m = 0; m < 4; ++m) { unsigned char* rowp = O + (size_t)(row0 + ai * HALF + m * 16) * 2048 + col0;
                float h[8];
#pragma unroll
                for (int n = 0; n < 2; ++n)
#pragma unroll
                    for (int j = 0; j < 4; ++j) { const float gt = acc[ai][0][m][n][j], up = acc[ai][1][m][n][j];
                        h[n * 4 + j] = gt * __builtin_amdgcn_rcpf(1.0f + __expf(-gt)) * up; }
                int p0 = __builtin_amdgcn_cvt_pk_fp8_f32(h[0], h[1], 0, false); p0 = __builtin_amdgcn_cvt_pk_fp8_f32(h[2], h[3], p0, true);
                int p1 = __builtin_amdgcn_cvt_pk_fp8_f32(h[4], h[5], 0, false); p1 = __builtin_amdgcn_cvt_pk_fp8_f32(h[6], h[7], p1, true);
                typedef int i32x2 __attribute__((ext_vector_type(2))); *(i32x2*)rowp = (i32x2){p0, p1}; }
    }
};
struct EpiDownScale {
    static constexpr bool PERM = true, AFTER_DRAIN = false;
    bf16_t* O; const float* gate;
    __device__ __forceinline__ void operator()(const f32x4 (&acc)[2][2][4][2], const Unit& u, int wr, int wc, int fr, int fq) const {
        const int row0 = u.pm * BM + wr * 64 + fr, col0 = (u.pn & 7) * BM + wc * 32 + 8 * fq;
#pragma unroll
        for (int ai = 0; ai < 2; ++ai)
#pragma unroll
            for (int m = 0; m < 4; ++m) { const int row = row0 + ai * HALF + m * 16; const float gs = gate[row]; bf16_t* rowp = O + (size_t)row * 2048 + col0;
#pragma unroll
                for (int bj = 0; bj < 2; ++bj) { const f32x4 v0 = acc[ai][bj][m][0] * gs, v1 = acc[ai][bj][m][1] * gs;
                    u32x4 w; w.x = cvt_pk_bf16(v0[0], v0[1]); w.y = cvt_pk_bf16(v0[2], v0[3]); w.z = cvt_pk_bf16(v1[0], v1[1]); w.w = cvt_pk_bf16(v1[2], v1[3]);
                    *(u32x4*)(rowp + bj * HALF) = w; } }
    }
};
struct MoeOrder : StaticOrder {
    int nNl;
    __device__ void init2(int nNl_, int G_, int c_) { nNl = nNl_; init(32768, nNl_ * BM, G_, c_); }
    __device__ bool next(int i, Unit& u) const { if (!StaticOrder::next(i, u)) return false; u.pn += (u.pm >> 3) * nNl; return true; }
};

struct SplitOrder : StaticOrder {
    int full_rounds, xrounds, xlo, xhi;
    __device__ void init3(int M, int N, int G_, int c_, int fr_, int xr_, int xlo_, int xhi_) { init(M, N, G_, c_); full_rounds = fr_; xrounds = xr_; xlo = xlo_; xhi = xhi_; }
    __device__ bool next(int i, Unit& u) const {
        long L;
        if (i < full_rounds) L = (long)i * G + c;
        else { const int j = i - full_rounds; if (j >= xrounds || c < xlo || c >= xhi) return false; L = (long)full_rounds * G + (long)j * (xhi - xlo) + (c - xlo); }
        if (L >= nwg) return false;
        int wgid = (int)L; { const int q = nwg / NXCD, r = nwg % NXCD, xcd = wgid % NXCD, off = wgid / NXCD; wgid = (xcd < r ? xcd * (q + 1) : r * (q + 1) + (xcd - r) * q) + off; }
        const int nig = WGM * nN, gid = wgid / nig, fm = gid * WGM, gsz = (nM - fm) < WGM ? (nM - fm) : WGM;
        u.pm = fm + ((wgid % nig) % gsz); u.pn = (wgid % nig) / gsz; return true;
    }
};
template <class Epi, class Sched, bool ALIGN_EPI = false, bool SP2 = false, bool FP8 = false, int WSC = 0x7F7F7F7F>
__device__ __forceinline__ void gemm_phase(PG8_LAS unsigned char* lds, const Gemm g, const Sched& S, const Epi& E) {
    int tid_ = threadIdx.x; asm volatile("" : "+v"(tid_));
    const int tid = tid_, wid = __builtin_amdgcn_readfirstlane(tid >> 6), lane = tid & 63, wr = wid >> 2, wc = wid & 3, fr = lane & 15, fq = lane >> 4;
    const int K = g.K, nt = K / BK;
    unsigned voffA[2], voffB[2];
#pragma unroll
    for (int i = 0; i < 2; ++i) { int R, C; stage_rc(tid * 16 + i * 8192, R, C); const int Rb = Epi::PERM ? ((R & ~31) + perm32(R & 31)) : R;
        voffA[i] = (unsigned)(R * K + C) * 2u; voffB[i] = (unsigned)(Rb * K + C) * 2u; }
    const size_t kstep = (size_t)(BK * 2);
    const size_t hstep = (size_t)HALF * K * 2;
    const size_t tstep = 2 * hstep;
    const unsigned ldsw = (unsigned)wid * 1024u;
    const int aoff = lds_byte(wr * 64 + fr, fq * 8), boff = lds_byte(wc * 32 + fr, fq * 8);
typedef int pg8_v8i __attribute__((ext_vector_type(8))); typedef short pg8_s16 __attribute__((ext_vector_type(16)));
#define PG8_CAT(lo, hi) __builtin_bit_cast(pg8_v8i, __builtin_shufflevector(lo, hi, 0, 1, 2, 3, 4, 5, 6, 7, 8, 9, 10, 11, 12, 13, 14, 15))
#define PG8_SA(b, h) (((b) * 2 + (h)) * HTB)
#define PG8_SB(b, h) ((4 + (b) * 2 + (h)) * HTB)
#define PG8_STAGE(bufoff, gbase, voff) do { _Pragma("unroll") for (int _i = 0; _i < 2; ++_i) \
        __builtin_amdgcn_global_load_lds((const unsigned*)((const char*)(gbase) + (voff)[_i]), (PG8_LAS unsigned*)(lds + (bufoff) + ldsw + _i * 8192), 16, 0, 0); } while (0)
#define PG8_LDA(dst, b, h) do { if constexpr (FP8) { _Pragma("unroll") for (int m = 0; m < 4; ++m) { const bf16x8 lo_ = *(const PG8_LAS bf16x8*)(lds + PG8_SA(b, h) + aoff + m * 2048), hi_ = *(const PG8_LAS bf16x8*)(lds + PG8_SA(b, h) + aoff + m * 2048 + 1024); dst##8[m] = PG8_CAT(lo_, hi_); } } \
        else { _Pragma("unroll") for (int m = 0; m < 4; ++m) _Pragma("unroll") for (int k = 0; k < 2; ++k) dst[m][k] = *(const PG8_LAS bf16x8*)(lds + PG8_SA(b, h) + aoff + m * 2048 + k * 1024); } } while (0)
#define PG8_LDB(dst, b, h) do { if constexpr (FP8) { _Pragma("unroll") for (int n = 0; n < 2; ++n) { const bf16x8 lo_ = *(const PG8_LAS bf16x8*)(lds + PG8_SB(b, h) + boff + n * 2048), hi_ = *(const PG8_LAS bf16x8*)(lds + PG8_SB(b, h) + boff + n * 2048 + 1024); dst##8[n] = PG8_CAT(lo_, hi_); } } \
        else { _Pragma("unroll") for (int n = 0; n < 2; ++n) _Pragma("unroll") for (int k = 0; k < 2; ++k) dst[n][k] = *(const PG8_LAS bf16x8*)(lds + PG8_SB(b, h) + boff + n * 2048 + k * 1024); } } while (0)
#define PG8_MMA(ai, bj, At, Bt) do { __builtin_amdgcn_s_setprio(1); \
        if constexpr (FP8) { _Pragma("unroll") for (int m = 0; m < 4; ++m) _Pragma("unroll") for (int n = 0; n < 2; ++n) \
            asm volatile("v_mfma_scale_f32_16x16x128_f8f6f4 %0, %1, %2, %0, %3, %4 op_sel_hi:[0,0,0]" : "+v"(acc[ai][bj][m][n]) : "v"(Bt##8[n]), "v"(At##8[m]), "v"(fp8_wsc), "v"(fp8_one)); }     \
        else { _Pragma("unroll") for (int m = 0; m < 4; ++m) _Pragma("unroll") for (int n = 0; n < 2; ++n) _Pragma("unroll") for (int k = 0; k < 2; ++k) \
            acc[ai][bj][m][n] = __builtin_amdgcn_mfma_f32_16x16x32_bf16(Bt[n][k], At[m][k], acc[ai][bj][m][n], 0, 0, 0); } \
        __builtin_amdgcn_s_setprio(0); } while (0)
#define PG8_WAIT_V(n) asm volatile("s_waitcnt vmcnt(" #n ")" ::: "memory")
#define PG8_WAIT_L(n) asm volatile("s_waitcnt lgkmcnt(" #n ")" ::: "memory")
#define PG8_BAR __builtin_amdgcn_s_barrier()
#define PG8_SCHED __builtin_amdgcn_sched_barrier(0)
    Unit cur, nxt; int ui = 0;
    if (!S.next(0, cur)) return;
    f32x4 acc[2][2][4][2];
#pragma unroll
    for (int a = 0; a < 2; ++a)
#pragma unroll
        for (int b = 0; b < 2; ++b)
#pragma unroll
            for (int m = 0; m < 4; ++m)
#pragma unroll
                for (int n = 0; n < 2; ++n) acc[a][b][m][n] = (f32x4){0.f, 0.f, 0.f, 0.f};
    int fp8_wsc = WSC, fp8_one = 0x7F7F7F7F; if constexpr (FP8) asm volatile("" : "+v"(fp8_wsc), "+v"(fp8_one));
    bf16x8 At[4][2], B0[2][2], B1[2][2]; pg8_v8i At8[4], B08[2], B18[2];
    const char* cA = (const char*)g.A + (size_t)cur.pm * tstep; const char* cB = (const char*)g.Bt + (size_t)cur.pn * tstep;
    S.a_ready(cur);
    if constexpr (SP2) {
        PG8_STAGE(PG8_SB(0, 0), cB, voffB); PG8_STAGE(PG8_SB(0, 1), cB + hstep, voffB); PG8_STAGE(PG8_SA(0, 0), cA, voffA); PG8_STAGE(PG8_SA(0, 1), cA + hstep, voffA);
        if (wr == 1) PG8_BAR;
        PG8_WAIT_V(2); PG8_BAR;
        PG8_STAGE(PG8_SB(1, 0), cB + kstep, voffB); PG8_STAGE(PG8_SA(1, 0), cA + kstep, voffA); PG8_STAGE(PG8_SB(1, 1), cB + hstep + kstep, voffB);
        PG8_WAIT_V(6); PG8_BAR;
    } else {
        PG8_STAGE(PG8_SB(0, 0), cB, voffB); PG8_STAGE(PG8_SA(0, 0), cA, voffA); PG8_STAGE(PG8_SB(0, 1), cB + hstep, voffB); PG8_STAGE(PG8_SA(0, 1), cA + hstep, voffA);
        if (wr == 1) PG8_BAR;
        PG8_WAIT_V(4); PG8_BAR;
        PG8_STAGE(PG8_SB(1, 0), cB + kstep, voffB); PG8_STAGE(PG8_SA(1, 0), cA + kstep, voffA); PG8_STAGE(PG8_SB(1, 1), cB + hstep + kstep, voffB);
        PG8_WAIT_V(6); PG8_BAR;
    }
    for (;;) {
        const bool has_next = S.next(ui + 1, nxt);
        const char* nA = has_next ? (const char*)g.A + (size_t)nxt.pm * tstep : cA; const char* nB = has_next ? (const char*)g.Bt + (size_t)nxt.pn * tstep : cB;
        for (int t = 0; t < nt; t += 2) {
            const bool last = (t == nt - 2);
            const char* a1 = cA + (size_t)(t + 1) * kstep;
            const char* a2 = last ? nA : cA + (size_t)(t + 2) * kstep; const char* b2 = last ? nB : cB + (size_t)(t + 2) * kstep;
            const char* a3 = a2 + kstep; const char* b3 = b2 + kstep;
            if (last && has_next) S.a_ready(nxt);
            if constexpr (SP2) {
            PG8_LDB(B0, 0, 0); PG8_LDB(B1, 0, 1); PG8_SCHED; PG8_LDA(At, 0, 0); PG8_STAGE(PG8_SA(1, 1), a1 + hstep, voffA);
            PG8_WAIT_V(8); PG8_WAIT_L(0); PG8_BAR; PG8_MMA(0, 0, At, B0); PG8_MMA(0, 1, At, B1); PG8_BAR; PG8_SCHED;
            PG8_LDA(At, 0, 1); PG8_STAGE(PG8_SB(0, 0), b2, voffB); PG8_STAGE(PG8_SB(0, 1), b2 + hstep, voffB); PG8_STAGE(PG8_SA(0, 0), a2, voffA);
            PG8_WAIT_V(8); PG8_WAIT_L(0); PG8_BAR; PG8_MMA(1, 0, At, B0); PG8_MMA(1, 1, At, B1); PG8_BAR; PG8_SCHED;
            PG8_LDB(B0, 1, 0); PG8_LDB(B1, 1, 1); PG8_SCHED; PG8_LDA(At, 1, 0); PG8_STAGE(PG8_SA(0, 1), a2 + hstep, voffA);
            PG8_WAIT_V(8); PG8_WAIT_L(0); PG8_BAR; PG8_MMA(0, 0, At, B0); PG8_MMA(0, 1, At, B1); PG8_BAR; PG8_SCHED;
            PG8_LDA(At, 1, 1); PG8_STAGE(PG8_SB(1, 0), b3, voffB); PG8_STAGE(PG8_SB(1, 1), b3 + hstep, voffB); PG8_STAGE(PG8_SA(1, 0), a3, voffA);
            PG8_WAIT_V(8); PG8_WAIT_L(0); PG8_BAR; PG8_MMA(1, 0, At, B0); PG8_MMA(1, 1, At, B1); PG8_BAR; PG8_SCHED;
            } else {
            PG8_LDB(B0, 0, 0); PG8_SCHED; PG8_LDA(At, 0, 0); PG8_STAGE(PG8_SA(1, 1), a1 + hstep, voffA);
            PG8_WAIT_L(8); PG8_BAR; PG8_WAIT_L(0); PG8_MMA(0, 0, At, B0); PG8_BAR; PG8_SCHED;
            PG8_LDB(B1, 0, 1); PG8_STAGE(PG8_SB(0, 0), b2, voffB);
            PG8_BAR; PG8_WAIT_L(0); PG8_MMA(0, 1, At, B1); PG8_BAR;
            PG8_LDA(At, 0, 1); PG8_STAGE(PG8_SA(0, 0), a2, voffA);
            PG8_BAR; PG8_WAIT_L(0); PG8_MMA(1, 0, At, B0); PG8_BAR; PG8_SCHED;
            PG8_STAGE(PG8_SB(0, 1), b2 + hstep, voffB);
            PG8_WAIT_V(6); PG8_BAR; PG8_MMA(1, 1, At, B1); PG8_BAR;
            PG8_LDB(B0, 1, 0); PG8_SCHED; PG8_LDA(At, 1, 0); PG8_STAGE(PG8_SA(0, 1), a2 + hstep, voffA);
            PG8_WAIT_L(8); PG8_BAR; PG8_WAIT_L(0); PG8_MMA(0, 0, At, B0); PG8_BAR; PG8_SCHED;
            PG8_LDB(B1, 1, 1); PG8_STAGE(PG8_SB(1, 0), b3, voffB);
            PG8_BAR; PG8_WAIT_L(0); PG8_MMA(0, 1, At, B1); PG8_BAR;
            PG8_LDA(At, 1, 1); PG8_STAGE(PG8_SA(1, 0), a3, voffA);
            PG8_BAR; PG8_WAIT_L(0); PG8_MMA(1, 0, At, B0); PG8_BAR; PG8_SCHED;
            PG8_STAGE(PG8_SB(1, 1), b3 + hstep, voffB);
            PG8_WAIT_V(6); PG8_BAR; PG8_MMA(1, 1, At, B1); PG8_BAR;
            }
        }
        if constexpr (ALIGN_EPI) { if (wr == 0) PG8_BAR; }
        if constexpr (FP8) asm volatile("s_nop 15\n\ts_nop 15" ::: "memory");
        if constexpr (!Epi::AFTER_DRAIN) { E(acc, cur, wr, wc, fr, fq); S.done(cur); }
        if (!has_next) break;
#pragma unroll
        for (int a = 0; a < 2; ++a)
#pragma unroll
            for (int b = 0; b < 2; ++b)
#pragma unroll
                for (int m = 0; m < 4; ++m)
#pragma unroll
                    for (int n = 0; n < 2; ++n) acc[a][b][m][n] = (f32x4){0.f, 0.f, 0.f, 0.f};
        cur = nxt; cA = nA; cB = nB; ++ui;
        if constexpr (ALIGN_EPI) { if (wr == 1) PG8_BAR; }
    }
    PG8_WAIT_V(0);
    if constexpr (!ALIGN_EPI) { if (wr == 0) PG8_BAR; }
    PG8_BAR;
    if constexpr (Epi::AFTER_DRAIN) { E.fused(acc, cur, wr, wc, fr, fq, lds, wid, lane); S.done(cur); }
#undef PG8_SA
#undef PG8_SB
#undef PG8_STAGE
#undef PG8_LDA
#undef PG8_LDB
#undef PG8_MMA
#undef PG8_CAT
#undef PG8_WAIT_V
#undef PG8_WAIT_L
#undef PG8_BAR
#undef PG8_SCHED
}
}
constexpr int DM = 2048, NB = 8, SEQ = 2048, MTOK = NB * SEQ;
constexpr int HD = 64, NAW = 1024, RWW = 1024, NHEAD = 16;
constexpr int RWP = 3488, INP = 6560, LDP = 6656;
constexpr int NE = 16, CAP = 256, FF = 2048, MEXP = NE * NB * CAP;
constexpr int GLORA = 160;
constexpr int PC_Q = 0, PC_K = 1024, PC_V = 2048, PC_RW = 3072;

constexpr size_t MiB = 1u << 20;
constexpr size_t WS_CTL = 0, CTL_ZERO_BYTES = 1 * MiB;
constexpr size_t WS_WIN = 2 * MiB;
constexpr size_t WS_WOUT = 28 * MiB;
constexpr size_t WS_G2T = 36 * MiB;
constexpr size_t WS_WGU = 38 * MiB;
constexpr size_t WS_WD = 294 * MiB;
constexpr size_t WS_H = 422 * MiB;
constexpr size_t WS_PROJ = 486 * MiB;
constexpr size_t WS_MIX = 694 * MiB;
constexpr size_t WS_WKV = 758 * MiB;
constexpr size_t WS_SB = 886 * MiB;
constexpr size_t WS_AFF = 888 * MiB;
constexpr size_t WS_GATE = 889 * MiB;
constexpr size_t WS_TOKSLOT = 890 * MiB;
constexpr size_t WS_WINQ = 892 * MiB;
constexpr size_t WS_HQ = 898 * MiB;
constexpr size_t WS_X2 = 930 * MiB;
constexpr size_t WS_END = 994 * MiB;
constexpr size_t WS_XE = WS_PROJ;
constexpr size_t WS_HID = 614 * MiB;
static_assert(WS_HID + 128 * MiB <= WS_WKV && WS_XE + 128 * MiB <= WS_HID, "overlay map");

constexpr int NWAVES = 8, NTHR = 512;
constexpr int LDS_BYTES = 163840;

#define LAS __attribute__((address_space(3)))
#define GAS __attribute__((address_space(1)))
typedef unsigned short bf16;
typedef float f32x4 __attribute__((ext_vector_type(4)));
typedef float f32x2 __attribute__((ext_vector_type(2)));
typedef short bf16x8 __attribute__((ext_vector_type(8)));
typedef short s16x4 __attribute__((ext_vector_type(4)));
typedef unsigned u32x4 __attribute__((ext_vector_type(4)));
typedef unsigned u32x2 __attribute__((ext_vector_type(2)));
#define LDS_WAIT() asm volatile("s_waitcnt lgkmcnt(0)" ::: "memory")

__device__ __forceinline__ unsigned f2bf(float f) { unsigned u = __builtin_bit_cast(unsigned, f); return (u + 0x7fffu + ((u >> 16) & 1u)) >> 16; }
typedef __bf16 bf16x2_t __attribute__((ext_vector_type(2)));
__device__ __forceinline__ unsigned pk2(float lo, float hi) { const f32x2 v = {lo, hi}; const bf16x2_t b = __builtin_convertvector(v, bf16x2_t); return __builtin_bit_cast(unsigned, b); }
__device__ __forceinline__ float bflo(unsigned u) { return __builtin_bit_cast(float, u << 16); }
__device__ __forceinline__ float bfhi(unsigned u) { return __builtin_bit_cast(float, u & 0xffff0000u); }
__device__ __forceinline__ float bf2f(unsigned short b) { return __builtin_bit_cast(float, (unsigned)b << 16); }
__device__ __forceinline__ void unpack8(const u32x4 v, float* f) { f[0] = bflo(v.x); f[1] = bfhi(v.x); f[2] = bflo(v.y); f[3] = bfhi(v.y); f[4] = bflo(v.z); f[5] = bfhi(v.z); f[6] = bflo(v.w); f[7] = bfhi(v.w); }
__device__ __forceinline__ void unpack8v(const u32x4 v, f32x2* f) { f[0] = (f32x2){bflo(v.x), bfhi(v.x)}; f[1] = (f32x2){bflo(v.y), bfhi(v.y)}; f[2] = (f32x2){bflo(v.z), bfhi(v.z)}; f[3] = (f32x2){bflo(v.w), bfhi(v.w)}; }
__device__ __forceinline__ float sigmoidf_(float x) { return __builtin_amdgcn_rcpf(1.0f + __expf(-x)); }
template <int CTRL> __device__ __forceinline__ float dppf(float x) { return __builtin_bit_cast(float, __builtin_amdgcn_update_dpp(0, __builtin_bit_cast(int, x), CTRL, 0xF, 0xF, true)); }
__device__ __forceinline__ float red8(float x) { x += dppf<0xB1>(x); x += dppf<0x4E>(x); x += dppf<0x141>(x); return x; }
__device__ __forceinline__ float wave_sum(float v) {
#pragma unroll
    for (int o = 1; o < 64; o <<= 1) v += __shfl_xor(v, o);
    return v;
}

template <class T> __device__ __forceinline__ T* gptr(T* p) {
#if defined(__HIP_DEVICE_COMPILE__)
    __builtin_assume(!__builtin_amdgcn_is_shared((const void*)p)); __builtin_assume(!__builtin_amdgcn_is_private((const void*)p));
#endif
    return p; }
struct Args {
    const float* in[24]; float* out; unsigned char* ws;
};

struct Frame {
    unsigned char* lds;
    int tid, lane, wave, G, c;
    const float* const* in;
    float* out; __attribute__((address_space(1))) unsigned char* ws;
};

__device__ __forceinline__ void p0_transpose_item(const float* W, int ldw, int k0, int n0, bf16* outp, int ldo, LAS float* scr, int lane) {
#pragma unroll
    for (int i = 0; i < 32; ++i) { const int kk = 2 * i + (lane >> 5); scr[kk * 33 + (lane & 31)] = __builtin_nontemporal_load(&W[(size_t)(k0 + kk) * ldw + n0 + (lane & 31)]); }
    LDS_WAIT(); asm volatile("" ::: "memory");
    const int c = lane & 7;
#pragma unroll
    for (int j = 0; j < 4; ++j) { const int n = (lane >> 3) + 8 * j; const LAS float* s = scr + (8 * c) * 33 + n;
        u32x4 o; o.x = pk2(s[0 * 33], s[1 * 33]); o.y = pk2(s[2 * 33], s[3 * 33]); o.z = pk2(s[4 * 33], s[5 * 33]); o.w = pk2(s[6 * 33], s[7 * 33]);
        *(u32x4*)(outp + (size_t)n * ldo + 8 * c) = o; }
    LDS_WAIT(); asm volatile("" ::: "memory");
}
__device__ __forceinline__ void p0_transpose_item_fp8(const float* W, int ldw, int k0, int n0, unsigned char* outp, int ldo, LAS float* scr, int lane) {
#pragma unroll 32
    for (int i = 0; i < 64; ++i) { const int kk = 2 * i + (lane >> 5); scr[kk * 33 + (lane & 31)] = __builtin_nontemporal_load(&W[(size_t)(k0 + kk) * ldw + n0 + (lane & 31)]); }
    LDS_WAIT(); asm volatile("" ::: "memory");
    const int c = lane & 7;
#pragma unroll
    for (int j = 0; j < 4; ++j) { const int n = (lane >> 3) + 8 * j; const LAS float* s = scr + (16 * c) * 33 + n; int o[4];
#pragma unroll
        for (int q = 0; q < 4; ++q) { int pw = __builtin_amdgcn_cvt_pk_fp8_f32(s[(4 * q) * 33] * 32.0f, s[(4 * q + 1) * 33] * 32.0f, 0, false); o[q] = __builtin_amdgcn_cvt_pk_fp8_f32(s[(4 * q + 2) * 33] * 32.0f, s[(4 * q + 3) * 33] * 32.0f, pw, true); }
        __builtin_nontemporal_store((u32x4){(unsigned)o[0], (unsigned)o[1], (unsigned)o[2], (unsigned)o[3]}, (u32x4*)(outp + (size_t)n * ldo + 16 * c)); }
    LDS_WAIT(); asm volatile("" ::: "memory");
}
__device__ __forceinline__ void rms_row_to_bf16(const float* xrow, const float* g, bf16* orow, unsigned char* qrow, int lane) {
    const f32x4* xr = (const f32x4*)xrow + lane; const f32x4* gr = (const f32x4*)g + lane;
    f32x4 v[8]; float s = 0.f;
#pragma unroll
    for (int j = 0; j < 8; ++j) { v[j] = __builtin_nontemporal_load(&xr[64 * j]); s += (v[j].x * v[j].x + v[j].y * v[j].y) + (v[j].z * v[j].z + v[j].w * v[j].w); }
    const float rstd = 1.0f / sqrtf(wave_sum(s) * (1.0f / DM) + 1e-6f);
    u32x2* o8 = (u32x2*)orow + lane; unsigned* o4 = (unsigned*)qrow + lane;
#pragma unroll
    for (int j = 0; j < 8; ++j) { const f32x4 hv = v[j] * rstd * gr[64 * j]; u32x2 w; w.x = pk2(hv.x, hv.y); w.y = pk2(hv.z, hv.w); o8[64 * j] = w;
        int pw = __builtin_amdgcn_cvt_pk_fp8_f32(hv.x, hv.y, 0, false); pw = __builtin_amdgcn_cvt_pk_fp8_f32(hv.z, hv.w, pw, true); o4[64 * j] = (unsigned)pw; }
}
__device__ __forceinline__ void p0_prologue(const Frame& F, LAS unsigned char* lds) {
    LAS float* scr = (LAS float*)(lds + F.wave * 17408);
    const int gw = F.c * NWAVES + F.wave, NGW = F.G * NWAVES;
    const float* w_in = gptr(F.in[2]); const float* w_out = gptr(F.in[18]); const float* w_gate = gptr(F.in[21]); const float* w_up = gptr(F.in[22]); const float* w_down = gptr(F.in[23]);
    bf16* WIN = (bf16*)(F.ws + WS_WIN); bf16* WOUT = (bf16*)(F.ws + WS_WOUT); unsigned char* WGU = (unsigned char*)(F.ws + WS_WGU); unsigned char* WD = (unsigned char*)(F.ws + WS_WD);
    constexpr int I_IN = 32 * 109, I_OUT = 32 * 64;
    constexpr int NITEMS = I_IN + I_OUT;
    for (int it = gw; it < NITEMS; it += NGW) {
        int r = it;
        if (r < I_IN) { const int kb = r / 109, nb = 96 + r % 109; p0_transpose_item(w_in, INP, 64 * kb, 32 * nb, WIN + (size_t)(32 * nb) * DM + 64 * kb, DM, scr, F.lane); continue; } r -= I_IN;
        { const int kb = r / 64, nb = r % 64; p0_transpose_item(w_out, DM, 64 * kb, 32 * nb, WOUT + (size_t)(32 * nb) * DM + 64 * kb, DM, scr, F.lane); }
    }
    { unsigned char* WINQ = (unsigned char*)(F.ws + WS_WINQ); for (int it = gw; it < 16 * 96; it += NGW) { const int kb = it / 96, nb = it % 96; p0_transpose_item_fp8(w_in, INP, 128 * kb, 32 * nb, WINQ + (size_t)(32 * nb) * DM + 128 * kb, DM, scr, F.lane); } }
    for (int it = gw; it < 48 * 1024; it += NGW) { const int mat = it >> 10, e = mat / 3, which = mat - 3 * e, r = it & 1023, kb = r >> 6, nb = r & 63, n0 = 32 * nb;
        if (which == 2) p0_transpose_item_fp8(w_down + (size_t)e * FF * DM, DM, 128 * kb, n0, WD + ((size_t)e * DM + n0) * FF + 128 * kb, FF, scr, F.lane);
        else { const float* W = (which == 0 ? w_gate : w_up) + (size_t)e * DM * FF; const int orow = (n0 >> 7) * 256 + which * 128 + (n0 & 127);
            p0_transpose_item_fp8(W, FF, 128 * kb, n0, WGU + ((size_t)e * 4096 + orow) * DM + 128 * kb, DM, scr, F.lane); } }
    { u32x4* z = (u32x4*)(WIN + (size_t)INP * DM); const int n16 = 96 * DM * 2 / 16; for (int i = F.c * NTHR + F.tid; i < n16; i += F.G * NTHR) z[i] = (u32x4){0u, 0u, 0u, 0u}; }
    { const float* g2 = gptr(F.in[12]); bf16* G2T = (bf16*)(F.ws + WS_G2T); for (int i = F.c * NTHR + F.tid; i < GLORA * RWW; i += F.G * NTHR) { const int n = i / GLORA, k = i % GLORA; G2T[i] = (bf16)f2bf(g2[(size_t)k * RWW + n]); } }
    { const float* x = gptr(F.in[0]); const float* g = gptr(F.in[1]); bf16* H = (bf16*)(F.ws + WS_H); unsigned char* HQ = (unsigned char*)(F.ws + WS_HQ); for (int m = gw; m < MTOK; m += NGW) rms_row_to_bf16(x + (size_t)m * DM, g, H + (size_t)m * DM, HQ + (size_t)m * DM, F.lane); }
}
#define XB_TMO      128
#define XB_XCNT(j)  (256  + 64 * (j))
#define XB_XSUB(j)  (1280 + 64 * (j))
#define XB_XGEN(j)  (2304 + 64 * (j))
#define XB_TOP      3328
#define XB_TOPGEN   3392
#define XCD_BAR_WORDS 3456
#define XB_SPIN_CAP (1u << 18)

__device__ __forceinline__ unsigned xb_ld(unsigned* p)              { return __hip_atomic_load(p, __ATOMIC_RELAXED, __HIP_MEMORY_SCOPE_AGENT); }
__device__ __forceinline__ unsigned xb_add(unsigned* p, unsigned v) { return __hip_atomic_fetch_add(p, v, __ATOMIC_RELAXED, __HIP_MEMORY_SCOPE_AGENT); }
__device__ __forceinline__ unsigned xb_xcc_id() { return (unsigned)__builtin_amdgcn_s_getreg((3 << 11) | 20) & 0xFu; }
#define XB_SPIN(cond, bar) do { unsigned _sp = 0; while (cond) { __builtin_amdgcn_s_sleep(1); \
    if ((++_sp & 255u) == 0u) { if (xb_ld(&(bar)[XB_TMO])) break; if (_sp > XB_SPIN_CAP) { atomicAdd(&(bar)[XB_TMO], 1u); break; } } } } while (0)

struct XcdBarrier {
    unsigned* bar; unsigned x;
    volatile LAS unsigned* st;
};

__device__ __forceinline__ XcdBarrier xcd_barrier_post(unsigned* bar, volatile LAS unsigned* st) {
    XcdBarrier b; b.bar = bar; b.x = xb_xcc_id(); b.st = st;
    if (threadIdx.x == 0) (void)xb_add(&bar[XB_XCNT(b.x)], 1u);
    return b;
}
__device__ __forceinline__ void xcd_barrier_complete(unsigned* bar, unsigned x, unsigned& nloc, unsigned& nx) {
    const unsigned G = gridDim.x * gridDim.y * gridDim.z;
    unsigned sum, cnt, mine, sp = 0u;
    for (;;) {
        sum = 0u; cnt = 0u; mine = 0u;
#pragma unroll
        for (unsigned j = 0; j < 16; ++j) { const unsigned c = xb_ld(&bar[XB_XCNT(j)]); sum += c; cnt += (c > 0u) ? 1u : 0u; mine = (j == x) ? c : mine; }
        if (sum == G) break;
        __builtin_amdgcn_s_sleep(1);
        if ((++sp & 255u) == 0u) { if (xb_ld(&bar[XB_TMO])) break; if (sp > XB_SPIN_CAP) { atomicAdd(&bar[XB_TMO], 1u); break; } }
    }
    nloc = mine > 0u ? mine : 1u; nx = cnt > 0u ? cnt : 1u;
}

__device__ __forceinline__ void xcd_barrier(const XcdBarrier& b) {
    asm volatile("s_waitcnt vmcnt(0)" ::: "memory");
    __syncthreads();
    if (threadIdx.x == 0) {
        unsigned* bar = b.bar;
        __builtin_amdgcn_s_waitcnt(0);
        unsigned nloc = b.st[0], nx = b.st[1];
        if (nloc == 0u) { xcd_barrier_complete(bar, b.x, nloc, nx); b.st[0] = nloc; b.st[1] = nx; }
        const unsigned old = xb_add(&bar[XB_XSUB(b.x)], 1u);
        const unsigned gen = old / nloc;
        if (old + 1u == (gen + 1u) * nloc) {
            __builtin_amdgcn_fence(__ATOMIC_RELEASE, "agent");
            asm volatile("s_waitcnt vmcnt(0)" ::: "memory");
            const unsigned og = xb_add(&bar[XB_TOP], 1u);
            const unsigned tg = og / nx;
            if (og + 1u == (tg + 1u) * nx) xb_add(&bar[XB_TOPGEN], 1u);
            else XB_SPIN(xb_ld(&bar[XB_TOPGEN]) == tg, bar);
            __builtin_amdgcn_fence(__ATOMIC_ACQUIRE, "agent");
            xb_add(&bar[XB_XGEN(b.x)], 1u);
            asm volatile("s_waitcnt vmcnt(0)" ::: "memory");
        } else {
            XB_SPIN(xb_ld(&bar[XB_XGEN(b.x)]) == gen, bar);
            __builtin_amdgcn_fence(__ATOMIC_ACQUIRE, "agent");
            asm volatile("s_waitcnt vmcnt(0)" ::: "memory");
        }
    }
    __syncthreads();
}

constexpr int NA_VSTR = 160;
constexpr int NA_OFF_V = 0, NA_OFF_RK = 512 * NA_VSTR, NA_OFF_BIAS = NA_OFF_RK + 2048, NA_OFF_ML = NA_OFF_BIAS + 1920, NA_OFF_O = NA_OFF_ML + 1024, NA_END = NA_OFF_O + 16384;
typedef short v4i16_t __attribute__((ext_vector_type(4)));
__device__ __forceinline__ s16x4 tr_read(LAS unsigned char* p) { return __builtin_bit_cast(s16x4, __builtin_amdgcn_ds_read_tr16_b64_v4i16((LAS v4i16_t*)p)); }
__device__ __forceinline__ f32x4 mfma16(bf16x8 a, bf16x8 b, f32x4 c) { return __builtin_amdgcn_mfma_f32_16x16x32_bf16(a, b, c, 0, 0, 0); }

constexpr int NA2_SLOT = 64 * NA_VSTR;
constexpr int NA2_V = 0, NA2_RK = 9 * NA2_SLOT, NA2_BIAS = NA2_RK + 9 * 256, NA2_MRG = NA2_BIAS + 1920, NA2_END = NA2_MRG + 4 * 64 * 18 * 4;
static_assert(NA2_END <= LDS_BYTES - 16, "NA LDS map");
__device__ __forceinline__ void na_phase(const Frame& F, LAS unsigned char* lds) {
    const bf16* PROJ = (const bf16*)(F.ws + WS_PROJ); bf16* MIX = (bf16*)(F.ws + WS_MIX);
    const float* qg = gptr(F.in[3]); const float* kg = gptr(F.in[4]); const float* rpb = gptr(F.in[5]);
    LAS float* BI = (LAS float*)(lds + NA2_BIAS); LAS float* MRG = (LAS float*)(lds + NA2_MRG);
    const int tid = F.tid, lane = F.lane, w = F.wave, c16 = lane & 15, g = lane >> 4, qb = w & 3, kh = w >> 2;
    constexpr float LOG2E = 1.442695041f;
    f32x2 gg[8];
#pragma unroll
    for (int j = 0; j < 4; ++j) { gg[j] = (f32x2){qg[8 * g + 2 * j] * kg[8 * g + 2 * j], qg[8 * g + 2 * j + 1] * kg[8 * g + 2 * j + 1]} * (0.125f * LOG2E);
        gg[4 + j] = (f32x2){qg[32 + 8 * g + 2 * j] * kg[32 + 8 * g + 2 * j], qg[32 + 8 * g + 2 * j + 1] * kg[32 + 8 * g + 2 * j + 1]} * (0.125f * LOG2E); }
    const int cw0 = (qb == 0) ? 0 : (qb == 1) ? 8 : (qb == 2) ? 24 : 32;
    const int qcol = 16 * qb + c16; const int cs = (qcol - 8) < 0 ? 0 : ((qcol - 8) > 48 ? 48 : (qcol - 8));
    int dcv[2][4];
#pragma unroll
    for (int cb = 0; cb < 2; ++cb)
#pragma unroll
        for (int reg = 0; reg < 4; ++reg) { const int kcol = cw0 + cb * 16 + 4 * g + reg; const bool valid = (kcol >= cs) && (kcol < cs + 16); dcv[cb][reg] = valid ? (kcol - qcol + 15) : -1; }
    const int skey = tid >> 3, sch = tid & 7;
    const unsigned koff0 = (unsigned)(((cw0 + c16) * LDP + 8 * g) * 2), koff1 = koff0 + 16 * LDP * 2, qoff = (unsigned)((qcol * LDP + 8 * g) * 2), soff = (unsigned)((skey * LDP + sch * 8) * 2);
    for (int unit = F.c; unit < 256; unit += F.G) {
        const int b = unit >> 5, h = (unit >> 1) & 15, r0 = (unit & 1) * 16;
        const size_t tokb = (size_t)b * SEQ;
        const char* rowK = (const char*)(PROJ + tokb * LDP + PC_K + h * 64); const char* rowV = (const char*)(PROJ + tokb * LDP + PC_V + h * 64); const char* rowQ = (const char*)(PROJ + tokb * LDP + PC_Q + h * 64);
        constexpr size_t ROWB = (size_t)64 * LDP * 2;
        __syncthreads();
        if (tid < 465) BI[tid] = rpb[h * 465 + tid] * LOG2E;
        { const int rs0 = (r0 - 4) < 0 ? 0 : ((r0 - 4) > 24 ? 24 : (r0 - 4)); u32x4 pv_[8], pk_[8];
#pragma unroll
            for (int i = 0; i < 8; ++i) { pv_[i] = *(const u32x4*)(rowV + (size_t)(rs0 + i) * ROWB + soff); pk_[i] = *(const u32x4*)(rowK + (size_t)(rs0 + i) * ROWB + soff); }
#pragma unroll
            for (int i = 0; i < 8; ++i) { const int slot = (rs0 + i) % 9;
                *(LAS u32x4*)(lds + NA2_V + slot * NA2_SLOT + skey * NA_VSTR + sch * 16) = pv_[i];
                float f[8]; unpack8(pk_[i], f); float ss = 0.f;
#pragma unroll
                for (int j = 0; j < 8; ++j) ss += f[j] * f[j];
                ss = red8(ss); if (sch == 0) *(LAS float*)(lds + NA2_RK + slot * 256 + skey * 4) = __builtin_amdgcn_rsqf(ss * (1.0f / 64.0f) + 1e-6f); } }
        u32x4 qraw[2], kraw[8][2];
#define NA2_ISSUE(rr) do { const int rs_ = ((rr) - 4) < 0 ? 0 : (((rr) - 4) > 24 ? 24 : ((rr) - 4)); \
            const char* qp_ = rowQ + (size_t)(rr) * ROWB + qoff; qraw[0] = *(const u32x4*)qp_; qraw[1] = *(const u32x4*)(qp_ + 64); \
            _Pragma("unroll") for (int i_ = 0; i_ < 8; ++i_) { const char* kp_ = rowK + (size_t)(rs_ + kh * 4 + (i_ >> 1)) * ROWB + ((i_ & 1) ? koff1 : koff0); kraw[i_][0] = *(const u32x4*)kp_; kraw[i_][1] = *(const u32x4*)(kp_ + 64); } } while (0)
        NA2_ISSUE(r0);
        f32x2 bs[4][2][2]; int cur_dro = 99;
        __syncthreads();
        for (int r = r0; r < r0 + 16; ++r) {
            const int rs = (r - 4) < 0 ? 0 : ((r - 4) > 24 ? 24 : (r - 4));
            const int rn = r + 1; const int rsn = (rn - 4) < 0 ? 0 : ((rn - 4) > 24 ? 24 : (rn - 4)); const bool moves = (rn < r0 + 16) && (rsn != rs);
            u32x4 nv, nk;
            { nv = *(const u32x4*)(rowV + (size_t)(rsn + 7) * ROWB + soff); nk = *(const u32x4*)(rowK + (size_t)(rsn + 7) * ROWB + soff); }
            if (rs - r != cur_dro) { cur_dro = rs - r;
#pragma unroll
                for (int kr = 0; kr < 4; ++kr)
#pragma unroll
                    for (int cb = 0; cb < 2; ++cb)
#pragma unroll
                        for (int reg = 0; reg < 4; ++reg) { const int dc = dcv[cb][reg]; const float bv_ = BI[(cur_dro + kh * 4 + kr + 7) * 31 + (dc < 0 ? 0 : dc)]; bs[kr][cb][reg >> 1][reg & 1] = dc < 0 ? -1e30f : bv_; } }
            f32x2 qf[8]; unpack8v(qraw[0], qf); unpack8v(qraw[1], qf + 4);
            f32x2 s2 = (f32x2){0.f, 0.f};
#pragma unroll
            for (int j = 0; j < 8; ++j) s2 = qf[j] * qf[j] + s2;
            float ss = s2.x + s2.y; ss += __shfl_xor(ss, 16); ss += __shfl_xor(ss, 32);
            const float rq = __builtin_amdgcn_rsqf(ss * (1.0f / 64.0f) + 1e-6f);
            u32x4 q0u, q1u; unsigned* q0p = (unsigned*)&q0u; unsigned* q1p = (unsigned*)&q1u;
#pragma unroll
            for (int j = 0; j < 4; ++j) { const f32x2 a = qf[j] * gg[j], c = qf[4 + j] * gg[4 + j]; q0p[j] = pk2(a.x, a.y); q1p[j] = pk2(c.x, c.y); }
            const bf16x8 q0 = __builtin_bit_cast(bf16x8, q0u), q1 = __builtin_bit_cast(bf16x8, q1u);
            f32x4 acc[4][2];
#pragma unroll
            for (int kr = 0; kr < 4; ++kr)
#pragma unroll
                for (int cb = 0; cb < 2; ++cb) { f32x4 a = (f32x4){0.f, 0.f, 0.f, 0.f};
                    a = mfma16(__builtin_bit_cast(bf16x8, kraw[kr * 2 + cb][0]), q0, a); a = mfma16(__builtin_bit_cast(bf16x8, kraw[kr * 2 + cb][1]), q1, a); acc[kr][cb] = a; }
            asm volatile("" : "+v"(acc[0][0]), "+v"(acc[0][1]), "+v"(acc[1][0]), "+v"(acc[1][1]), "+v"(acc[2][0]), "+v"(acc[2][1]), "+v"(acc[3][0]), "+v"(acc[3][1]));
            NA2_ISSUE(rn < r0 + 16 ? rn : r);
            f32x2 sc[4][2][2]; float mx = -1e30f;
#pragma unroll
            for (int kr = 0; kr < 4; ++kr) { const int slot = (rs + kh * 4 + kr) % 9;
#pragma unroll
                for (int cb = 0; cb < 2; ++cb) { const f32x4 rk = *(LAS f32x4*)(lds + NA2_RK + slot * 256 + (cw0 + cb * 16 + 4 * g) * 4);
                    sc[kr][cb][0] = (acc[kr][cb].xy * rk.xy) * rq + bs[kr][cb][0]; sc[kr][cb][1] = (acc[kr][cb].zw * rk.zw) * rq + bs[kr][cb][1];
                    mx = fmaxf(fmaxf(mx, fmaxf(sc[kr][cb][0].x, sc[kr][cb][0].y)), fmaxf(sc[kr][cb][1].x, sc[kr][cb][1].y)); } }
            mx = fmaxf(mx, __shfl_xor(mx, 16)); mx = fmaxf(mx, __shfl_xor(mx, 32));
            f32x2 ls2 = (f32x2){0.f, 0.f};
#pragma unroll
            for (int kr = 0; kr < 4; ++kr)
#pragma unroll
                for (int cb = 0; cb < 2; ++cb)
#pragma unroll
                    for (int hh = 0; hh < 2; ++hh) { const f32x2 d = sc[kr][cb][hh] - mx; f32x2 p; p.x = __builtin_amdgcn_exp2f(d.x); p.y = __builtin_amdgcn_exp2f(d.y); sc[kr][cb][hh] = p; ls2 = ls2 + p; }
            float lsum = ls2.x + ls2.y; lsum += __shfl_xor(lsum, 16); lsum += __shfl_xor(lsum, 32);
            f32x4 o[4];
#pragma unroll
            for (int db = 0; db < 4; ++db) o[db] = (f32x4){0.f, 0.f, 0.f, 0.f};
#pragma unroll
            for (int kr = 0; kr < 4; ++kr) {
                u32x4 pu; pu.x = pk2(sc[kr][0][0].x, sc[kr][0][0].y); pu.y = pk2(sc[kr][0][1].x, sc[kr][0][1].y); pu.z = pk2(sc[kr][1][0].x, sc[kr][1][0].y); pu.w = pk2(sc[kr][1][1].x, sc[kr][1][1].y);
                const bf16x8 pa = __builtin_bit_cast(bf16x8, pu);
                const int slot = (rs + kh * 4 + kr) % 9;
                LAS unsigned char* a0 = lds + NA2_V + slot * NA2_SLOT + (cw0 + 4 * g + (c16 >> 2)) * NA_VSTR + (c16 & 3) * 8;
#pragma unroll
                for (int db = 0; db < 4; ++db) { const s16x4 lo = tr_read(a0 + db * 32), hi = tr_read(a0 + 16 * NA_VSTR + db * 32);
                    const bf16x8 vb = (bf16x8){lo[0], lo[1], lo[2], lo[3], hi[0], hi[1], hi[2], hi[3]};
                    o[db] = mfma16(vb, pa, o[db]); } }
            LAS float* mp = MRG + (qb * 64 + lane) * 18;
            if (kh == 1) { *(LAS f32x2*)(mp + 16) = (f32x2){mx, lsum};
#pragma unroll
                for (int db = 0; db < 4; ++db) { *(LAS f32x2*)(mp + db * 4) = o[db].xy; *(LAS f32x2*)(mp + db * 4 + 2) = o[db].zw; } }
            __syncthreads();
            if (moves) { const int slot = (rsn + 7) % 9;
                *(LAS u32x4*)(lds + NA2_V + slot * NA2_SLOT + skey * NA_VSTR + sch * 16) = nv;
                float f[8]; unpack8(nk, f); float sq = 0.f;
#pragma unroll
                for (int j = 0; j < 8; ++j) sq += f[j] * f[j];
                sq = red8(sq); if (sch == 0) *(LAS float*)(lds + NA2_RK + slot * 256 + skey * 4) = __builtin_amdgcn_rsqf(sq * (1.0f / 64.0f) + 1e-6f); }
            if (kh == 0) { const f32x2 ml = *(LAS f32x2*)(mp + 16); const float mm = fmaxf(mx, ml.x); const float f0 = __builtin_amdgcn_exp2f(mx - mm), f1 = __builtin_amdgcn_exp2f(ml.x - mm); const float inv = __builtin_amdgcn_rcpf(lsum * f0 + ml.y * f1);
                const float g0 = f0 * inv, g1 = f1 * inv;
                bf16* dst = MIX + (tokb + (size_t)r * 64 + qcol) * DM + h * 64 + 4 * g;
#pragma unroll
                for (int db = 0; db < 4; ++db) { const f32x2 pa_ = *(LAS f32x2*)(mp + db * 4), pb_ = *(LAS f32x2*)(mp + db * 4 + 2);
                    const f32x2 oa = o[db].xy * g0 + pa_ * g1, ob = o[db].zw * g0 + pb_ * g1;
                    u32x2 ov; ov.x = pk2(oa.x, oa.y); ov.y = pk2(ob.x, ob.y);
                    *(u32x2*)(dst + db * 16) = ov; } }
            __syncthreads();
        }
    }
}

constexpr int PO_SGSTR = 336;
__device__ __forceinline__ void post_phase(const Frame& F, LAS unsigned char* lds) {
    const bf16* PROJ = (const bf16*)(F.ws + WS_PROJ); const bf16* G2T = (const bf16*)(F.ws + WS_G2T); const float* WKV = (const float*)(F.ws + WS_WKV); const float* SB = (const float*)(F.ws + WS_SB);
    bf16* MIX = (bf16*)(F.ws + WS_MIX); const float* mu_prev = gptr(F.in[6]); const float* mu_next = gptr(F.in[7]); const float* lnx_w = gptr(F.in[16]); const float* lnx_b = gptr(F.in[17]);
    const int lane = F.lane, w = F.wave, c16 = lane & 15, g = lane >> 4;
    for (int tile = F.c; tile < MTOK / 64; tile += F.G) {
        const int m0 = tile * 64;
        __syncthreads();
        for (int i = F.tid; i < 64 * (GLORA / 8); i += NTHR) { const int tok = i / (GLORA / 8), ch = i - tok * (GLORA / 8); const int m = m0 + tok, t = m & (SEQ - 1);
            const bf16* p = PROJ + (size_t)m * LDP + PC_RW + 3328 + 8 * ch; float c0[8], pm[8], pn[8]; unpack8(*(const u32x4*)p, c0);
            if (t > 0) unpack8(*(const u32x4*)(p - LDP), pm); else {
#pragma unroll
                for (int j = 0; j < 8; ++j) pm[j] = 0.f; }
            if (t < SEQ - 1) unpack8(*(const u32x4*)(p + LDP), pn); else {
#pragma unroll
                for (int j = 0; j < 8; ++j) pn[j] = 0.f; }
            const f32x4 mpA = *(const f32x4*)(mu_prev + 3328 + 8 * ch), mpB = *(const f32x4*)(mu_prev + 3328 + 8 * ch + 4), mnA = *(const f32x4*)(mu_next + 3328 + 8 * ch), mnB = *(const f32x4*)(mu_next + 3328 + 8 * ch + 4);
            float sg[8];
#pragma unroll
            for (int j = 0; j < 8; ++j) { const float mp = j < 4 ? mpA[j & 3] : mpB[j & 3], mn = j < 4 ? mnA[j & 3] : mnB[j & 3]; sg[j] = sigmoidf_(c0[j] + mp * (pm[j] - c0[j]) + mn * (pn[j] - c0[j])); }
            u32x4 o; o.x = pk2(sg[0], sg[1]); o.y = pk2(sg[2], sg[3]); o.z = pk2(sg[4], sg[5]); o.w = pk2(sg[6], sg[7]);
            *(LAS u32x4*)(lds + tok * PO_SGSTR + ch * 16) = o; }
        __syncthreads();
#pragma unroll 1
        for (int hd = 0; hd < 2; ++hd) {
            const int head = 2 * w + hd;
            f32x4 acc[4][4];
#pragma unroll
            for (int q = 0; q < 4; ++q)
#pragma unroll
                for (int mb = 0; mb < 4; ++mb) acc[q][mb] = (f32x4){0.f, 0.f, 0.f, 0.f};
#pragma unroll
            for (int ks = 0; ks < 5; ++ks) { bf16x8 bfr[4];
#pragma unroll
                for (int mb = 0; mb < 4; ++mb) bfr[mb] = *(LAS bf16x8*)(lds + (16 * mb + c16) * PO_SGSTR + (32 * ks + 8 * g) * 2);
#pragma unroll
                for (int q = 0; q < 4; ++q) { const bf16x8 af = *(const bf16x8*)(G2T + (size_t)(64 * head + 16 * q + c16) * GLORA + 32 * ks + 8 * g);
#pragma unroll
                    for (int mb = 0; mb < 4; ++mb) acc[q][mb] = mfma16(af, bfr[mb], acc[q][mb]); } }
#pragma unroll
            for (int mb = 0; mb < 4; ++mb) { const int m = m0 + 16 * mb + c16, t = m & (SEQ - 1); f32x4 x[4]; float s1 = 0.f;
#pragma unroll
                for (int q = 0; q < 4; ++q) { const int ch = 64 * head + 16 * q + 4 * g; x[q] = __builtin_nontemporal_load((const f32x4*)(WKV + (size_t)m * RWW + ch)) + __builtin_nontemporal_load((const f32x4*)(WKV + ((size_t)MTOK + m) * RWW + ch)); s1 += (x[q][0] + x[q][1]) + (x[q][2] + x[q][3]); }
                s1 += __shfl_xor(s1, 16); s1 += __shfl_xor(s1, 32); const float mean = s1 * (1.0f / 64.0f); float s2 = 0.f;
#pragma unroll
                for (int q = 0; q < 4; ++q) { const f32x4 d = x[q] - mean; s2 += (d[0] * d[0] + d[1] * d[1]) + (d[2] * d[2] + d[3] * d[3]); }
                s2 += __shfl_xor(s2, 16); s2 += __shfl_xor(s2, 32); const float rstd = 1.0f / sqrtf(s2 * (1.0f / 64.0f) + 64e-5f);
                const float sbv = SB[(size_t)m * 16 + head] + SB[((size_t)MTOK + m) * 16 + head];
#pragma unroll
                for (int q = 0; q < 4; ++q) { const int ch = 64 * head + 16 * q + 4 * g;
                    const bf16* pv = PROJ + (size_t)m * LDP + PC_RW + 2048 + ch; const u32x2 c0u = *(const u32x2*)pv; u32x2 pmu = (u32x2){0u, 0u}, pnu = (u32x2){0u, 0u};
                    if (t > 0) pmu = *(const u32x2*)(pv - LDP); if (t < SEQ - 1) pnu = *(const u32x2*)(pv + LDP);
                    const f32x4 c0 = (f32x4){bflo(c0u.x), bfhi(c0u.x), bflo(c0u.y), bfhi(c0u.y)}, pm = (f32x4){bflo(pmu.x), bfhi(pmu.x), bflo(pmu.y), bfhi(pmu.y)}, pn = (f32x4){bflo(pnu.x), bfhi(pnu.x), bflo(pnu.y), bfhi(pnu.y)};
                    const f32x4 mp = *(const f32x4*)(mu_prev + 2048 + ch), mn = *(const f32x4*)(mu_next + 2048 + ch);
                    const f32x4 vs = c0 + mp * (pm - c0) + mn * (pn - c0);
                    const f32x4 lw = *(const f32x4*)(lnx_w + ch), lb = *(const f32x4*)(lnx_b + ch);
                    const f32x4 y = ((x[q] - mean) * rstd * lw + lb + sbv * vs) * acc[q][mb];
                    u32x2 o; o.x = pk2(y[0], y[1]); o.y = pk2(y[2], y[3]); *(u32x2*)(MIX + (size_t)m * DM + NAW + ch) = o; }
                asm volatile("" ::: "memory"); }
        }
    }
}

constexpr int RT_PITCH = 4112, RT_LO = 16 * RT_PITCH;
__device__ __forceinline__ void norm2_router_phase(const Frame& F, LAS unsigned char* lds) {
    const float* wrt = gptr(F.in[20]); const float* gn = gptr(F.in[19]);
    for (int i = F.tid; i < DM * NE; i += NTHR) { const int d = i >> 4, e = i & 15; const float wv = gn[d] * wrt[i]; const unsigned hi = f2bf(wv); const unsigned lo = f2bf(wv - bf2f((unsigned short)hi));
        *(LAS bf16*)(lds + e * RT_PITCH + d * 2) = (bf16)hi; *(LAS bf16*)(lds + RT_LO + e * RT_PITCH + d * 2) = (bf16)lo; }
    __syncthreads();
    const bf16* X2 = (const bf16*)(F.ws + WS_X2); unsigned char* H2 = (unsigned char*)(F.ws + WS_H); float* AFF = (float*)(F.ws + WS_AFF);
    const int lane = F.lane, c16 = lane & 15, g = lane >> 4, gw = F.c * NWAVES + F.wave, NGW = F.G * NWAVES;
    f32x4 gains[8];
#pragma unroll
    for (int j = 0; j < 8; ++j) gains[j] = ((const f32x4*)gn)[64 * j + lane];
    for (int blk = gw; blk < MTOK / 16; blk += NGW) {
        const int m0 = 16 * blk;
        const bf16* xrow = X2 + (size_t)(m0 + c16) * DM + 8 * g; LAS unsigned char* bh = lds + c16 * RT_PITCH + 16 * g;
        f32x4 acc = (f32x4){0.f, 0.f, 0.f, 0.f}; f32x2 sq = (f32x2){0.f, 0.f};
#pragma unroll 8
        for (int ks = 0; ks < 64; ++ks) { const u32x4 a = *(const u32x4*)(xrow + 32 * ks);
            const bf16x8 h8 = *(LAS bf16x8*)(bh + 64 * ks), l8 = *(LAS bf16x8*)(bh + RT_LO + 64 * ks);
            acc = mfma16(__builtin_bit_cast(bf16x8, a), h8, acc); acc = mfma16(__builtin_bit_cast(bf16x8, a), l8, acc);
            f32x2 f[4]; unpack8v(a, f); sq = f[0] * f[0] + sq; sq = f[1] * f[1] + sq; sq = f[2] * f[2] + sq; sq = f[3] * f[3] + sq; }
        float ssq = sq.x + sq.y; ssq += __shfl_xor(ssq, 16); ssq += __shfl_xor(ssq, 32);
        const float rstd_c = __builtin_amdgcn_rsqf(ssq * (1.0f / DM) + 1e-6f);
        f32x4 aff;
#pragma unroll
        for (int reg = 0; reg < 4; ++reg) { const float lg = acc[reg] * __shfl(rstd_c, 4 * g + reg); float mx = lg;
#pragma unroll
            for (int o = 1; o < 16; o <<= 1) mx = fmaxf(mx, __shfl_xor(mx, o));
            const float ex = __expf(lg - mx); float sm = ex;
#pragma unroll
            for (int o = 1; o < 16; o <<= 1) sm += __shfl_xor(sm, o);
            aff[reg] = ex / sm; }
        { const int b = m0 >> 11, t0 = (m0 & (SEQ - 1)) + 4 * g; *(f32x4*)(AFF + ((size_t)b * NE + c16) * SEQ + t0) = aff; }
        for (int r = 0; r < 16; ++r) { const float rs = __shfl(rstd_c, r); const u32x2* xr = (const u32x2*)(X2 + (size_t)(m0 + r) * DM) + lane; unsigned* o4 = (unsigned*)(H2 + (size_t)(m0 + r) * DM) + lane;
#pragma unroll
            for (int j = 0; j < 8; ++j) { const u32x2 xv = xr[64 * j]; const f32x4 hv = (f32x4){bflo(xv.x), bfhi(xv.x), bflo(xv.y), bfhi(xv.y)} * rs * gains[j];
                int pw = __builtin_amdgcn_cvt_pk_fp8_f32(hv.x, hv.y, 0, false); pw = __builtin_amdgcn_cvt_pk_fp8_f32(hv.z, hv.w, pw, true); o4[64 * j] = (unsigned)pw; } }
    }
}

__device__ __forceinline__ int block_excl_scan(int v, int& total, LAS int* part, int lane, int wave) {
    int inc = v;
#pragma unroll
    for (int o = 1; o < 64; o <<= 1) { const int y = __shfl_up(inc, o); inc += (lane >= o) ? y : 0; }
    if (lane == 63) part[wave] = inc;
    __syncthreads();
    int base = 0, tot = 0;
#pragma unroll
    for (int ww = 0; ww < NWAVES; ++ww) { const int p = part[ww]; base += (ww < wave) ? p : 0; tot += p; }
    __syncthreads();
    total = tot; return base + inc - v;
}
__device__ __forceinline__ void topk_gather_phase(const Frame& F, LAS unsigned char* lds) {
    LAS int* IDX = (LAS int*)lds; LAS int* PART = (LAS int*)(lds + 1024); LAS int* CNT = (LAS int*)(lds + 1024 + 64);
    const float* AFF = (const float*)(F.ws + WS_AFF); float* GATE = (float*)(F.ws + WS_GATE); int* TOKSLOT = (int*)(F.ws + WS_TOKSLOT);
    const unsigned char* H2 = (unsigned char*)(F.ws + WS_H); unsigned char* XE = (unsigned char*)(F.ws + WS_XE);
    const int tid = F.tid, lane = F.lane, wave = F.wave;
    for (int uu = F.c; uu < 2 * NB * NE; uu += F.G) {
        const int u = uu >> 1, half = uu & 1, b = u >> 4, e = u & 15;
        __syncthreads();
        const u32x4 kv = *(const u32x4*)(AFF + (size_t)u * SEQ + 4 * tid);
        unsigned key[4]; key[0] = kv.x; key[1] = kv.y; key[2] = kv.z; key[3] = kv.w;
        asm volatile("" : "+v"(key[0]), "+v"(key[1]), "+v"(key[2]), "+v"(key[3]));
        unsigned T = 0u;
        for (int bit = 31; bit >= 0; --bit) { const unsigned cand = T | (1u << bit);
            int c = 0;
#pragma unroll
            for (int j = 0; j < 4; ++j) c += (key[j] >= cand) ? 1 : 0;
#pragma unroll
            for (int o = 1; o < 64; o <<= 1) c += __shfl_xor(c, o);
            if (lane == 0) CNT[(bit & 1) * 8 + wave] = c;
            __syncthreads();
            int tot = 0;
#pragma unroll
            for (int ww = 0; ww < NWAVES; ++ww) tot += CNT[(bit & 1) * 8 + ww];
            if (tot >= CAP) T = cand; }
        int ngt = 0, neq = 0;
#pragma unroll
        for (int j = 0; j < 4; ++j) { ngt += (key[j] > T) ? 1 : 0; neq += (key[j] == T) ? 1 : 0; }
        int tot_gt, tot_eq; const int eq_before = block_excl_scan(neq, tot_eq, PART, lane, wave); (void)block_excl_scan(ngt, tot_gt, PART, lane, wave);
        const int need = CAP - tot_gt;
        bool sel[4]; int nsel = 0, eqr = eq_before;
#pragma unroll
        for (int j = 0; j < 4; ++j) { const bool iseq = key[j] == T; sel[j] = (key[j] > T) || (iseq && eqr < need); eqr += iseq ? 1 : 0; nsel += sel[j] ? 1 : 0; }
        int tot_sel; int slot = block_excl_scan(nsel, tot_sel, PART, lane, wave);
#pragma unroll
        for (int j = 0; j < 4; ++j) { const int t = 4 * tid + j; const int sl = sel[j] ? slot : -1; if (half == 0) TOKSLOT[((size_t)b * SEQ + t) * NE + e] = sl;
            if (sel[j]) { IDX[slot] = t; if (half == 0) GATE[e * 2048 + b * CAP + slot] = __builtin_bit_cast(float, key[j]); ++slot; } }
        __syncthreads();
        for (int s8 = wave; s8 < CAP / 2; s8 += NWAVES) { const int sl = half * (CAP / 2) + s8; const int t = IDX[sl];
            const u32x4* src = (const u32x4*)(H2 + ((size_t)b * SEQ + t) * DM) + lane; u32x4* dst = (u32x4*)(XE + ((size_t)e * 2048 + b * CAP + sl) * DM) + lane;
#pragma unroll
            for (int j = 0; j < 2; ++j) dst[64 * j] = src[64 * j]; }
    }
}

__device__ __forceinline__ void combine_phase(const Frame& F) {
    const int* TOKSLOT = (const int*)(F.ws + WS_TOKSLOT); const bf16* YE = (const bf16*)(F.ws + WS_XE);
    const int lane = F.lane, gw = F.c * NWAVES + F.wave, NGW = F.G * NWAVES;
    for (int m = gw; m < MTOK; m += NGW) { const int b = m >> 11; const int myslot = lane < NE ? TOKSLOT[(size_t)m * NE + lane] : -1;
        f32x4* orow = (f32x4*)(F.out + (size_t)m * DM) + lane; const u32x2* xrow = (const u32x2*)((const bf16*)(F.ws + WS_X2) + (size_t)m * DM) + lane; f32x4 acc[8];
#pragma unroll
        for (int j = 0; j < 8; ++j) { const u32x2 xv = xrow[64 * j]; acc[j] = (f32x4){bflo(xv.x), bfhi(xv.x), bflo(xv.y), bfhi(xv.y)}; }
#pragma unroll
        for (int e = 0; e < NE; ++e) { const int sl = __builtin_amdgcn_readlane(myslot, e);
            if (sl >= 0) { const u32x2* yr = (const u32x2*)(YE + ((size_t)e * 2048 + b * CAP + sl) * DM) + lane;
#pragma unroll
                for (int j = 0; j < 8; ++j) { const u32x2 v = __builtin_nontemporal_load(&yr[64 * j]); acc[j] += (f32x4){bflo(v.x), bfhi(v.x), bflo(v.y), bfhi(v.y)}; } } }
#pragma unroll
        for (int j = 0; j < 8; ++j) __builtin_nontemporal_store(acc[j], &orow[64 * j]);
    }
}
constexpr int CS_ST = 160, CS_MAT = 64 * CS_ST;
constexpr int CL_LW2 = 0, CL_LA2 = CS_MAT, CL_S = 2 * CS_MAT, CL_AT = 3 * CS_MAT, CL_BT = 4 * CS_MAT, CL_KT = 5 * CS_MAT, CL_RT = 6 * CS_MAT, CL_VM = 7 * CS_MAT;
constexpr int CL_XB0 = 8 * CS_MAT, CL_XB1 = 9 * CS_MAT, CL_PB0 = 10 * CS_MAT, CL_PB1 = 11 * CS_MAT, CL_MK = 12 * CS_MAT, CL_PBM = 13 * CS_MAT, CL_PKM = 14 * CS_MAT;
constexpr int CL_GL = 15 * CS_MAT, CL_CST = CL_GL + 256, CL_MU = CL_CST + 1536, CL_END = CL_MU + 3840;
constexpr int CL_X1 = CL_XB0, CL_X2 = CL_PB0, CL_WR = CL_PB1, WR_ST = 272, CL_AR = CL_WR + 64 * WR_ST, CL_TOT = CL_XB0;
constexpr int CL_Z = CL_KT, CL_U = CL_XB1;
static_assert(CL_AR + 64 * WR_ST <= CL_GL && CL_END <= LDS_BYTES - 16, "scan LDS map");

__device__ __forceinline__ bf16x8 cs_ld_row(LAS unsigned char* M, int row0, int ks, int c16, int g) { return *(LAS bf16x8*)(M + (row0 + c16) * CS_ST + (32 * ks + 8 * g) * 2); }
__device__ __forceinline__ bf16x8 cs_ld_tr(LAS unsigned char* M, int col0, int ks, int c16, int g) {
    LAS unsigned char* p = M + (32 * ks + 8 * g + (c16 >> 2)) * CS_ST + (col0 + 4 * (c16 & 3)) * 2;
    const s16x4 lo = tr_read(p), hi = tr_read(p + 4 * CS_ST);
    return (bf16x8){lo[0], lo[1], lo[2], lo[3], hi[0], hi[1], hi[2], hi[3]};
}
template <bool ATR, bool BTR> __device__ __forceinline__ void cs_mm(f32x4 (&acc)[2], LAS unsigned char* MA, LAS unsigned char* MB, int rb, int cb0, int c16, int g) {
#pragma unroll
    for (int ks = 0; ks < 2; ++ks) { const bf16x8 a = ATR ? cs_ld_tr(MA, 16 * rb, ks, c16, g) : cs_ld_row(MA, 16 * rb, ks, c16, g);
#pragma unroll
        for (int q = 0; q < 2; ++q) { const bf16x8 b = BTR ? cs_ld_tr(MB, 16 * (cb0 + q), ks, c16, g) : cs_ld_row(MB, 16 * (cb0 + q), ks, c16, g); acc[q] = mfma16(b, a, acc[q]); } }
}
__device__ __forceinline__ void cs_st(LAS unsigned char* M, int rb, int cb, const f32x4 v, int c16, int g) {
    u32x2 o; o.x = pk2(v[0], v[1]); o.y = pk2(v[2], v[3]); *(LAS u32x2*)(M + (16 * rb + c16) * CS_ST + (16 * cb + 4 * g) * 2) = o;
}
#define CS_ZERO2(a) do { a[0] = (f32x4){0.f, 0.f, 0.f, 0.f}; a[1] = (f32x4){0.f, 0.f, 0.f, 0.f}; } while (0)

__device__ __forceinline__ void scan_phase2(const Frame& F, LAS unsigned char* lds) {
    const bf16* PROJ = (const bf16*)(F.ws + WS_PROJ); float* WKV = (float*)(F.ws + WS_WKV); float* SBG = (float*)(F.ws + WS_SB);
    const float* mu_prev = gptr(F.in[6]); const float* mu_next = gptr(F.in[7]); const float* w0 = gptr(F.in[8]); const float* w2 = gptr(F.in[9]); const float* a0 = gptr(F.in[10]); const float* a2 = gptr(F.in[11]);
    const float* k_k = gptr(F.in[13]); const float* k_a = gptr(F.in[14]); const float* r_k = gptr(F.in[15]);
    const int tid = F.tid, lane = F.lane, w = F.wave;
    const int tl = lane & 7, cg = lane >> 3, trow = 8 * w + tl, cg8 = 8 * cg;
    const int c16 = lane & 15, g = lane >> 4, rb = w >> 1, cb0 = 2 * (w & 1);
    for (int sid = F.c; sid < 256; sid += F.G) {
        const int z = sid >> 7, b = (sid >> 4) & 7, h = sid & 15;
        __syncthreads();
        LAS unsigned char* L1 = lds; asm volatile("" : "+v"(L1));
        for (int i = tid; i < 4096; i += NTHR) { const int l = i >> 6, c = i & 63;
            *(LAS bf16*)(L1 + CL_LW2 + l * CS_ST + c * 2) = (bf16)f2bf(w2[((size_t)z * 64 + l) * RWW + h * 64 + c]);
            *(LAS bf16*)(L1 + CL_LA2 + l * CS_ST + c * 2) = (bf16)f2bf(a2[((size_t)z * 64 + l) * RWW + h * 64 + c]);
            *(LAS bf16*)(L1 + CL_S + l * CS_ST + c * 2) = (bf16)0; }
        const int fc0 = 64 * h, fc1 = 1024 + 64 * h, fc2 = 2048 + 64 * h, fc3 = 3072 + 64 * z, fc4 = 3200 + 64 * z;
        { LAS float* MU = (LAS float*)(L1 + CL_MU); LAS float* CST = (LAS float*)(L1 + CL_CST);
            if (tid < 64) { const int c = tid; const int fcs[5] = {fc0, fc1, fc2, fc3, fc4};
#pragma unroll
                for (int f = 0; f < 5; ++f) { const float mp_ = mu_prev[fcs[f] + c], mn_ = mu_next[fcs[f] + c]; MU[(3 * f) * 64 + c] = 1.0f - mp_ - mn_; MU[(3 * f + 1) * 64 + c] = mp_; MU[(3 * f + 2) * 64 + c] = mn_; }
                const float ka_ = k_a[64 * h + c];
                CST[c] = w0[z * RWW + 64 * h + c]; CST[64 + c] = a0[z * RWW + 64 * h + c]; CST[128 + c] = k_k[64 * h + c]; CST[192 + c] = ka_; CST[256 + c] = 1.0f - ka_; CST[320 + c] = r_k[h * 64 + c]; } }
        f32x4 sst[2]; CS_ZERO2(sst);
        u32x4 raw[15];
#define CS_ISSUE(cj) do { const int sidx_ = (cj) * 64 + trow; const int t_ = z ? (SEQ - 1 - sidx_) : sidx_; const bf16* p0_ = PROJ + ((size_t)b * SEQ + t_) * LDP + PC_RW + cg8; \
            const int dm_ = t_ > 0 ? -LDP : 0, dn_ = t_ < SEQ - 1 ? LDP : 0; \
            _Pragma("unroll") for (int f = 0; f < 5; ++f) { const int fc = (f == 0) ? fc0 : (f == 1) ? fc1 : (f == 2) ? fc2 : (f == 3) ? fc3 : fc4; \
                raw[3 * f] = *(const u32x4*)(p0_ + fc); raw[3 * f + 1] = *(const u32x4*)(p0_ + fc + dm_); raw[3 * f + 2] = *(const u32x4*)(p0_ + fc + dn_); } } while (0)
        CS_ISSUE(0);
        f32x2 xr[4], xk[4], xv[4];
#define CS_S0(CJ) do { \
            { const int sidx0_ = (CJ) * 64 + trow; const int t0_ = z ? (SEQ - 1 - sidx0_) : sidx0_; const bool edge = ((CJ) == 0) || ((CJ) == 31); const float fpm = t0_ > 0 ? 1.f : 0.f, fpn = t0_ < SEQ - 1 ? 1.f : 0.f; \
            _Pragma("unroll") \
                for (int f = 0; f < 5; ++f) { \
                    f32x2 c0[4], pm[4], pn[4], xs[4]; unpack8v(raw[3 * f], c0); unpack8v(raw[3 * f + 1], pm); unpack8v(raw[3 * f + 2], pn); \
                    if (edge) { \
            _Pragma("unroll") \
                        for (int i = 0; i < 4; ++i) { pm[i] = pm[i] * fpm; pn[i] = pn[i] * fpn; } } \
                    const LAS f32x4* mu = (const LAS f32x4*)&MU[(3 * f) * 64 + cg8];                   \
                    const f32x4 k0A = mu[0], k0B = mu[1], mpA = mu[16], mpB = mu[17], mnA = mu[32], mnB = mu[33]; \
                    xs[0] = c0[0] * k0A.xy + pm[0] * mpA.xy + pn[0] * mnA.xy; xs[1] = c0[1] * k0A.zw + pm[1] * mpA.zw + pn[1] * mnA.zw; \
                    xs[2] = c0[2] * k0B.xy + pm[2] * mpB.xy + pn[2] * mnB.xy; xs[3] = c0[3] * k0B.zw + pm[3] * mpB.zw + pn[3] * mnB.zw; \
                    if (f == 0) { \
            _Pragma("unroll") \
                        for (int i = 0; i < 4; ++i) xr[i] = xs[i]; } \
                    else if (f == 1) { \
            _Pragma("unroll") \
                        for (int i = 0; i < 4; ++i) xk[i] = xs[i]; } \
                    else if (f == 2) { \
            _Pragma("unroll") \
                        for (int i = 0; i < 4; ++i) xv[i] = xs[i]; } \
                    else { if (f == 3) { \
            _Pragma("unroll") \
                            for (int i = 0; i < 4; ++i) { const f32x2 a2 = xs[i] * 2.885390082f; f32x2 e2; e2.x = __builtin_amdgcn_exp2f(a2.x); e2.y = __builtin_amdgcn_exp2f(a2.y); e2 = e2 + 1.0f; \
                                f32x2 rr; rr.x = __builtin_amdgcn_rcpf(e2.x); rr.y = __builtin_amdgcn_rcpf(e2.y); xs[i] = rr * (-2.0f) + 1.0f; } }                    \
                        u32x4 pk; pk.x = pk2(xs[0].x, xs[0].y); pk.y = pk2(xs[1].x, xs[1].y); pk.z = pk2(xs[2].x, xs[2].y); pk.w = pk2(xs[3].x, xs[3].y); \
                        *(LAS u32x4*)(L0 + (f == 3 ? CL_X1 : CL_X2) + trow * CS_ST + cg8 * 2) = pk; } } } \
            } while (0)
        __syncthreads();
        { LAS unsigned char* L0 = lds; asm volatile("" : "+v"(L0)); LAS float* MU = (LAS float*)(L0 + CL_MU); CS_S0(0); }
        __syncthreads();
        for (int ci = 0; ci < 32; ++ci) {
            LAS unsigned char* L0 = lds; asm volatile("" : "+v"(L0));
            LAS float* MU = (LAS float*)(L0 + CL_MU); LAS float* CST = (LAS float*)(L0 + CL_CST);
            { f32x4 wa[2], aa[2]; CS_ZERO2(wa); CS_ZERO2(aa);
                { bf16x8 a1[2], a2_[2], b10[2], b11[2], b20[2], b21[2];
                    a1[0] = cs_ld_row(L0 + CL_X1, 16 * rb, 0, c16, g); a1[1] = cs_ld_row(L0 + CL_X1, 16 * rb, 1, c16, g); a2_[0] = cs_ld_row(L0 + CL_X2, 16 * rb, 0, c16, g); a2_[1] = cs_ld_row(L0 + CL_X2, 16 * rb, 1, c16, g);
                    b10[0] = cs_ld_tr(L0 + CL_LW2, 16 * cb0, 0, c16, g); b10[1] = cs_ld_tr(L0 + CL_LW2, 16 * cb0, 1, c16, g); b11[0] = cs_ld_tr(L0 + CL_LW2, 16 * cb0 + 16, 0, c16, g); b11[1] = cs_ld_tr(L0 + CL_LW2, 16 * cb0 + 16, 1, c16, g);
                    b20[0] = cs_ld_tr(L0 + CL_LA2, 16 * cb0, 0, c16, g); b20[1] = cs_ld_tr(L0 + CL_LA2, 16 * cb0, 1, c16, g); b21[0] = cs_ld_tr(L0 + CL_LA2, 16 * cb0 + 16, 0, c16, g); b21[1] = cs_ld_tr(L0 + CL_LA2, 16 * cb0 + 16, 1, c16, g);
                    __builtin_amdgcn_sched_barrier(0);
                    wa[0] = mfma16(b10[0], a1[0], wa[0]); wa[1] = mfma16(b11[0], a1[0], wa[1]); wa[0] = mfma16(b10[1], a1[1], wa[0]); wa[1] = mfma16(b11[1], a1[1], wa[1]);
                    aa[0] = mfma16(b20[0], a2_[0], aa[0]); aa[1] = mfma16(b21[0], a2_[0], aa[1]); aa[0] = mfma16(b20[1], a2_[1], aa[0]); aa[1] = mfma16(b21[1], a2_[1], aa[1]); }
#pragma unroll
                for (int q = 0; q < 2; ++q) { const int off = (16 * rb + c16) * WR_ST + (16 * (cb0 + q) + 4 * g) * 4; *(LAS f32x4*)(L0 + CL_WR + off) = wa[q]; *(LAS f32x4*)(L0 + CL_AR + off) = aa[q]; } }
            __syncthreads();
            f32x2 lw[4], av[4], bv[4]; float lam[8];
            { const LAS f32x4* wrp = (const LAS f32x4*)(L0 + CL_WR + trow * WR_ST + cg8 * 4); const LAS f32x4* arp = (const LAS f32x4*)(L0 + CL_AR + trow * WR_ST + cg8 * 4);
                const f32x4 wA = wrp[0], wB = wrp[1], aA = arp[0], aB = arp[1];
                const LAS f32x4* cst = (const LAS f32x4*)&CST[cg8];
                const f32x4 w0A = cst[0], w0B = cst[1], a0A = cst[16], a0B = cst[17], kkA = cst[32], kkB = cst[33], kaA = cst[48], kaB = cst[49], okA = cst[64], okB = cst[65], rkA = cst[80], rkB = cst[81];
                const f32x2 wr_[4] = {wA.xy + w0A.xy, wA.zw + w0A.zw, wB.xy + w0B.xy, wB.zw + w0B.zw}, ar_[4] = {aA.xy + a0A.xy, aA.zw + a0A.zw, aB.xy + a0B.xy, aB.zw + a0B.zw};
                const f32x2 kkc[4] = {kkA.xy, kkA.zw, kkB.xy, kkB.zw}, kac[4] = {kaA.xy, kaA.zw, kaB.xy, kaB.zw}, okc[4] = {okA.xy, okA.zw, okB.xy, okB.zw}, rkc[4] = {rkA.xy, rkA.zw, rkB.xy, rkB.zw};
                f32x2 kk[4], ss2 = (f32x2){0.f, 0.f}, bo2 = (f32x2){0.f, 0.f};
#pragma unroll
                for (int i = 0; i < 4; ++i) { kk[i] = xk[i] * kkc[i]; ss2 = kk[i] * kk[i] + ss2; }
                float ssq = ss2.x + ss2.y;
                ssq += dppf<0x128>(ssq); ssq += __shfl_xor(ssq, 16); ssq += __shfl_xor(ssq, 32);
                const float ninv = -__builtin_amdgcn_rcpf(fmaxf(__builtin_amdgcn_sqrtf(ssq), 1e-12f));
#pragma unroll
                for (int i = 0; i < 4; ++i) { f32x2 ew = wr_[i] * (-1.442695041f), ea = ar_[i] * (-1.442695041f);
                    ew.x = __builtin_amdgcn_exp2f(ew.x); ew.y = __builtin_amdgcn_exp2f(ew.y); ea.x = __builtin_amdgcn_exp2f(ea.x); ea.y = __builtin_amdgcn_exp2f(ea.y); ew = ew + 1.0f; ea = ea + 1.0f;
                    f32x2 sw, as; sw.x = __builtin_amdgcn_rcpf(ew.x); sw.y = __builtin_amdgcn_rcpf(ew.y); as.x = __builtin_amdgcn_rcpf(ea.x); as.y = __builtin_amdgcn_rcpf(ea.y);
                    lw[i] = sw * (-0.6065306597f); av[i] = kk[i] * ninv; bv[i] = -(av[i] * as);
                    const f32x2 kd = xk[i] * (as * kac[i] + okc[i]); bo2 = xr[i] * (kd * rkc[i]) + bo2; xk[i] = kd; }
                float bon = bo2.x + bo2.y;
                bon += dppf<0x128>(bon); bon += __shfl_xor(bon, 16); bon += __shfl_xor(bon, 32);
                if (cg == 0) { const int sidx = ci * 64 + trow; const int t = z ? (SEQ - 1 - sidx) : sidx; SBG[((size_t)z * MTOK + (size_t)b * SEQ + t) * 16 + h] = 0.5f * bon; }
#pragma unroll
                for (int j = 0; j < 8; ++j) { float y = lw[j >> 1][j & 1]; float s1 = dppf<0x111>(y); y += (tl >= 1) ? s1 : 0.f; float s2 = dppf<0x112>(y); y += (tl >= 2) ? s2 : 0.f; float s4 = dppf<0x114>(y); y += (tl >= 4) ? s4 : 0.f; lam[j] = y; }
                if (tl == 7) { LAS float* TOT = (LAS float*)(L0 + CL_TOT) + w * 64 + cg8; *(LAS f32x4*)TOT = (f32x4){lam[0], lam[1], lam[2], lam[3]}; *(LAS f32x4*)(TOT + 4) = (f32x4){lam[4], lam[5], lam[6], lam[7]}; } }
            __syncthreads();
            { f32x2 pre[4];
#pragma unroll
                for (int i = 0; i < 4; ++i) pre[i] = (f32x2){lam[2 * i], lam[2 * i + 1]};
                for (int ww = 0; ww < w; ++ww) { const LAS f32x4* TOT = (const LAS f32x4*)((const LAS float*)(L0 + CL_TOT) + ww * 64 + cg8); const f32x4 tA = TOT[0], tB = TOT[1];
                    pre[0] = pre[0] + tA.xy; pre[1] = pre[1] + tA.zw; pre[2] = pre[2] + tB.xy; pre[3] = pre[3] + tB.zw; }
                u32x4 pA, pB, pK, pR, pV; unsigned* qa = (unsigned*)&pA; unsigned* qb = (unsigned*)&pB; unsigned* qk = (unsigned*)&pK; unsigned* qr = (unsigned*)&pR; unsigned* qv = (unsigned*)&pV;
#pragma unroll
                for (int i = 0; i < 4; ++i) { const f32x2 l2 = pre[i] * 1.442695041f, m2 = (pre[i] - lw[i]) * 1.442695041f; f32x2 E, Em, Ei;
                    E.x = __builtin_amdgcn_exp2f(l2.x); E.y = __builtin_amdgcn_exp2f(l2.y); Em.x = __builtin_amdgcn_exp2f(m2.x); Em.y = __builtin_amdgcn_exp2f(m2.y); Ei.x = __builtin_amdgcn_rcpf(E.x); Ei.y = __builtin_amdgcn_rcpf(E.y);
                    const f32x2 at = av[i] * Em, bt = bv[i] * Ei, kt = xk[i] * Ei, rt = xr[i] * E;
                    qa[i] = pk2(at.x, at.y); qb[i] = pk2(bt.x, bt.y); qk[i] = pk2(kt.x, kt.y); qr[i] = pk2(rt.x, rt.y); qv[i] = pk2(xv[i].x, xv[i].y);
                    if (trow == 63) *(LAS f32x2*)(L0 + CL_GL + (cg8 + 2 * i) * 4) = E; }
                *(LAS u32x4*)(L0 + CL_AT + trow * CS_ST + cg8 * 2) = pA; *(LAS u32x4*)(L0 + CL_BT + trow * CS_ST + cg8 * 2) = pB; *(LAS u32x4*)(L0 + CL_KT + trow * CS_ST + cg8 * 2) = pK;
                *(LAS u32x4*)(L0 + CL_RT + trow * CS_ST + cg8 * 2) = pR; *(LAS u32x4*)(L0 + CL_VM + trow * CS_ST + cg8 * 2) = pV; }
            __syncthreads();
            f32x4 P[2], vk[2], pkv[2]; LAS unsigned char* TM = L0 + CL_PB1;
#define LDROW2(dst, M, row0) do { dst[0] = cs_ld_row(M, row0, 0, c16, g); dst[1] = cs_ld_row(M, row0, 1, c16, g); } while (0)
#define LDTR2(dst, M, col0) do { dst[0] = cs_ld_tr(M, col0, 0, c16, g); dst[1] = cs_ld_tr(M, col0, 1, c16, g); } while (0)
#define MM2(acc, a, b0, b1) do { acc[0] = mfma16(b0[0], a[0], acc[0]); acc[1] = mfma16(b1[0], a[0], acc[1]); acc[0] = mfma16(b0[1], a[1], acc[0]); acc[1] = mfma16(b1[1], a[1], acc[1]); } while (0)
#define SB0() __builtin_amdgcn_sched_barrier(0)
            { f32x4 nn[2], mk[2], pb[2], pkk[2]; CS_ZERO2(nn); CS_ZERO2(mk); CS_ZERO2(pb); CS_ZERO2(pkk); CS_ZERO2(vk);
                bf16x8 aA[2], aR[2], bB0[2], bB1[2], bK0[2], bK1[2], aV[2], tK0[2], tK1[2];
                LDROW2(aA, L0 + CL_AT, 16 * rb); LDROW2(aR, L0 + CL_RT, 16 * rb); LDROW2(bB0, L0 + CL_BT, 16 * cb0); LDROW2(bB1, L0 + CL_BT, 16 * cb0 + 16); LDROW2(bK0, L0 + CL_KT, 16 * cb0); LDROW2(bK1, L0 + CL_KT, 16 * cb0 + 16);
                LDTR2(aV, L0 + CL_VM, 16 * rb); LDTR2(tK0, L0 + CL_KT, 16 * cb0); LDTR2(tK1, L0 + CL_KT, 16 * cb0 + 16);
                SB0();
                MM2(nn, aA, bB0, bB1); MM2(mk, aA, bK0, bK1); MM2(pb, aR, bB0, bB1); MM2(pkk, aR, bK0, bK1); MM2(vk, aV, tK0, tK1);
#pragma unroll
                for (int q = 0; q < 2; ++q) {
#pragma unroll
                    for (int reg = 0; reg < 4; ++reg) { const int tt_ = 16 * rb + c16, ii = 16 * (cb0 + q) + 4 * g + reg; const bool lo = ii < tt_, le = ii <= tt_;
                        nn[q][reg] = lo ? nn[q][reg] : 0.f; mk[q][reg] = lo ? mk[q][reg] : 0.f; pb[q][reg] = le ? pb[q][reg] : 0.f; pkk[q][reg] = le ? pkk[q][reg] : 0.f;
                        P[q][reg] = nn[q][reg] + (ii == tt_ ? 1.0f : 0.f); }
                    cs_st(L0 + CL_XB0, rb, cb0 + q, nn[q], c16, g); cs_st(L0 + CL_PB0, rb, cb0 + q, P[q], c16, g); cs_st(L0 + CL_MK, rb, cb0 + q, mk[q], c16, g);
                    cs_st(L0 + CL_PBM, rb, cb0 + q, pb[q], c16, g); cs_st(L0 + CL_PKM, rb, cb0 + q, pkk[q], c16, g); } }
            __syncthreads();
            { f32x4 xx[2], zz[2]; CS_ZERO2(xx); CS_ZERO2(zz); CS_ZERO2(pkv);
                bf16x8 ax[2], bx0[2], bx1[2], aA[2], aM[2], aP[2], aR[2], bS0[2], bS1[2], bV0[2], bV1[2];
                LDROW2(ax, L0 + CL_XB0, 16 * rb); LDTR2(bx0, L0 + CL_XB0, 16 * cb0); LDTR2(bx1, L0 + CL_XB0, 16 * cb0 + 16);
                LDROW2(aA, L0 + CL_AT, 16 * rb); LDROW2(aM, L0 + CL_MK, 16 * rb); LDROW2(aP, L0 + CL_PKM, 16 * rb); LDROW2(aR, L0 + CL_RT, 16 * rb);
                LDROW2(bS0, L0 + CL_S, 16 * cb0); LDROW2(bS1, L0 + CL_S, 16 * cb0 + 16); LDTR2(bV0, L0 + CL_VM, 16 * cb0); LDTR2(bV1, L0 + CL_VM, 16 * cb0 + 16);
                SB0();
                MM2(xx, ax, bx0, bx1); MM2(zz, aA, bS0, bS1); MM2(zz, aM, bV0, bV1); MM2(pkv, aP, bV0, bV1); MM2(pkv, aR, bS0, bS1);
                cs_st(L0 + CL_XB1, rb, cb0, xx[0], c16, g); cs_st(L0 + CL_XB1, rb, cb0 + 1, xx[1], c16, g); cs_st(L0 + CL_Z, rb, cb0, zz[0], c16, g); cs_st(L0 + CL_Z, rb, cb0 + 1, zz[1], c16, g); }
            __syncthreads();

            CS_ISSUE(ci < 31 ? ci + 1 : 31);
#pragma unroll
            for (int j = 2; j <= 6; ++j) { LAS unsigned char* Xp = L0 + (((j - 1) & 1) ? CL_XB1 : CL_XB0); LAS unsigned char* Xn = L0 + ((j & 1) ? CL_XB1 : CL_XB0);
                LAS unsigned char* Pp = L0 + ((j & 1) ? CL_PB1 : CL_PB0); LAS unsigned char* Pn = L0 + (((j - 1) & 1) ? CL_PB1 : CL_PB0);
                bf16x8 ax[2], ap[2], bx0[2], bx1[2];
                if (j <= 5) LDROW2(ax, Xp, 16 * rb);
                LDROW2(ap, Pp, 16 * rb);
                LDTR2(bx0, Xp, 16 * cb0); LDTR2(bx1, Xp, 16 * cb0 + 16);
                SB0();
                if (j <= 5) { f32x4 xx[2]; CS_ZERO2(xx); MM2(xx, ax, bx0, bx1); cs_st(Xn, rb, cb0, xx[0], c16, g); cs_st(Xn, rb, cb0 + 1, xx[1], c16, g); }
                MM2(P, ap, bx0, bx1); cs_st(Pn, rb, cb0, P[0], c16, g); cs_st(Pn, rb, cb0 + 1, P[1], c16, g);
                __syncthreads(); }
            { f32x4 u[2]; CS_ZERO2(u);
                bf16x8 aT[2], bZ0[2], bZ1[2];
                LDROW2(aT, TM, 16 * rb); LDTR2(bZ0, L0 + CL_Z, 16 * cb0); LDTR2(bZ1, L0 + CL_Z, 16 * cb0 + 16);
                SB0();
                MM2(u, aT, bZ0, bZ1);
                cs_st(L0 + CL_U, rb, cb0, u[0], c16, g); cs_st(L0 + CL_U, rb, cb0 + 1, u[1], c16, g); }
            __syncthreads();
            { bf16x8 aPb[2], bU0[2], bU1[2], aU[2], bB0[2], bB1[2];
                LDROW2(aPb, L0 + CL_PBM, 16 * rb); LDTR2(bU0, L0 + CL_U, 16 * cb0); LDTR2(bU1, L0 + CL_U, 16 * cb0 + 16); LDTR2(aU, L0 + CL_U, 16 * rb); LDTR2(bB0, L0 + CL_BT, 16 * cb0); LDTR2(bB1, L0 + CL_BT, 16 * cb0 + 16);
                const f32x4 gl0 = *(LAS f32x4*)(L0 + CL_GL + (16 * cb0 + 4 * g) * 4), gl1 = *(LAS f32x4*)(L0 + CL_GL + (16 * cb0 + 16 + 4 * g) * 4);
                SB0();
                MM2(pkv, aPb, bU0, bU1); MM2(vk, aU, bB0, bB1);
                { const int ts = ci * 64 + 16 * rb + c16; const int tt_ = z ? (SEQ - 1 - ts) : ts; float* dst = WKV + ((size_t)z * MTOK + (size_t)b * SEQ + tt_) * RWW + h * 64 + 16 * cb0 + 4 * g;
                    *(f32x4*)dst = pkv[0]; *(f32x4*)(dst + 16) = pkv[1]; }
                sst[0] = (sst[0] + vk[0]) * gl0; sst[1] = (sst[1] + vk[1]) * gl1;
                cs_st(L0 + CL_S, rb, cb0, sst[0], c16, g); cs_st(L0 + CL_S, rb, cb0 + 1, sst[1], c16, g); }
            if (ci < 31) { CS_S0(ci + 1); }
            __syncthreads();
        }
    }
}
#ifndef PROBE_PHASE
#define PROBE_PHASE -1
#endif
#ifdef PROBE_NOBAR
#define PROBE_SEAM() __syncthreads()
#else
#define PROBE_SEAM() xcd_barrier(xbar)
#endif
#define REP(k) for (int rep_ = 0; rep_ < ((k) == PROBE_PHASE ? 2 : 1); ++rep_)
#ifndef SP2
#define SP2 true
#endif
#ifndef FP8_SP2
#define FP8_SP2 true
#endif
#ifndef ALIGN_EPI
#define ALIGN_EPI true
#endif
__global__ void __launch_bounds__(NTHR, 2) fwd_kernel(Args args) {
    extern __shared__ __attribute__((aligned(16))) unsigned char lds_raw[];
    cg::grid_group grid = cg::this_grid();
    LAS unsigned char* lds = (LAS unsigned char*)lds_raw;
#define MKFRAME() Frame F; { int t_ = threadIdx.x; asm volatile("" : "+v"(t_)); unsigned char* w_ = args.ws; asm volatile("" : "+s"(w_)); \
    F.lds = lds_raw; F.tid = t_; F.lane = t_ & 63; F.wave = __builtin_amdgcn_readfirstlane(t_ >> 6); F.G = gridDim.x; F.c = blockIdx.x; F.in = args.in; F.out = gptr(args.out); F.ws = (GAS unsigned char*)w_; } \
    GAS unsigned char* ws = F.ws; (void)ws
    if (args.out == nullptr) grid.sync();
    { volatile LAS unsigned* st = (volatile LAS unsigned*)(lds + LDS_BYTES - 16); if (threadIdx.x < 4) st[threadIdx.x] = 0u; }
    __syncthreads();
    const XcdBarrier xbar = xcd_barrier_post((unsigned*)(args.ws + WS_CTL), (volatile LAS unsigned*)(lds + LDS_BYTES - 16));
#if !defined(ONLY) || ONLY==0
    REP(0) { if (rep_) { __syncthreads(); } MKFRAME(); p0_prologue(F, lds); }
#endif
    xcd_barrier(xbar);
#if !defined(ONLY) || ONLY==1
    REP(1) { if (rep_) xcd_barrier(xbar);
    { MKFRAME();
      const bool even = (F.G == 256);
      { pg8::Gemm g{(const pg8::bf16_t*)(ws + WS_HQ), (const pg8::bf16_t*)(ws + WS_WINQ), MTOK, 3072, DM / 2}; pg8::SplitOrder S; S.init3(MTOK, 3072, F.G, F.c, even ? 2 : (1 << 20), even ? 2 : 0, 128, 256);
        pg8::EpiStoreBf16 E{(pg8::bf16_t*)(ws + WS_PROJ), LDP};
        pg8::gemm_phase<pg8::EpiStoreBf16, pg8::SplitOrder, ALIGN_EPI, FP8_SP2, true, 0x7A7A7A7A>(lds, g, S, E); }
      { pg8::Gemm g{(const pg8::bf16_t*)(ws + WS_H), (const pg8::bf16_t*)(ws + WS_WIN) + (size_t)3072 * DM, MTOK, 3584, DM}; pg8::SplitOrder S; S.init3(MTOK, 3584, F.G, F.c, even ? 3 : (1 << 20), even ? 1 : 0, 0, 128);
        pg8::EpiStoreBf16 E{(pg8::bf16_t*)(ws + WS_PROJ) + 3072, LDP};
        pg8::gemm_phase<pg8::EpiStoreBf16, pg8::SplitOrder, ALIGN_EPI, SP2>(lds, g, S, E); } } }
#endif
    xcd_barrier(xbar);
#if !defined(ONLY) || ONLY==2
    REP(2) { if (rep_) { PROBE_SEAM(); } MKFRAME(); na_phase(F, lds); }
#endif
#if !defined(ONLY) || ONLY==3
    REP(3) { if (rep_) { PROBE_SEAM(); } MKFRAME(); scan_phase2(F, lds); }
#endif
    xcd_barrier(xbar);
#if !defined(ONLY) || ONLY==4
    REP(4) { if (rep_) { PROBE_SEAM(); } MKFRAME(); post_phase(F, lds); }
#endif
    xcd_barrier(xbar);
#if !defined(ONLY) || ONLY==5
    REP(5) { if (rep_) xcd_barrier(xbar);
    { MKFRAME(); pg8::Gemm g{(const pg8::bf16_t*)(ws + WS_MIX), (const pg8::bf16_t*)(ws + WS_WOUT), MTOK, DM, DM}; pg8::StaticOrder S; S.init(MTOK, DM, F.G, F.c);
      pg8::EpiResBf16 E{gptr(args.in[0]), (pg8::bf16_t*)(ws + WS_X2), DM};
      pg8::gemm_phase<pg8::EpiResBf16, pg8::StaticOrder, ALIGN_EPI, SP2>(lds, g, S, E); } }
#endif
    xcd_barrier(xbar);
#if !defined(ONLY) || ONLY==6
    REP(6) { if (rep_) xcd_barrier(xbar); MKFRAME(); norm2_router_phase(F, lds); }
#endif
    xcd_barrier(xbar);
#if !defined(ONLY) || ONLY==7
    REP(7) { if (rep_) xcd_barrier(xbar); MKFRAME(); topk_gather_phase(F, lds); }
#endif
    xcd_barrier(xbar);
#if !defined(ONLY) || ONLY==8
    REP(8) { if (rep_) xcd_barrier(xbar);
    { MKFRAME(); pg8::Gemm g{(const pg8::bf16_t*)(ws + WS_XE), (const pg8::bf16_t*)(ws + WS_WGU), MEXP, 4096, DM / 2}; pg8::MoeOrder S; S.init2(16, F.G, F.c);
      pg8::EpiSwiGLU E{(unsigned char*)(ws + WS_HID)};
      pg8::gemm_phase<pg8::EpiSwiGLU, pg8::MoeOrder, ALIGN_EPI, FP8_SP2, true, 0x7A7A7A7A>(lds, g, S, E); } }
#endif
    xcd_barrier(xbar);
#if !defined(ONLY) || ONLY==9
    REP(9) { if (rep_) xcd_barrier(xbar);
    { MKFRAME(); pg8::Gemm g{(const pg8::bf16_t*)(ws + WS_HID), (const pg8::bf16_t*)(ws + WS_WD), MEXP, 2048, FF / 2}; pg8::MoeOrder S; S.init2(8, F.G, F.c);
      pg8::EpiDownScale E{(pg8::bf16_t*)(ws + WS_XE), (const float*)(ws + WS_GATE)};
      pg8::gemm_phase<pg8::EpiDownScale, pg8::MoeOrder, ALIGN_EPI, FP8_SP2, true, 0x7A7A7A7A>(lds, g, S, E); } }
#endif
    xcd_barrier(xbar);
#ifdef PROBE_BARRIERS
    for (int pb_ = 0; pb_ < PROBE_BARRIERS; ++pb_) xcd_barrier(xbar);
#endif
#if !defined(ONLY) || ONLY==10
    { MKFRAME(); combine_phase(F); }
#endif
}

extern "C" void kernel_launch(void* const* d_in, const int* in_sizes, int n_in, void* d_out, int out_size, void* d_ws, size_t ws_size, hipStream_t stream) {
    static int grid = 0;
    if (grid == 0) {
        if (n_in != 24 || out_size != MTOK * DM || ws_size < WS_END) { fprintf(stderr, "kernel_launch: unexpected shapes (n_in %d, out %d, ws %zu)\n", n_in, out_size, ws_size); grid = -1; return; }
        int dev = 0, cus = 0, per_cu = 0;
        if (hipGetDevice(&dev) != hipSuccess || hipDeviceGetAttribute(&cus, hipDeviceAttributeMultiprocessorCount, dev) != hipSuccess) { grid = -1; return; }
        if (hipFuncSetAttribute((const void*)fwd_kernel, hipFuncAttributeMaxDynamicSharedMemorySize, LDS_BYTES) != hipSuccess) { fprintf(stderr, "kernel_launch: hipFuncSetAttribute failed\n"); grid = -1; return; }
        if (hipOccupancyMaxActiveBlocksPerMultiprocessor(&per_cu, (const void*)fwd_kernel, NTHR, LDS_BYTES) != hipSuccess || per_cu < 1) { fprintf(stderr, "kernel_launch: occupancy query failed (%d)\n", per_cu); (void)hipGetLastError(); per_cu = 1; }
        grid = cus * per_cu;
    }
    if (grid < 0) return;
    if (hipMemsetAsync((char*)d_ws + WS_CTL, 0, 65536, stream) != hipSuccess) { fprintf(stderr, "kernel_launch: memset failed\n"); return; }
    Args a{};
    for (int i = 0; i < 24; ++i) a.in[i] = (const float*)d_in[i];
    a.out = (float*)d_out; a.ws = (unsigned char*)d_ws;
    void* kargs[] = {&a};
    hipError_t e = hipLaunchCooperativeKernel((const void*)fwd_kernel, dim3(grid), dim3(NTHR), kargs, LDS_BYTES, stream);
    if (e != hipSuccess) fprintf(stderr, "kernel_launch: cooperative launch failed: %s (grid %d)\n", hipGetErrorString(e), grid);
}
```

```cpp
#include <hip/hip_runtime.h>
#include <hip/hip_cooperative_groups.h>
#include <cstdio>
#include <cstdint>
namespace cg = cooperative_groups;

namespace pg8 {
#define PG8_LAS __attribute__((address_space(3)))
typedef unsigned short bf16_t;
typedef short bf16x8 __attribute__((ext_vector_type(8)));
typedef float f32x4 __attribute__((ext_vector_type(4)));
typedef unsigned u32x4 __attribute__((ext_vector_type(4)));
constexpr int BM = 256, BK = 64, HALF = 128, HTB = HALF * BK * 2  , STAGE_BYTES = 8 * HTB, NXCD = 8, WGM = 8;

__host__ __device__ __forceinline__ int lds_byte(int r, int c) { const int st = (r >> 4) * 2 + (c >> 5), rr = r & 15, cc = c & 31, ob = rr * 64 + cc * 2; return st * 1024 + (ob ^ (((ob >> 9) & 1) << 5)); }
__host__ __device__ __forceinline__ void stage_rc(int b, int& R, int& C) { const int st = b / 1024, sb = b % 1024, swz = sb ^ (((sb >> 9) & 1) << 5); R = (st >> 1) * 16 + swz / 64; C = (st & 1) * 32 + (swz % 64) / 2; }
__host__ __device__ __forceinline__ int perm32(int rho) { const int n = rho >> 4, i = rho & 15; return 8 * (i >> 2) + 4 * n + (i & 3); }

struct Unit { int pm, pn; };
struct Gemm { const bf16_t* A; const bf16_t* Bt; int M, N, K; };

struct StaticOrder {
    int nM, nN, nwg, G, c;
    __host__ __device__ void init(int M, int N, int G_, int c_) { nM = M / BM; nN = N / BM; nwg = nM * nN; G = G_; c = c_; }
    __host__ __device__ bool next(int i, Unit& u) const {
        const long L = (long)i * G + c; if (L >= nwg) return false;
        int wgid = (int)L; { const int q = nwg / NXCD, r = nwg % NXCD, xcd = wgid % NXCD, off = wgid / NXCD; wgid = (xcd < r ? xcd * (q + 1) : r * (q + 1) + (xcd - r) * q) + off; }
        const int nig = WGM * nN, gid = wgid / nig, fm = gid * WGM, gsz = (nM - fm) < WGM ? (nM - fm) : WGM;
        u.pm = fm + ((wgid % nig) % gsz); u.pn = (wgid % nig) / gsz; return true;
    }
    __device__ __forceinline__ void a_ready(const Unit&) const {}
    __device__ __forceinline__ void done(const Unit&) const {}
};

__device__ __forceinline__ unsigned cvt_pk_bf16(float lo, float hi) { unsigned r; asm volatile("v_cvt_pk_bf16_f32 %0, %1, %2" : "=v"(r) : "v"(lo), "v"(hi)); return r; }

struct EpiStoreBf16 {
    static constexpr bool PERM = true, AFTER_DRAIN = false;
    bf16_t* O; int ldc;
    __device__ __forceinline__ void operator()(const f32x4 (&acc)[2][2][4][2], const Unit& u, int wr, int wc, int fr, int fq) const {
        const int row0 = u.pm * BM + wr * 64 + fr, col0 = u.pn * BM + wc * 32 + 8 * fq;
#pragma unroll
        for (int ai = 0; ai < 2; ++ai)
#pragma unroll
            for (int m = 0; m < 4; ++m) { bf16_t* rowp = O + (size_t)(row0 + ai * HALF + m * 16) * ldc + col0;
#pragma unroll
                for (int bj = 0; bj < 2; ++bj) { const f32x4 v0 = acc[ai][bj][m][0], v1 = acc[ai][bj][m][1];
                    u32x4 w; w.x = cvt_pk_bf16(v0[0], v0[1]); w.y = cvt_pk_bf16(v0[2], v0[3]); w.z = cvt_pk_bf16(v1[0], v1[1]); w.w = cvt_pk_bf16(v1[2], v1[3]);
                    *(u32x4*)(rowp + bj * HALF) = w; } }
    }
};
struct EpiResF32 {
    static constexpr bool PERM = false, AFTER_DRAIN = false;
    const float* base; float* out; int ldc;
    __device__ __forceinline__ void operator()(const f32x4 (&acc)[2][2][4][2], const Unit& u, int wr, int wc, int fr, int fq) const {
        const int row0 = u.pm * BM + wr * 64 + fr, col0 = u.pn * BM + wc * 32 + 4 * fq;
#pragma unroll
        for (int ai = 0; ai < 2; ++ai)
#pragma unroll
            for (int m = 0; m < 4; ++m) { const size_t off = (size_t)(row0 + ai * HALF + m * 16) * ldc + col0;
#pragma unroll
                for (int bj = 0; bj < 2; ++bj)
#pragma unroll
                    for (int n = 0; n < 2; ++n) { const f32x4 b = *(const f32x4*)(base + off + bj * HALF + n * 16); *(f32x4*)(out + off + bj * HALF + n * 16) = b + acc[ai][bj][m][n]; } }
    }
};
struct EpiResBf16 {
    static constexpr bool PERM = true, AFTER_DRAIN = false;
    const float* base; bf16_t* out; int ldc;
    __device__ __forceinline__ void operator()(const f32x4 (&acc)[2][2][4][2], const Unit& u, int wr, int wc, int fr, int fq) const {
        const int row0 = u.pm * BM + wr * 64 + fr, col0 = u.pn * BM + wc * 32 + 8 * fq;
#pragma unroll
        for (int ai = 0; ai < 2; ++ai)
#pragma unroll
            for (int m = 0; m < 4; ++m) { const size_t off = (size_t)(row0 + ai * HALF + m * 16) * ldc + col0;
#pragma unroll
                for (int bj = 0; bj < 2; ++bj) { const f32x4 v0 = __builtin_nontemporal_load((const f32x4*)(base + off + bj * HALF)) + acc[ai][bj][m][0], v1 = __builtin_nontemporal_load((const f32x4*)(base + off + bj * HALF + 4)) + acc[ai][bj][m][1];
                    u32x4 w; w.x = cvt_pk_bf16(v0[0], v0[1]); w.y = cvt_pk_bf16(v0[2], v0[3]); w.z = cvt_pk_bf16(v1[0], v1[1]); w.w = cvt_pk_bf16(v1[2], v1[3]);
                    *(u32x4*)(out + off + bj * HALF) = w; } }
    }
};
struct EpiSwiGLU {
    static constexpr bool PERM = true, AFTER_DRAIN = false;
    unsigned char* O;
    __device__ __forceinline__ void operator()(const f32x4 (&acc)[2][2][4][2], const Unit& u, int wr, int wc, int fr, int fq) const {
        const int row0 = u.pm * BM + wr * 64 + fr, col0 = (u.pn & 15) * HALF + wc * 32 + 8 * fq;
#pragma unroll
        for (int ai = 0; ai < 2; ++ai)
#pragma unroll
            for (int m = 0; m < 4; ++m) { unsigned char* rowp = O + (size_t)(row0 + ai * HALF + m * 16) * 2048 + col0;
                float h[8];
#pragma unroll
                for (int n = 0; n < 2; ++n)
#pragma unroll
                    for (int j = 0; j < 4; ++j) { const float gt = acc[ai][0][m][n][j], up = acc[ai][1][m][n][j];
                        h[n * 4 + j] = gt * __builtin_amdgcn_rcpf(1.0f + __expf(-gt)) * up; }
                int p0 = __builtin_amdgcn_cvt_pk_fp8_f32(h[0], h[1], 0, false); p0 = __builtin_amdgcn_cvt_pk_fp8_f32(h[2], h[3], p0, true);
                int p1 = __builtin_amdgcn_cvt_pk_fp8_f32(h[4], h[5], 0, false); p1 = __builtin_amdgcn_cvt_pk_fp8_f32(h[6], h[7], p1, true);
                typedef int i32x2 __attribute__((ext_vector_type(2))); *(i32x2*)rowp = (i32x2){p0, p1}; }
    }
};
struct EpiDownScale {
    static constexpr bool PERM = true, AFTER_DRAIN = false;
    bf16_t* O; const float* gate;
    __device__ __forceinline__ void operator()(const f32x4 (&acc)[2][2][4][2], const Unit& u, int wr, int wc, int fr, int fq) const {
        const int row0 = u.pm * BM + wr * 64 + fr, col0 = (u.pn & 7) * BM + wc * 32 + 8 * fq;
#pragma unroll
        for (int ai = 0; ai < 2; ++ai)
#pragma unroll
            for (int m = 0; m < 4; ++m) { const int row = row0 + ai * HALF + m * 16; const float gs = gate[row]; bf16_t* rowp = O + (size_t)row * 2048 + col0;
#pragma unroll
                for (int bj = 0; bj < 2; ++bj) { const f32x4 v0 = acc[ai][bj][m][0] * gs, v1 = acc[ai][bj][m][1] * gs;
                    u32x4 w; w.x = cvt_pk_bf16(v0[0], v0[1]); w.y = cvt_pk_bf16(v0[2], v0[3]); w.z = cvt_pk_bf16(v1[0], v1[1]); w.w = cvt_pk_bf16(v1[2], v1[3]);
                    *(u32x4*)(rowp + bj * HALF) = w; } }
    }
};
struct MoeOrder : StaticOrder {
    int nNl;
    __device__ void init2(int nNl_, int G_, int c_) { nNl = nNl_; init(32768, nNl_ * BM, G_, c_); }
    __device__ bool next(int i, Unit& u) const { if (!StaticOrder::next(i, u)) return false; u.pn += (u.pm >> 3) * nNl; return true; }
};

struct SplitOrder : StaticOrder {
    int full_rounds, xrounds, xlo, xhi;
    __device__ void init3(int M, int N, int G_, int c_, int fr_, int xr_, int xlo_, int xhi_) { init(M, N, G_, c_); full_rounds = fr_; xrounds = xr_; xlo = xlo_; xhi = xhi_; }
    __device__ bool next(int i, Unit& u) const {
        long L;
        if (i < full_rounds) L = (long)i * G + c;
        else { const int j = i - full_rounds; if (j >= xrounds || c < xlo || c >= xhi) return false; L = (long)full_rounds * G + (long)j * (xhi - xlo) + (c - xlo); }
        if (L >= nwg) return false;
        int wgid = (int)L; { const int q = nwg / NXCD, r = nwg % NXCD, xcd = wgid % NXCD, off = wgid / NXCD; wgid = (xcd < r ? xcd * (q + 1) : r * (q + 1) + (xcd - r) * q) + off; }
        const int nig = WGM * nN, gid = wgid / nig, fm = gid * WGM, gsz = (nM - fm) < WGM ? (nM - fm) : WGM;
        u.pm = fm + ((wgid % nig) % gsz); u.pn = (wgid % nig) / gsz; return true;
    }
};
template <class Epi, class Sched, bool ALIGN_EPI = false, bool SP2 = false, bool FP8 = false, int WSC = 0x7F7F7F7F>
__device__ __forceinline__ void gemm_phase(PG8_LAS unsigned char* lds, const Gemm g, const Sched& S, const Epi& E) {
    int tid_ = threadIdx.x; asm volatile("" : "+v"(tid_));
    const int tid = tid_, wid = __builtin_amdgcn_readfirstlane(tid >> 6), lane = tid & 63, wr = wid >> 2, wc = wid & 3, fr = lane & 15, fq = lane >> 4;
    const int K = g.K, nt = K / BK;
    unsigned voffA[2], voffB[2];
#pragma unroll
    for (int i = 0; i < 2; ++i) { int R, C; stage_rc(tid * 16 + i * 8192, R, C); const int Rb = Epi::PERM ? ((R & ~31) + perm32(R & 31)) : R;
        voffA[i] = (unsigned)(R * K + C) * 2u; voffB[i] = (unsigned)(Rb * K + C) * 2u; }
    const size_t kstep = (size_t)(BK * 2);
    const size_t hstep = (size_t)HALF * K * 2;
    const size_t tstep = 2 * hstep;
    const unsigned ldsw = (unsigned)wid * 1024u;
    const int aoff = lds_byte(wr * 64 + fr, fq * 8), boff = lds_byte(wc * 32 + fr, fq * 8);
typedef int pg8_v8i __attribute__((ext_vector_type(8))); typedef short pg8_s16 __attribute__((ext_vector_type(16)));
#define PG8_CAT(lo, hi) __builtin_bit_cast(pg8_v8i, __builtin_shufflevector(lo, hi, 0, 1, 2, 3, 4, 5, 6, 7, 8, 9, 10, 11, 12, 13, 14, 15))
#define PG8_SA(b, h) (((b) * 2 + (h)) * HTB)
#define PG8_SB(b, h) ((4 + (b) * 2 + (h)) * HTB)
#define PG8_STAGE(bufoff, gbase, voff) do { _Pragma("unroll") for (int _i = 0; _i < 2; ++_i) \
        __builtin_amdgcn_global_load_lds((const unsigned*)((const char*)(gbase) + (voff)[_i]), (PG8_LAS unsigned*)(lds + (bufoff) + ldsw + _i * 8192), 16, 0, 0); } while (0)
#define PG8_LDA(dst, b, h) do { if constexpr (FP8) { _Pragma("unroll") for (int m = 0; m < 4; ++m) { const bf16x8 lo_ = *(const PG8_LAS bf16x8*)(lds + PG8_SA(b, h) + aoff + m * 2048), hi_ = *(const PG8_LAS bf16x8*)(lds + PG8_SA(b, h) + aoff + m * 2048 + 1024); dst##8[m] = PG8_CAT(lo_, hi_); } } \
        else { _Pragma("unroll") for (int m = 0; m < 4; ++m) _Pragma("unroll") for (int k = 0; k < 2; ++k) dst[m][k] = *(const PG8_LAS bf16x8*)(lds + PG8_SA(b, h) + aoff + m * 2048 + k * 1024); } } while (0)
#define PG8_LDB(dst, b, h) do { if constexpr (FP8) { _Pragma("unroll") for (int n = 0; n < 2; ++n) { const bf16x8 lo_ = *(const PG8_LAS bf16x8*)(lds + PG8_SB(b, h) + boff + n * 2048), hi_ = *(const PG8_LAS bf16x8*)(lds + PG8_SB(b, h) + boff + n * 2048 + 1024); dst##8[n] = PG8_CAT(lo_, hi_); } } \
        else { _Pragma("unroll") for (int n = 0; n < 2; ++n) _Pragma("unroll") for (int k = 0; k < 2; ++k) dst[n][k] = *(const PG8_LAS bf16x8*)(lds + PG8_SB(b, h) + boff + n * 2048 + k * 1024); } } while (0)
#define PG8_MMA(ai, bj, At, Bt) do { __builtin_amdgcn_s_setprio(1); \
        if constexpr (FP8) { _Pragma("unroll") for (int m = 0; m < 4; ++m) _Pragma("unroll") for (int n = 0; n < 2; ++n) \
            asm volatile("v_mfma_scale_f32_16x16x128_f8f6f4 %0, %1, %2, %0, %3, %4 op_sel_hi:[0,0,0]" : "+v"(acc[ai][bj][m][n]) : "v"(Bt##8[n]), "v"(At##8[m]), "v"(fp8_wsc), "v"(fp8_one)); }     \
        else { _Pragma("unroll") for (int m = 0; m < 4; ++m) _Pragma("unroll") for (int n = 0; n < 2; ++n) _Pragma("unroll") for (int k = 0; k < 2; ++k) \
            acc[ai][bj][m][n] = __builtin_amdgcn_mfma_f32_16x16x32_bf16(Bt[n][k], At[m][k], acc[ai][bj][m][n], 0, 0, 0); } \
        __builtin_amdgcn_s_setprio(0); } while (0)
#define PG8_WAIT_V(n) asm volatile("s_waitcnt vmcnt(" #n ")" ::: "memory")
#define PG8_WAIT_L(n) asm volatile("s_waitcnt lgkmcnt(" #n ")" ::: "memory")
#define PG8_BAR __builtin_amdgcn_s_barrier()
#define PG8_SCHED __builtin_amdgcn_sched_barrier(0)
    Unit cur, nxt; int ui = 0;
    if (!S.next(0, cur)) return;
    f32x4 acc[2][2][4][2];
#pragma unroll
    for (int a = 0; a < 2; ++a)
#pragma unroll
        for (int b = 0; b < 2; ++b)
#pragma unroll
            for (int m = 0; m < 4; ++m)
#pragma unroll
                for (int n = 0; n < 2; ++n) acc[a][b][m][n] = (f32x4){0.f, 0.f, 0.f, 0.f};
    int fp8_wsc = WSC, fp8_one = 0x7F7F7F7F; if constexpr (FP8) asm volatile("" : "+v"(fp8_wsc), "+v"(fp8_one));
    bf16x8 At[4][2], B0[2][2], B1[2][2]; pg8_v8i At8[4], B08[2], B18[2];
    const char* cA = (const char*)g.A + (size_t)cur.pm * tstep; const char* cB = (const char*)g.Bt + (size_t)cur.pn * tstep;
    S.a_ready(cur);
    if constexpr (SP2) {
        PG8_STAGE(PG8_SB(0, 0), cB, voffB); PG8_STAGE(PG8_SB(0, 1), cB + hstep, voffB); PG8_STAGE(PG8_SA(0, 0), cA, voffA); PG8_STAGE(PG8_SA(0, 1), cA + hstep, voffA);
        if (wr == 1) PG8_BAR;
        PG8_WAIT_V(2); PG8_BAR;
        PG8_STAGE(PG8_SB(1, 0), cB + kstep, voffB); PG8_STAGE(PG8_SA(1, 0), cA + kstep, voffA); PG8_STAGE(PG8_SB(1, 1), cB + hstep + kstep, voffB);
        PG8_WAIT_V(6); PG8_BAR;
    } else {
        PG8_STAGE(PG8_SB(0, 0), cB, voffB); PG8_STAGE(PG8_SA(0, 0), cA, voffA); PG8_STAGE(PG8_SB(0, 1), cB + hstep, voffB); PG8_STAGE(PG8_SA(0, 1), cA + hstep, voffA);
        if (wr == 1) PG8_BAR;
        PG8_WAIT_V(4); PG8_BAR;
        PG8_STAGE(PG8_SB(1, 0), cB + kstep, voffB); PG8_STAGE(PG8_SA(1, 0), cA + kstep, voffA); PG8_STAGE(PG8_SB(1, 1), cB + hstep + kstep, voffB);
        PG8_WAIT_V(6); PG8_BAR;
    }
    for (;;) {
        const bool has_next = S.next(ui + 1, nxt);
        const char* nA = has_next ? (const char*)g.A + (size_t)nxt.pm * tstep : cA; const char* nB = has_next ? (const char*)g.Bt + (size_t)nxt.pn * tstep : cB;
        for (int t = 0; t < nt; t += 2) {
            const bool last = (t == nt - 2);
            const char* a1 = cA + (size_t)(t + 1) * kstep;
            const char* a2 = last ? nA : cA + (size_t)(t + 2) * kstep; const char* b2 = last ? nB : cB + (size_t)(t + 2) * kstep;
            const char* a3 = a2 + kstep; const char* b3 = b2 + kstep;
            if (last && has_next) S.a_ready(nxt);
            if constexpr (SP2) {
            PG8_LDB(B0, 0, 0); PG8_LDB(B1, 0, 1); PG8_SCHED; PG8_LDA(At, 0, 0); PG8_STAGE(PG8_SA(1, 1), a1 + hstep, voffA);
            PG8_WAIT_V(8); PG8_WAIT_L(0); PG8_BAR; PG8_MMA(0, 0, At, B0); PG8_MMA(0, 1, At, B1); PG8_BAR; PG8_SCHED;
            PG8_LDA(At, 0, 1); PG8_STAGE(PG8_SB(0, 0), b2, voffB); PG8_STAGE(PG8_SB(0, 1), b2 + hstep, voffB); PG8_STAGE(PG8_SA(0, 0), a2, voffA);
            PG8_WAIT_V(8); PG8_WAIT_L(0); PG8_BAR; PG8_MMA(1, 0, At, B0); PG8_MMA(1, 1, At, B1); PG8_BAR; PG8_SCHED;
            PG8_LDB(B0, 1, 0); PG8_LDB(B1, 1, 1); PG8_SCHED; PG8_LDA(At, 1, 0); PG8_STAGE(PG8_SA(0, 1), a2 + hstep, voffA);
            PG8_WAIT_V(8); PG8_WAIT_L(0); PG8_BAR; PG8_MMA(0, 0, At, B0); PG8_MMA(0, 1, At, B1); PG8_BAR; PG8_SCHED;
            PG8_LDA(At, 1, 1); PG8_STAGE(PG8_SB(1, 0), b3, voffB); PG8_STAGE(PG8_SB(1, 1), b3 + hstep, voffB); PG8_STAGE(PG8_SA(1, 0), a3, voffA);
            PG8_WAIT_V(8); PG8_WAIT_L(0); PG8_BAR; PG8_MMA(1, 0, At, B0); PG8_MMA(1, 1, At, B1); PG8_BAR; PG8_SCHED;
            } else {
            PG8_LDB(B0, 0, 0); PG8_SCHED; PG8_LDA(At, 0, 0); PG8_STAGE(PG8_SA(1, 1), a1 + hstep, voffA);
            PG8_WAIT_L(8); PG8_BAR; PG8_WAIT_L(0); PG8_MMA(0, 0, At, B0); PG8_BAR; PG8_SCHED;
            PG8_LDB(B1, 0, 1); PG8_STAGE(PG8_SB(0, 0), b2, voffB);
            PG8_BAR; PG8_WAIT_L(0); PG8_MMA(0, 1, At, B1); PG8_BAR;
            PG8_LDA(At, 0, 1); PG8_STAGE(PG8_SA(0, 0), a2, voffA);
            PG8_BAR; PG8_WAIT_L(0); PG8_MMA(1, 0, At, B0); PG8_BAR; PG8_SCHED;
            PG8_STAGE(PG8_SB(0, 1), b2 + hstep, voffB);
            PG8_WAIT_V(6); PG8_BAR; PG8_MMA(1, 1, At, B1); PG8_BAR;
            PG8_LDB(B0, 1, 0); PG8_SCHED; PG8_LDA(At, 1, 0); PG8_STAGE(PG8_SA(0, 1), a2 + hstep, voffA);
            PG8_WAIT_L(8); PG8_BAR; PG8_WAIT_L(0); PG8_MMA(0, 0, At, B0); PG8_BAR; PG8_SCHED;
            PG8_LDB(B1, 1, 1); PG8_STAGE(PG8_SB(1, 0), b3, voffB);
            PG8_BAR; PG8_WAIT_L(0); PG8_MMA(0, 1, At, B1); PG8_BAR;
            PG8_LDA(At, 1, 1); PG8_STAGE(PG8_SA(1, 0), a3, voffA);
            PG8_BAR; PG8_WAIT_L(0); PG8_MMA(1, 0, At, B0); PG8_BAR; PG8_SCHED;
            PG8_STAGE(PG8_SB(1, 1), b3 + hstep, voffB);
            PG8_WAIT_V(6); PG8_BAR; PG8_MMA(1, 1, At, B1); PG8_BAR;
            }
        }
        if constexpr (ALIGN_EPI) { if (wr == 0) PG8_BAR; }
        if constexpr (FP8) asm volatile("s_nop 15\n\ts_nop 15" ::: "memory");
        if constexpr (!Epi::AFTER_DRAIN) { E(acc, cur, wr, wc, fr, fq); S.done(cur); }
        if (!has_next) break;
#pragma unroll
        for (int a = 0; a < 2; ++a)
#pragma unroll
            for (int b = 0; b < 2; ++b)
#pragma unroll
                for (int m = 0; m < 4; ++m)
#pragma unroll
                    for (int n = 0; n < 2; ++n) acc[a][b][m][n] = (f32x4){0.f, 0.f, 0.f, 0.f};
        cur = nxt; cA = nA; cB = nB; ++ui;
        if constexpr (ALIGN_EPI) { if (wr == 1) PG8_BAR; }
    }
    PG8_WAIT_V(0);
    if constexpr (!ALIGN_EPI) { if (wr == 0) PG8_BAR; }
    PG8_BAR;
    if constexpr (Epi::AFTER_DRAIN) { E.fused(acc, cur, wr, wc, fr, fq, lds, wid, lane); S.done(cur); }
#undef PG8_SA
#undef PG8_SB
#undef PG8_STAGE
#undef PG8_LDA
#undef PG8_LDB
#undef PG8_MMA
#undef PG8_CAT
#undef PG8_WAIT_V
#undef PG8_WAIT_L
#undef PG8_BAR
#undef PG8_SCHED
}
}
constexpr int DM = 2048, NB = 8, SEQ = 2048, MTOK = NB * SEQ;
constexpr int HD = 64, NAW = 1024, RWW = 1024, NHEAD = 16;
constexpr int RWP = 3488, INP = 6560, LDP = 6656;
constexpr int NE = 16, CAP = 256, FF = 2048, MEXP = NE * NB * CAP;
constexpr int GLORA = 160;
constexpr int PC_Q = 0, PC_K = 1024, PC_V = 2048, PC_RW = 3072;

constexpr size_t MiB = 1u << 20;
constexpr size_t WS_CTL = 0, CTL_ZERO_BYTES = 1 * MiB;
constexpr size_t WS_WIN = 2 * MiB;
constexpr size_t WS_WOUT = 28 * MiB;
constexpr size_t WS_G2T = 36 * MiB;
constexpr size_t WS_WGU = 38 * MiB;
constexpr size_t WS_WD = 294 * MiB;
constexpr size_t WS_H = 422 * MiB;
constexpr size_t WS_PROJ = 486 * MiB;
constexpr size_t WS_MIX = 694 * MiB;
constexpr size_t WS_WKV = 758 * MiB;
constexpr size_t WS_SB = 886 * MiB;
constexpr size_t WS_AFF = 888 * MiB;
constexpr size_t WS_GATE = 889 * MiB;
constexpr size_t WS_TOKSLOT = 890 * MiB;
constexpr size_t WS_WINQ = 892 * MiB;
constexpr size_t WS_HQ = 898 * MiB;
constexpr size_t WS_X2 = 930 * MiB;
constexpr size_t WS_END = 994 * MiB;
constexpr size_t WS_XE = WS_PROJ;
constexpr size_t WS_HID = 614 * MiB;
static_assert(WS_HID + 128 * MiB <= WS_WKV && WS_XE + 128 * MiB <= WS_HID, "overlay map");

constexpr int NWAVES = 8, NTHR = 512;
constexpr int LDS_BYTES = 163840;

#define LAS __attribute__((address_space(3)))
#define GAS __attribute__((address_space(1)))
typedef unsigned short bf16;
typedef float f32x4 __attribute__((ext_vector_type(4)));
typedef float f32x2 __attribute__((ext_vector_type(2)));
typedef short bf16x8 __attribute__((ext_vector_type(8)));
typedef short s16x4 __attribute__((ext_vector_type(4)));
typedef unsigned u32x4 __attribute__((ext_vector_type(4)));
typedef unsigned u32x2 __attribute__((ext_vector_type(2)));
#define LDS_WAIT() asm volatile("s_waitcnt lgkmcnt(0)" ::: "memory")

__device__ __forceinline__ unsigned f2bf(float f) { unsigned u = __builtin_bit_cast(unsigned, f); return (u + 0x7fffu + ((u >> 16) & 1u)) >> 16; }
typedef __bf16 bf16x2_t __attribute__((ext_vector_type(2)));
__device__ __forceinline__ unsigned pk2(float lo, float hi) { const f32x2 v = {lo, hi}; const bf16x2_t b = __builtin_convertvector(v, bf16x2_t); return __builtin_bit_cast(unsigned, b); }
__device__ __forceinline__ float bflo(unsigned u) { return __builtin_bit_cast(float, u << 16); }
__device__ __forceinline__ float bfhi(unsigned u) { return __builtin_bit_cast(float, u & 0xffff0000u); }
__device__ __forceinline__ float bf2f(unsigned short b) { return __builtin_bit_cast(float, (unsigned)b << 16); }
__device__ __forceinline__ void unpack8(const u32x4 v, float* f) { f[0] = bflo(v.x); f[1] = bfhi(v.x); f[2] = bflo(v.y); f[3] = bfhi(v.y); f[4] = bflo(v.z); f[5] = bfhi(v.z); f[6] = bflo(v.w); f[7] = bfhi(v.w); }
__device__ __forceinline__ void unpack8v(const u32x4 v, f32x2* f) { f[0] = (f32x2){bflo(v.x), bfhi(v.x)}; f[1] = (f32x2){bflo(v.y), bfhi(v.y)}; f[2] = (f32x2){bflo(v.z), bfhi(v.z)}; f[3] = (f32x2){bflo(v.w), bfhi(v.w)}; }
__device__ __forceinline__ float sigmoidf_(float x) { return __builtin_amdgcn_rcpf(1.0f + __expf(-x)); }
template <int CTRL> __device__ __forceinline__ float dppf(float x) { return __builtin_bit_cast(float, __builtin_amdgcn_update_dpp(0, __builtin_bit_cast(int, x), CTRL, 0xF, 0xF, true)); }
__device__ __forceinline__ float red8(float x) { x += dppf<0xB1>(x); x += dppf<0x4E>(x); x += dppf<0x141>(x); return x; }
__device__ __forceinline__ float wave_sum(float v) {
#pragma unroll
    for (int o = 1; o < 64; o <<= 1) v += __shfl_xor(v, o);
    return v;
}

template <class T> __device__ __forceinline__ T* gptr(T* p) {
#if defined(__HIP_DEVICE_COMPILE__)
    __builtin_assume(!__builtin_amdgcn_is_shared((const void*)p)); __builtin_assume(!__builtin_amdgcn_is_private((const void*)p));
#endif
    return p; }
struct Args {
    const float* in[24]; float* out; unsigned char* ws;
};

struct Frame {
    unsigned char* lds;
    int tid, lane, wave, G, c;
    const float* const* in;
    float* out; __attribute__((address_space(1))) unsigned char* ws;
};

__device__ __forceinline__ void p0_transpose_item(const float* W, int ldw, int k0, int n0, bf16* outp, int ldo, LAS float* scr, int lane) {
#pragma unroll
    for (int i = 0; i < 32; ++i) { const int kk = 2 * i + (lane >> 5); scr[kk * 33 + (lane & 31)] = __builtin_nontemporal_load(&W[(size_t)(k0 + kk) * ldw + n0 + (lane & 31)]); }
    LDS_WAIT(); asm volatile("" ::: "memory");
    const int c = lane & 7;
#pragma unroll
    for (int j = 0; j < 4; ++j) { const int n = (lane >> 3) + 8 * j; const LAS float* s = scr + (8 * c) * 33 + n;
        u32x4 o; o.x = pk2(s[0 * 33], s[1 * 33]); o.y = pk2(s[2 * 33], s[3 * 33]); o.z = pk2(s[4 * 33], s[5 * 33]); o.w = pk2(s[6 * 33], s[7 * 33]);
        *(u32x4*)(outp + (size_t)n * ldo + 8 * c) = o; }
    LDS_WAIT(); asm volatile("" ::: "memory");
}
__device__ __forceinline__ void p0_transpose_item_fp8(const float* W, int ldw, int k0, int n0, unsigned char* outp, int ldo, LAS float* scr, int lane) {
#pragma unroll 32
    for (int i = 0; i < 64; ++i) { const int kk = 2 * i + (lane >> 5); scr[kk * 33 + (lane & 31)] = __builtin_nontemporal_load(&W[(size_t)(k0 + kk) * ldw + n0 + (lane & 31)]); }
    LDS_WAIT(); asm volatile("" ::: "memory");
    const int c = lane & 7;
#pragma unroll
    for (int j = 0; j < 4; ++j) { const int n = (lane >> 3) + 8 * j; const LAS float* s = scr + (16 * c) * 33 + n; int o[4];
#pragma unroll
        for (int q = 0; q < 4; ++q) { int pw = __builtin_amdgcn_cvt_pk_fp8_f32(s[(4 * q) * 33] * 32.0f, s[(4 * q + 1) * 33] * 32.0f, 0, false); o[q] = __builtin_amdgcn_cvt_pk_fp8_f32(s[(4 * q + 2) * 33] * 32.0f, s[(4 * q + 3) * 33] * 32.0f, pw, true); }
        __builtin_nontemporal_store((u32x4){(unsigned)o[0], (unsigned)o[1], (unsigned)o[2], (unsigned)o[3]}, (u32x4*)(outp + (size_t)n * ldo + 16 * c)); }
    LDS_WAIT(); asm volatile("" ::: "memory");
}
__device__ __forceinline__ void rms_row_to_bf16(const float* xrow, const float* g, bf16* orow, unsigned char* qrow, int lane) {
    const f32x4* xr = (const f32x4*)xrow + lane; const f32x4* gr = (const f32x4*)g + lane;
    f32x4 v[8]; float s = 0.f;
#pragma unroll
    for (int j = 0; j < 8; ++j) { v[j] = __builtin_nontemporal_load(&xr[64 * j]); s += (v[j].x * v[j].x + v[j].y * v[j].y) + (v[j].z * v[j].z + v[j].w * v[j].w); }
    const float rstd = 1.0f / sqrtf(wave_sum(s) * (1.0f / DM) + 1e-6f);
    u32x2* o8 = (u32x2*)orow + lane; unsigned* o4 = (unsigned*)qrow + lane;
#pragma unroll
    for (int j = 0; j < 8; ++j) { const f32x4 hv = v[j] * rstd * gr[64 * j]; u32x2 w; w.x = pk2(hv.x, hv.y); w.y = pk2(hv.z, hv.w); o8[64 * j] = w;
        int pw = __builtin_amdgcn_cvt_pk_fp8_f32(hv.x, hv.y, 0, false); pw = __builtin_amdgcn_cvt_pk_fp8_f32(hv.z, hv.w, pw, true); o4[64 * j] = (unsigned)pw; }
}
__device__ __forceinline__ void p0_prologue(const Frame& F, LAS unsigned char* lds) {
    LAS float* scr = (LAS float*)(lds + F.wave * 17408);
    const int gw = F.c * NWAVES + F.wave, NGW = F.G * NWAVES;
    const float* w_in = gptr(F.in[2]); const float* w_out = gptr(F.in[18]); const float* w_gate = gptr(F.in[21]); const float* w_up = gptr(F.in[22]); const float* w_down = gptr(F.in[23]);
    bf16* WIN = (bf16*)(F.ws + WS_WIN); bf16* WOUT = (bf16*)(F.ws + WS_WOUT); unsigned char* WGU = (unsigned char*)(F.ws + WS_WGU); unsigned char* WD = (unsigned char*)(F.ws + WS_WD);
    constexpr int I_IN = 32 * 109, I_OUT = 32 * 64;
    constexpr int NITEMS = I_IN + I_OUT;
    for (int it = gw; it < NITEMS; it += NGW) {
        int r = it;
        if (r < I_IN) { const int kb = r / 109, nb = 96 + r % 109; p0_transpose_item(w_in, INP, 64 * kb, 32 * nb, WIN + (size_t)(32 * nb) * DM + 64 * kb, DM, scr, F.lane); continue; } r -= I_IN;
        { const int kb = r / 64, nb = r % 64; p0_transpose_item(w_out, DM, 64 * kb, 32 * nb, WOUT + (size_t)(32 * nb) * DM + 64 * kb, DM, scr, F.lane); }
    }
    { unsigned char* WINQ = (unsigned char*)(F.ws + WS_WINQ); for (int it = gw; it < 16 * 96; it += NGW) { const int kb = it / 96, nb = it % 96; p0_transpose_item_fp8(w_in, INP, 128 * kb, 32 * nb, WINQ + (size_t)(32 * nb) * DM + 128 * kb, DM, scr, F.lane); } }
    for (int it = gw; it < 48 * 1024; it += NGW) { const int mat = it >> 10, e = mat / 3, which = mat - 3 * e, r = it & 1023, kb = r >> 6, nb = r & 63, n0 = 32 * nb;
        if (which == 2) p0_transpose_item_fp8(w_down + (size_t)e * FF * DM, DM, 128 * kb, n0, WD + ((size_t)e * DM + n0) * FF + 128 * kb, FF, scr, F.lane);
        else { const float* W = (which == 0 ? w_gate : w_up) + (size_t)e * DM * FF; const int orow = (n0 >> 7) * 256 + which * 128 + (n0 & 127);
            p0_transpose_item_fp8(W, FF, 128 * kb, n0, WGU + ((size_t)e * 4096 + orow) * DM + 128 * kb, DM, scr, F.lane); } }
    { u32x4* z = (u32x4*)(WIN + (size_t)INP * DM); const int n16 = 96 * DM * 2 / 16; for (int i = F.c * NTHR + F.tid; i < n16; i += F.G * NTHR) z[i] = (u32x4){0u, 0u, 0u, 0u}; }
    { const float* g2 = gptr(F.in[12]); bf16* G2T = (bf16*)(F.ws + WS_G2T); for (int i = F.c * NTHR + F.tid; i < GLORA * RWW; i += F.G * NTHR) { const int n = i / GLORA, k = i % GLORA; G2T[i] = (bf16)f2bf(g2[(size_t)k * RWW + n]); } }
    { const float* x = gptr(F.in[0]); const float* g = gptr(F.in[1]); bf16* H = (bf16*)(F.ws + WS_H); unsigned char* HQ = (unsigned char*)(F.ws + WS_HQ); for (int m = gw; m < MTOK; m += NGW) rms_row_to_bf16(x + (size_t)m * DM, g, H + (size_t)m * DM, HQ + (size_t)m * DM, F.lane); }
}
#define XB_TMO      128
#define XB_XCNT(j)  (256  + 64 * (j))
#define XB_XSUB(j)  (1280 + 64 * (j))
#define XB_XGEN(j)  (2304 + 64 * (j))
#define XB_TOP      3328
#define XB_TOPGEN   3392
#define XCD_BAR_WORDS 3456
#define XB_SPIN_CAP (1u << 18)

__device__ __forceinline__ unsigned xb_ld(unsigned* p)              { return __hip_atomic_load(p, __ATOMIC_RELAXED, __HIP_MEMORY_SCOPE_AGENT); }
__device__ __forceinline__ unsigned xb_add(unsigned* p, unsigned v) { return __hip_atomic_fetch_add(p, v, __ATOMIC_RELAXED, __HIP_MEMORY_SCOPE_AGENT); }
__device__ __forceinline__ unsigned xb_xcc_id() { return (unsigned)__builtin_amdgcn_s_getreg((3 << 11) | 20) & 0xFu; }
#define XB_SPIN(cond, bar) do { unsigned _sp = 0; while (cond) { __builtin_amdgcn_s_sleep(1); \
    if ((++_sp & 255u) == 0u) { if (xb_ld(&(bar)[XB_TMO])) break; if (_sp > XB_SPIN_CAP) { atomicAdd(&(bar)[XB_TMO], 1u); break; } } } } while (0)

struct XcdBarrier {
    unsigned* bar; unsigned x;
    volatile LAS unsigned* st;
};

__device__ __forceinline__ XcdBarrier xcd_barrier_post(unsigned* bar, volatile LAS unsigned* st) {
    XcdBarrier b; b.bar = bar; b.x = xb_xcc_id(); b.st = st;
    if (threadIdx.x == 0) (void)xb_add(&bar[XB_XCNT(b.x)], 1u);
    return b;
}
__device__ __forceinline__ void xcd_barrier_complete(unsigned* bar, unsigned x, unsigned& nloc, unsigned& nx) {
    const unsigned G = gridDim.x * gridDim.y * gridDim.z;
    unsigned sum, cnt, mine, sp = 0u;
    for (;;) {
        sum = 0u; cnt = 0u; mine = 0u;
#pragma unroll
        for (unsigned j = 0; j < 16; ++j) { const unsigned c = xb_ld(&bar[XB_XCNT(j)]); sum += c; cnt += (c > 0u) ? 1u : 0u; mine = (j == x) ? c : mine; }
        if (sum == G) break;
        __builtin_amdgcn_s_sleep(1);
        if ((++sp & 255u) == 0u) { if (xb_ld(&bar[XB_TMO])) break; if (sp > XB_SPIN_CAP) { atomicAdd(&bar[XB_TMO], 1u); break; } }
    }
    nloc = mine > 0u ? mine : 1u; nx = cnt > 0u ? cnt : 1u;
}

__device__ __forceinline__ void xcd_barrier(const XcdBarrier& b) {
    asm volatile("s_waitcnt vmcnt(0)" ::: "memory");
    __syncthreads();
    if (threadIdx.x == 0) {
        unsigned* bar = b.bar;
        __builtin_amdgcn_s_waitcnt(0);
        unsigned nloc = b.st[0], nx = b.st[1];
        if (nloc == 0u) { xcd_barrier_complete(bar, b.x, nloc, nx); b.st[0] = nloc; b.st[1] = nx; }
        const unsigned old = xb_add(&bar[XB_XSUB(b.x)], 1u);
        const unsigned gen = old / nloc;
        if (old + 1u == (gen + 1u) * nloc) {
            __builtin_amdgcn_fence(__ATOMIC_RELEASE, "agent");
            asm volatile("s_waitcnt vmcnt(0)" ::: "memory");
            const unsigned og = xb_add(&bar[XB_TOP], 1u);
            const unsigned tg = og / nx;
            if (og + 1u == (tg + 1u) * nx) xb_add(&bar[XB_TOPGEN], 1u);
            else XB_SPIN(xb_ld(&bar[XB_TOPGEN]) == tg, bar);
            __builtin_amdgcn_fence(__ATOMIC_ACQUIRE, "agent");
            xb_add(&bar[XB_XGEN(b.x)], 1u);
            asm volatile("s_waitcnt vmcnt(0)" ::: "memory");
        } else {
            XB_SPIN(xb_ld(&bar[XB_XGEN(b.x)]) == gen, bar);
            __builtin_amdgcn_fence(__ATOMIC_ACQUIRE, "agent");
            asm volatile("s_waitcnt vmcnt(0)" ::: "memory");
        }
    }
    __syncthreads();
}

constexpr int NA_VSTR = 160;
constexpr int NA_OFF_V = 0, NA_OFF_RK = 512 * NA_VSTR, NA_OFF_BIAS = NA_OFF_RK + 2048, NA_OFF_ML = NA_OFF_BIAS + 1920, NA_OFF_O = NA_OFF_ML + 1024, NA_END = NA_OFF_O + 16384;
typedef short v4i16_t __attribute__((ext_vector_type(4)));
__device__ __forceinline__ s16x4 tr_read(LAS unsigned char* p) { return __builtin_bit_cast(s16x4, __builtin_amdgcn_ds_read_tr16_b64_v4i16((LAS v4i16_t*)p)); }
__device__ __forceinline__ f32x4 mfma16(bf16x8 a, bf16x8 b, f32x4 c) { return __builtin_amdgcn_mfma_f32_16x16x32_bf16(a, b, c, 0, 0, 0); }

constexpr int NA2_SLOT = 64 * NA_VSTR;
constexpr int NA2_V = 0, NA2_RK = 9 * NA2_SLOT, NA2_BIAS = NA2_RK + 9 * 256, NA2_MRG = NA2_BIAS + 1920, NA2_END = NA2_MRG + 4 * 64 * 18 * 4;
static_assert(NA2_END <= LDS_BYTES - 16, "NA LDS map");
__device__ __forceinline__ void na_phase(const Frame& F, LAS unsigned char* lds) {
    const bf16* PROJ = (const bf16*)(F.ws + WS_PROJ); bf16* MIX = (bf16*)(F.ws + WS_MIX);
    const float* qg = gptr(F.in[3]); const float* kg = gptr(F.in[4]); const float* rpb = gptr(F.in[5]);
    LAS float* BI = (LAS float*)(lds + NA2_BIAS); LAS float* MRG = (LAS float*)(lds + NA2_MRG);
    const int tid = F.tid, lane = F.lane, w = F.wave, c16 = lane & 15, g = lane >> 4, qb = w & 3, kh = w >> 2;
    constexpr float LOG2E = 1.442695041f;
    f32x2 gg[8];
#pragma unroll
    for (int j = 0; j < 4; ++j) { gg[j] = (f32x2){qg[8 * g + 2 * j] * kg[8 * g + 2 * j], qg[8 * g + 2 * j + 1] * kg[8 * g + 2 * j + 1]} * (0.125f * LOG2E);
        gg[4 + j] = (f32x2){qg[32 + 8 * g + 2 * j] * kg[32 + 8 * g + 2 * j], qg[32 + 8 * g + 2 * j + 1] * kg[32 + 8 * g + 2 * j + 1]} * (0.125f * LOG2E); }
    const int cw0 = (qb == 0) ? 0 : (qb == 1) ? 8 : (qb == 2) ? 24 : 32;
    const int qcol = 16 * qb + c16; const int cs = (qcol - 8) < 0 ? 0 : ((qcol - 8) > 48 ? 48 : (qcol - 8));
    int dcv[2][4];
#pragma unroll
    for (int cb = 0; cb < 2; ++cb)
#pragma unroll
        for (int reg = 0; reg < 4; ++reg) { const int kcol = cw0 + cb * 16 + 4 * g + reg; const bool valid = (kcol >= cs) && (kcol < cs + 16); dcv[cb][reg] = valid ? (kcol - qcol + 15) : -1; }
    const int skey = tid >> 3, sch = tid & 7;
    const unsigned koff0 = (unsigned)(((cw0 + c16) * LDP + 8 * g) * 2), koff1 = koff0 + 16 * LDP * 2, qoff = (unsigned)((qcol * LDP + 8 * g) * 2), soff = (unsigned)((skey * LDP + sch * 8) * 2);
    for (int unit = F.c; unit < 256; unit += F.G) {
        const int b = unit >> 5, h = (unit >> 1) & 15, r0 = (unit & 1) * 16;
        const size_t tokb = (size_t)b * SEQ;
        const char* rowK = (const char*)(PROJ + tokb * LDP + PC_K + h * 64); const char* rowV = (const char*)(PROJ + tokb * LDP + PC_V + h * 64); const char* rowQ = (const char*)(PROJ + tokb * LDP + PC_Q + h * 64);
        constexpr size_t ROWB = (size_t)64 * LDP * 2;
        __syncthreads();
        if (tid < 465) BI[tid] = rpb[h * 465 + tid] * LOG2E;
        { const int rs0 = (r0 - 4) < 0 ? 0 : ((r0 - 4) > 24 ? 24 : (r0 - 4)); u32x4 pv_[8], pk_[8];
#pragma unroll
            for (int i = 0; i < 8; ++i) { pv_[i] = *(const u32x4*)(rowV + (size_t)(rs0 + i) * ROWB + soff); pk_[i] = *(const u32x4*)(rowK + (size_t)(rs0 + i) * ROWB + soff); }
#pragma unroll
            for (int i = 0; i < 8; ++i) { const int slot = (rs0 + i) % 9;
                *(LAS u32x4*)(lds + NA2_V + slot * NA2_SLOT + skey * NA_VSTR + sch * 16) = pv_[i];
                float f[8]; unpack8(pk_[i], f); float ss = 0.f;
#pragma unroll
                for (int j = 0; j < 8; ++j) ss += f[j] * f[j];
                ss = red8(ss); if (sch == 0) *(LAS float*)(lds + NA2_RK + slot * 256 + skey * 4) = __builtin_amdgcn_rsqf(ss * (1.0f / 64.0f) + 1e-6f); } }
        u32x4 qraw[2], kraw[8][2];
#define NA2_ISSUE(rr) do { const int rs_ = ((rr) - 4) < 0 ? 0 : (((rr) - 4) > 24 ? 24 : ((rr) - 4)); \
            const char* qp_ = rowQ + (size_t)(rr) * ROWB + qoff; qraw[0] = *(const u32x4*)qp_; qraw[1] = *(const u32x4*)(qp_ + 64); \
            _Pragma("unroll") for (int i_ = 0; i_ < 8; ++i_) { const char* kp_ = rowK + (size_t)(rs_ + kh * 4 + (i_ >> 1)) * ROWB + ((i_ & 1) ? koff1 : koff0); kraw[i_][0] = *(const u32x4*)kp_; kraw[i_][1] = *(const u32x4*)(kp_ + 64); } } while (0)
        NA2_ISSUE(r0);
        f32x2 bs[4][2][2]; int cur_dro = 99;
        __syncthreads();
        for (int r = r0; r < r0 + 16; ++r) {
            const int rs = (r - 4) < 0 ? 0 : ((r - 4) > 24 ? 24 : (r - 4));
            const int rn = r + 1; const int rsn = (rn - 4) < 0 ? 0 : ((rn - 4) > 24 ? 24 : (rn - 4)); const bool moves = (rn < r0 + 16) && (rsn != rs);
            u32x4 nv, nk;
            { nv = *(const u32x4*)(rowV + (size_t)(rsn + 7) * ROWB + soff); nk = *(const u32x4*)(rowK + (size_t)(rsn + 7) * ROWB + soff); }
            if (rs - r != cur_dro) { cur_dro = rs - r;
#pragma unroll
                for (int kr = 0; kr < 4; ++kr)
#pragma unroll
                    for (int cb = 0; cb < 2; ++cb)
#pragma unroll
                        for (int reg = 0; reg < 4; ++reg) { const int dc = dcv[cb][reg]; const float bv_ = BI[(cur_dro + kh * 4 + kr + 7) * 31 + (dc < 0 ? 0 : dc)]; bs[kr][cb][reg >> 1][reg & 1] = dc < 0 ? -1e30f : bv_; } }
            f32x2 qf[8]; unpack8v(qraw[0], qf); unpack8v(qraw[1], qf + 4);
            f32x2 s2 = (f32x2){0.f, 0.f};
#pragma unroll
            for (int j = 0; j < 8; ++j) s2 = qf[j] * qf[j] + s2;
            float ss = s2.x + s2.y; ss += __shfl_xor(ss, 16); ss += __shfl_xor(ss, 32);
            const float rq = __builtin_amdgcn_rsqf(ss * (1.0f / 64.0f) + 1e-6f);
            u32x4 q0u, q1u; unsigned* q0p = (unsigned*)&q0u; unsigned* q1p = (unsigned*)&q1u;
#pragma unroll
            for (int j = 0; j < 4; ++j) { const f32x2 a = qf[j] * gg[j], c = qf[4 + j] * gg[4 + j]; q0p[j] = pk2(a.x, a.y); q1p[j] = pk2(c.x, c.y); }
            const bf16x8 q0 = __builtin_bit_cast(bf16x8, q0u), q1 = __builtin_bit_cast(bf16x8, q1u);
            f32x4 acc[4][2];
#pragma unroll
            for (int kr = 0; kr < 4; ++kr)
#pragma unroll
                for (int cb = 0; cb < 2; ++cb) { f32x4 a = (f32x4){0.f, 0.f, 0.f, 0.f};
                    a = mfma16(__builtin_bit_cast(bf16x8, kraw[kr * 2 + cb][0]), q0, a); a = mfma16(__builtin_bit_cast(bf16x8, kraw[kr * 2 + cb][1]), q1, a); acc[kr][cb] = a; }
            asm volatile("" : "+v"(acc[0][0]), "+v"(acc[0][1]), "+v"(acc[1][0]), "+v"(acc[1][1]), "+v"(acc[2][0]), "+v"(acc[2][1]), "+v"(acc[3][0]), "+v"(acc[3][1]));
            NA2_ISSUE(rn < r0 + 16 ? rn : r);
            f32x2 sc[4][2][2]; float mx = -1e30f;
#pragma unroll
            for (int kr = 0; kr < 4; ++kr) { const int slot = (rs + kh * 4 + kr) % 9;
#pragma unroll
                for (int cb = 0; cb < 2; ++cb) { const f32x4 rk = *(LAS f32x4*)(lds + NA2_RK + slot * 256 + (cw0 + cb * 16 + 4 * g) * 4);
                    sc[kr][cb][0] = (acc[kr][cb].xy * rk.xy) * rq + bs[kr][cb][0]; sc[kr][cb][1] = (acc[kr][cb].zw * rk.zw) * rq + bs[kr][cb][1];
                    mx = fmaxf(fmaxf(mx, fmaxf(sc[kr][cb][0].x, sc[kr][cb][0].y)), fmaxf(sc[kr][cb][1].x, sc[kr][cb][1].y)); } }
            mx = fmaxf(mx, __shfl_xor(mx, 16)); mx = fmaxf(mx, __shfl_xor(mx, 32));
            f32x2 ls2 = (f32x2){0.f, 0.f};
#pragma unroll
            for (int kr = 0; kr < 4; ++kr)
#pragma unroll
                for (int cb = 0; cb < 2; ++cb)
#pragma unroll
                    for (int hh = 0; hh < 2; ++hh) { const f32x2 d = sc[kr][cb][hh] - mx; f32x2 p; p.x = __builtin_amdgcn_exp2f(d.x); p.y = __builtin_amdgcn_exp2f(d.y); sc[kr][cb][hh] = p; ls2 = ls2 + p; }
            float lsum = ls2.x + ls2.y; lsum += __shfl_xor(lsum, 16); lsum += __shfl_xor(lsum, 32);
            f32x4 o[4];
#pragma unroll
            for (int db = 0; db < 4; ++db) o[db] = (f32x4){0.f, 0.f, 0.f, 0.f};
#pragma unroll
            for (int kr = 0; kr < 4; ++kr) {
                u32x4 pu; pu.x = pk2(sc[kr][0][0].x, sc[kr][0][0].y); pu.y = pk2(sc[kr][0][1].x, sc[kr][0][1].y); pu.z = pk2(sc[kr][1][0].x, sc[kr][1][0].y); pu.w = pk2(sc[kr][1][1].x, sc[kr][1][1].y);
                const bf16x8 pa = __builtin_bit_cast(bf16x8, pu);
                const int slot = (rs + kh * 4 + kr) % 9;
                LAS unsigned char* a0 = lds + NA2_V + slot * NA2_SLOT + (cw0 + 4 * g + (c16 >> 2)) * NA_VSTR + (c16 & 3) * 8;
#pragma unroll
                for (int db = 0; db < 4; ++db) { const s16x4 lo = tr_read(a0 + db * 32), hi = tr_read(a0 + 16 * NA_VSTR + db * 32);
                    const bf16x8 vb = (bf16x8){lo[0], lo[1], lo[2], lo[3], hi[0], hi[1], hi[2], hi[3]};
                    o[db] = mfma16(vb, pa, o[db]); } }
            LAS float* mp = MRG + (qb * 64 + lane) * 18;
            if (kh == 1) { *(LAS f32x2*)(mp + 16) = (f32x2){mx, lsum};
#pragma unroll
                for (int db = 0; db < 4; ++db) { *(LAS f32x2*)(mp + db * 4) = o[db].xy; *(LAS f32x2*)(mp + db * 4 + 2) = o[db].zw; } }
            __syncthreads();
            if (moves) { const int slot = (rsn + 7) % 9;
                *(LAS u32x4*)(lds + NA2_V + slot * NA2_SLOT + skey * NA_VSTR + sch * 16) = nv;
                float f[8]; unpack8(nk, f); float sq = 0.f;
#pragma unroll
                for (int j = 0; j < 8; ++j) sq += f[j] * f[j];
                sq = red8(sq); if (sch == 0) *(LAS float*)(lds + NA2_RK + slot * 256 + skey * 4) = __builtin_amdgcn_rsqf(sq * (1.0f / 64.0f) + 1e-6f); }
            if (kh == 0) { const f32x2 ml = *(LAS f32x2*)(mp + 16); const float mm = fmaxf(mx, ml.x); const float f0 = __builtin_amdgcn_exp2f(mx - mm), f1 = __builtin_amdgcn_exp2f(ml.x - mm); const float inv = __builtin_amdgcn_rcpf(lsum * f0 + ml.y * f1);
                const float g0 = f0 * inv, g1 = f1 * inv;
                bf16* dst = MIX + (tokb + (size_t)r * 64 + qcol) * DM + h * 64 + 4 * g;
#pragma unroll
                for (int db = 0; db < 4; ++db) { const f32x2 pa_ = *(LAS f32x2*)(mp + db * 4), pb_ = *(LAS f32x2*)(mp + db * 4 + 2);
                    const f32x2 oa = o[db].xy * g0 + pa_ * g1, ob = o[db].zw * g0 + pb_ * g1;
                    u32x2 ov; ov.x = pk2(oa.x, oa.y); ov.y = pk2(ob.x, ob.y);
                    *(u32x2*)(dst + db * 16) = ov; } }
            __syncthreads();
        }
    }
}

constexpr int PO_SGSTR = 336;
__device__ __forceinline__ void post_phase(const Frame& F, LAS unsigned char* lds) {
    const bf16* PROJ = (const bf16*)(F.ws + WS_PROJ); const bf16* G2T = (const bf16*)(F.ws + WS_G2T); const float* WKV = (const float*)(F.ws + WS_WKV); const float* SB = (const float*)(F.ws + WS_SB);
    bf16* MIX = (bf16*)(F.ws + WS_MIX); const float* mu_prev = gptr(F.in[6]); const float* mu_next = gptr(F.in[7]); const float* lnx_w = gptr(F.in[16]); const float* lnx_b = gptr(F.in[17]);
    const int lane = F.lane, w = F.wave, c16 = lane & 15, g = lane >> 4;
    for (int tile = F.c; tile < MTOK / 64; tile += F.G) {
        const int m0 = tile * 64;
        __syncthreads();
        for (int i = F.tid; i < 64 * (GLORA / 8); i += NTHR) { const int tok = i / (GLORA / 8), ch = i - tok * (GLORA / 8); const int m = m0 + tok, t = m & (SEQ - 1);
            const bf16* p = PROJ + (size_t)m * LDP + PC_RW + 3328 + 8 * ch; float c0[8], pm[8], pn[8]; unpack8(*(const u32x4*)p, c0);
            if (t > 0) unpack8(*(const u32x4*)(p - LDP), pm); else {
#pragma unroll
                for (int j = 0; j < 8; ++j) pm[j] = 0.f; }
            if (t < SEQ - 1) unpack8(*(const u32x4*)(p + LDP), pn); else {
#pragma unroll
                for (int j = 0; j < 8; ++j) pn[j] = 0.f; }
            const f32x4 mpA = *(const f32x4*)(mu_prev + 3328 + 8 * ch), mpB = *(const f32x4*)(mu_prev + 3328 + 8 * ch + 4), mnA = *(const f32x4*)(mu_next + 3328 + 8 * ch), mnB = *(const f32x4*)(mu_next + 3328 + 8 * ch + 4);
            float sg[8];
#pragma unroll
            for (int j = 0; j < 8; ++j) { const float mp = j < 4 ? mpA[j & 3] : mpB[j & 3], mn = j < 4 ? mnA[j & 3] : mnB[j & 3]; sg[j] = sigmoidf_(c0[j] + mp * (pm[j] - c0[j]) + mn * (pn[j] - c0[j])); }
            u32x4 o; o.x = pk2(sg[0], sg[1]); o.y = pk2(sg[2], sg[3]); o.z = pk2(sg[4], sg[5]); o.w = pk2(sg[6], sg[7]);
            *(LAS u32x4*)(lds + tok * PO_SGSTR + ch * 16) = o; }
        __syncthreads();
#pragma unroll 1
        for (int hd = 0; hd < 2; ++hd) {
            const int head = 2 * w + hd;
            f32x4 acc[4][4];
#pragma unroll
            for (int q = 0; q < 4; ++q)
#pragma unroll
                for (int mb = 0; mb < 4; ++mb) acc[q][mb] = (f32x4){0.f, 0.f, 0.f, 0.f};
#pragma unroll
            for (int ks = 0; ks < 5; ++ks) { bf16x8 bfr[4];
#pragma unroll
                for (int mb = 0; mb < 4; ++mb) bfr[mb] = *(LAS bf16x8*)(lds + (16 * mb + c16) * PO_SGSTR + (32 * ks + 8 * g) * 2);
#pragma unroll
                for (int q = 0; q < 4; ++q) { const bf16x8 af = *(const bf16x8*)(G2T + (size_t)(64 * head + 16 * q + c16) * GLORA + 32 * ks + 8 * g);
#pragma unroll
                    for (int mb = 0; mb < 4; ++mb) acc[q][mb] = mfma16(af, bfr[mb], acc[q][mb]); } }
#pragma unroll
            for (int mb = 0; mb < 4; ++mb) { const int m = m0 + 16 * mb + c16, t = m & (SEQ - 1); f32x4 x[4]; float s1 = 0.f;
#pragma unroll
                for (int q = 0; q < 4; ++q) { const int ch = 64 * head + 16 * q + 4 * g; x[q] = __builtin_nontemporal_load((const f32x4*)(WKV + (size_t)m * RWW + ch)) + __builtin_nontemporal_load((const f32x4*)(WKV + ((size_t)MTOK + m) * RWW + ch)); s1 += (x[q][0] + x[q][1]) + (x[q][2] + x[q][3]); }
                s1 += __shfl_xor(s1, 16); s1 += __shfl_xor(s1, 32); const float mean = s1 * (1.0f / 64.0f); float s2 = 0.f;
#pragma unroll
                for (int q = 0; q < 4; ++q) { const f32x4 d = x[q] - mean; s2 += (d[0] * d[0] + d[1] * d[1]) + (d[2] * d[2] + d[3] * d[3]); }
                s2 += __shfl_xor(s2, 16); s2 += __shfl_xor(s2, 32); const float rstd = 1.0f / sqrtf(s2 * (1.0f / 64.0f) + 64e-5f);
                const float sbv = SB[(size_t)m * 16 + head] + SB[((size_t)MTOK + m) * 16 + head];
#pragma unroll
                for (int q = 0; q < 4; ++q) { const int ch = 64 * head + 16 * q + 4 * g;
                    const bf16* pv = PROJ + (size_t)m * LDP + PC_RW + 2048 + ch; const u32x2 c0u = *(const u32x2*)pv; u32x2 pmu = (u32x2){0u, 0u}, pnu = (u32x2){0u, 0u};
                    if (t > 0) pmu = *(const u32x2*)(pv - LDP); if (t < SEQ - 1) pnu = *(const u32x2*)(pv + LDP);
                    const f32x4 c0 = (f32x4){bflo(c0u.x), bfhi(c0u.x), bflo(c0u.y), bfhi(c0u.y)}, pm = (f32x4){bflo(pmu.x), bfhi(pmu.x), bflo(pmu.y), bfhi(pmu.y)}, pn = (f32x4){bflo(pnu.x), bfhi(pnu.x), bflo(pnu.y), bfhi(pnu.y)};
                    const f32x4 mp = *(const f32x4*)(mu_prev + 2048 + ch), mn = *(const f32x4*)(mu_next + 2048 + ch);
                    const f32x4 vs = c0 + mp * (pm - c0) + mn * (pn - c0);
                    const f32x4 lw = *(const f32x4*)(lnx_w + ch), lb = *(const f32x4*)(lnx_b + ch);
                    const f32x4 y = ((x[q] - mean) * rstd * lw + lb + sbv * vs) * acc[q][mb];
                    u32x2 o; o.x = pk2(y[0], y[1]); o.y = pk2(y[2], y[3]); *(u32x2*)(MIX + (size_t)m * DM + NAW + ch) = o; }
                asm volatile("" ::: "memory"); }
        }
    }
}

constexpr int RT_PITCH = 4112, RT_LO = 16 * RT_PITCH;
__device__ __forceinline__ void norm2_router_phase(const Frame& F, LAS unsigned char* lds) {
    const float* wrt = gptr(F.in[20]); const float* gn = gptr(F.in[19]);
    for (int i = F.tid; i < DM * NE; i += NTHR) { const int d = i >> 4, e = i & 15; const float wv = gn[d] * wrt[i]; const unsigned hi = f2bf(wv); const unsigned lo = f2bf(wv - bf2f((unsigned short)hi));
        *(LAS bf16*)(lds + e * RT_PITCH + d * 2) = (bf16)hi; *(LAS bf16*)(lds + RT_LO + e * RT_PITCH + d * 2) = (bf16)lo; }
    __syncthreads();
    const bf16* X2 = (const bf16*)(F.ws + WS_X2); unsigned char* H2 = (unsigned char*)(F.ws + WS_H); float* AFF = (float*)(F.ws + WS_AFF);
    const int lane = F.lane, c16 = lane & 15, g = lane >> 4, gw = F.c * NWAVES + F.wave, NGW = F.G * NWAVES;
    f32x4 gains[8];
#pragma unroll
    for (int j = 0; j < 8; ++j) gains[j] = ((const f32x4*)gn)[64 * j + lane];
    for (int blk = gw; blk < MTOK / 8; blk += NGW) {
        const int m0 = 8 * blk;
        const bf16* xrow = X2 + (size_t)(m0 + (c16 & 7)) * DM + 8 * g; LAS unsigned char* bh = lds + c16 * RT_PITCH + 16 * g;
        f32x4 acc = (f32x4){0.f, 0.f, 0.f, 0.f}; f32x2 sq = (f32x2){0.f, 0.f};
#pragma unroll 16
        for (int ks = 0; ks < 64; ++ks) { const u32x4 a = *(const u32x4*)(xrow + 32 * ks);
            const bf16x8 h8 = *(LAS bf16x8*)(bh + 64 * ks), l8 = *(LAS bf16x8*)(bh + RT_LO + 64 * ks);
            acc = mfma16(__builtin_bit_cast(bf16x8, a), h8, acc); acc = mfma16(__builtin_bit_cast(bf16x8, a), l8, acc);
            f32x2 f[4]; unpack8v(a, f); sq = f[0] * f[0] + sq; sq = f[1] * f[1] + sq; sq = f[2] * f[2] + sq; sq = f[3] * f[3] + sq; }
        float ssq = sq.x + sq.y; ssq += __shfl_xor(ssq, 16); ssq += __shfl_xor(ssq, 32);
        const float rstd_c = __builtin_amdgcn_rsqf(ssq * (1.0f / DM) + 1e-6f);
        f32x4 aff;
#pragma unroll
        for (int reg = 0; reg < 4; ++reg) { const float lg = acc[reg] * __shfl(rstd_c, (4 * g + reg) & 7); float mx = lg;
#pragma unroll
            for (int o = 1; o < 16; o <<= 1) mx = fmaxf(mx, __shfl_xor(mx, o));
            const float ex = __expf(lg - mx); float sm = ex;
#pragma unroll
            for (int o = 1; o < 16; o <<= 1) sm += __shfl_xor(sm, o);
            aff[reg] = ex / sm; }
        if (g < 2) { const int b = m0 >> 11, t0 = (m0 & (SEQ - 1)) + 4 * g; *(f32x4*)(AFF + ((size_t)b * NE + c16) * SEQ + t0) = aff; }
#pragma unroll
        for (int r4 = 0; r4 < 8; r4 += 4) { u32x2 xv[4][8];
#pragma unroll
            for (int q = 0; q < 4; ++q) { const u32x2* xr = (const u32x2*)(X2 + (size_t)(m0 + r4 + q) * DM) + lane;
#pragma unroll
                for (int j = 0; j < 8; ++j) xv[q][j] = xr[64 * j]; }
#pragma unroll
            for (int q = 0; q < 4; ++q) { const float rs = __shfl(rstd_c, r4 + q); unsigned* o4 = (unsigned*)(H2 + (size_t)(m0 + r4 + q) * DM) + lane;
#pragma unroll
                for (int j = 0; j < 8; ++j) { const f32x4 hv = (f32x4){bflo(xv[q][j].x), bfhi(xv[q][j].x), bflo(xv[q][j].y), bfhi(xv[q][j].y)} * rs * gains[j];
                    int pw = __builtin_amdgcn_cvt_pk_fp8_f32(hv.x, hv.y, 0, false); pw = __builtin_amdgcn_cvt_pk_fp8_f32(hv.z, hv.w, pw, true); o4[64 * j] = (unsigned)pw; } } }
    }
}

__device__ __forceinline__ int block_excl_scan(int v, int& total, LAS int* part, int lane, int wave) {
    int inc = v;
#pragma unroll
    for (int o = 1; o < 64; o <<= 1) { const int y = __shfl_up(inc, o); inc += (lane >= o) ? y : 0; }
    if (lane == 63) part[wave] = inc;
    __syncthreads();
    int base = 0, tot = 0;
#pragma unroll
    for (int ww = 0; ww < NWAVES; ++ww) { const int p = part[ww]; base += (ww < wave) ? p : 0; tot += p; }
    __syncthreads();
    total = tot; return base + inc - v;
}
__device__ __forceinline__ void topk_gather_phase(const Frame& F, LAS unsigned char* lds) {
    LAS int* IDX = (LAS int*)lds; LAS int* PART = (LAS int*)(lds + 1024); LAS int* CNT = (LAS int*)(lds + 1024 + 64);
    const float* AFF = (const float*)(F.ws + WS_AFF); float* GATE = (float*)(F.ws + WS_GATE); int* TOKSLOT = (int*)(F.ws + WS_TOKSLOT);
    const unsigned char* H2 = (unsigned char*)(F.ws + WS_H); unsigned char* XE = (unsigned char*)(F.ws + WS_XE);
    const int tid = F.tid, lane = F.lane, wave = F.wave;
    for (int uu = F.c; uu < 2 * NB * NE; uu += F.G) {
        const int u = uu >> 1, half = uu & 1, b = u >> 4, e = u & 15;
        __syncthreads();
        const u32x4 kv = *(const u32x4*)(AFF + (size_t)u * SEQ + 4 * tid);
        unsigned key[4]; key[0] = kv.x; key[1] = kv.y; key[2] = kv.z; key[3] = kv.w;
        asm volatile("" : "+v"(key[0]), "+v"(key[1]), "+v"(key[2]), "+v"(key[3]));
        unsigned T = 0u;
        for (int bit = 31; bit >= 0; --bit) { const unsigned cand = T | (1u << bit);
            int c = 0;
#pragma unroll
            for (int j = 0; j < 4; ++j) c += (key[j] >= cand) ? 1 : 0;
#pragma unroll
            for (int o = 1; o < 64; o <<= 1) c += __shfl_xor(c, o);
            if (lane == 0) CNT[(bit & 1) * 8 + wave] = c;
            __syncthreads();
            int tot = 0;
#pragma unroll
            for (int ww = 0; ww < NWAVES; ++ww) tot += CNT[(bit & 1) * 8 + ww];
            if (tot >= CAP) T = cand; }
        int ngt = 0, neq = 0;
#pragma unroll
        for (int j = 0; j < 4; ++j) { ngt += (key[j] > T) ? 1 : 0; neq += (key[j] == T) ? 1 : 0; }
        int tot_gt, tot_eq; const int eq_before = block_excl_scan(neq, tot_eq, PART, lane, wave); (void)block_excl_scan(ngt, tot_gt, PART, lane, wave);
        const int need = CAP - tot_gt;
        bool sel[4]; int nsel = 0, eqr = eq_before;
#pragma unroll
        for (int j = 0; j < 4; ++j) { const bool iseq = key[j] == T; sel[j] = (key[j] > T) || (iseq && eqr < need); eqr += iseq ? 1 : 0; nsel += sel[j] ? 1 : 0; }
        int tot_sel; int slot = block_excl_scan(nsel, tot_sel, PART, lane, wave);
#pragma unroll
        for (int j = 0; j < 4; ++j) { const int t = 4 * tid + j; const int sl = sel[j] ? slot : -1; if (half == 0) TOKSLOT[((size_t)b * SEQ + t) * NE + e] = sl;
            if (sel[j]) { IDX[slot] = t; if (half == 0) GATE[e * 2048 + b * CAP + slot] = __builtin_bit_cast(float, key[j]); ++slot; } }
        __syncthreads();
        for (int s8 = wave; s8 < CAP / 2; s8 += NWAVES) { const int sl = half * (CAP / 2) + s8; const int t = IDX[sl];
            const u32x4* src = (const u32x4*)(H2 + ((size_t)b * SEQ + t) * DM) + lane; u32x4* dst = (u32x4*)(XE + ((size_t)e * 2048 + b * CAP + sl) * DM) + lane;
#pragma unroll
            for (int j = 0; j < 2; ++j) dst[64 * j] = src[64 * j]; }
    }
}

__device__ __forceinline__ void combine_phase(const Frame& F) {
    const int* TOKSLOT = (const int*)(F.ws + WS_TOKSLOT); const bf16* YE = (const bf16*)(F.ws + WS_XE);
    const int lane = F.lane, gw = F.c * NWAVES + F.wave, NGW = F.G * NWAVES;
    for (int m = gw; m < MTOK; m += NGW) { const int b = m >> 11; const int myslot = lane < NE ? TOKSLOT[(size_t)m * NE + lane] : -1;
        f32x4* orow = (f32x4*)(F.out + (size_t)m * DM) + lane; const u32x2* xrow = (const u32x2*)((const bf16*)(F.ws + WS_X2) + (size_t)m * DM) + lane; f32x4 acc[8];
#pragma unroll
        for (int j = 0; j < 8; ++j) { const u32x2 xv = xrow[64 * j]; acc[j] = (f32x4){bflo(xv.x), bfhi(xv.x), bflo(xv.y), bfhi(xv.y)}; }
#pragma unroll
        for (int e = 0; e < NE; ++e) { const int sl = __builtin_amdgcn_readlane(myslot, e);
            if (sl >= 0) { const u32x2* yr = (const u32x2*)(YE + ((size_t)e * 2048 + b * CAP + sl) * DM) + lane;
#pragma unroll
                for (int j = 0; j < 8; ++j) { const u32x2 v = __builtin_nontemporal_load(&yr[64 * j]); acc[j] += (f32x4){bflo(v.x), bfhi(v.x), bflo(v.y), bfhi(v.y)}; } } }
#pragma unroll
        for (int j = 0; j < 8; ++j) __builtin_nontemporal_store(acc[j], &orow[64 * j]);
    }
}
constexpr int CS_ST = 160, CS_MAT = 64 * CS_ST;
constexpr int CL_LW2 = 0, CL_LA2 = CS_MAT, CL_S = 2 * CS_MAT, CL_AT = 3 * CS_MAT, CL_BT = 4 * CS_MAT, CL_KT = 5 * CS_MAT, CL_RT = 6 * CS_MAT, CL_VM = 7 * CS_MAT;
constexpr int CL_XB0 = 8 * CS_MAT, CL_XB1 = 9 * CS_MAT, CL_PB0 = 10 * CS_MAT, CL_PB1 = 11 * CS_MAT, CL_MK = 12 * CS_MAT, CL_PBM = 13 * CS_MAT, CL_PKM = 14 * CS_MAT;
constexpr int CL_GL = 15 * CS_MAT, CL_CST = CL_GL + 256, CL_MU = CL_CST + 1536, CL_END = CL_MU + 3840;
constexpr int CL_X1 = CL_XB0, CL_X2 = CL_PB0, CL_WR = CL_PB1, WR_ST = 272, CL_AR = CL_WR + 64 * WR_ST, CL_TOT = CL_XB0;
constexpr int CL_Z = CL_KT, CL_U = CL_XB1;
static_assert(CL_AR + 64 * WR_ST <= CL_GL && CL_END <= LDS_BYTES - 16, "scan LDS map");

__device__ __forceinline__ bf16x8 cs_ld_row(LAS unsigned char* M, int row0, int ks, int c16, int g) { return *(LAS bf16x8*)(M + (row0 + c16) * CS_ST + (32 * ks + 8 * g) * 2); }
__device__ __forceinline__ bf16x8 cs_ld_tr(LAS unsigned char* M, int col0, int ks, int c16, int g) {
    LAS unsigned char* p = M + (32 * ks + 8 * g + (c16 >> 2)) * CS_ST + (col0 + 4 * (c16 & 3)) * 2;
    const s16x4 lo = tr_read(p), hi = tr_read(p + 4 * CS_ST);
    return (bf16x8){lo[0], lo[1], lo[2], lo[3], hi[0], hi[1], hi[2], hi[3]};
}
template <bool ATR, bool BTR> __device__ __forceinline__ void cs_mm(f32x4 (&acc)[2], LAS unsigned char* MA, LAS unsigned char* MB, int rb, int cb0, int c16, int g) {
#pragma unroll
    for (int ks = 0; ks < 2; ++ks) { const bf16x8 a = ATR ? cs_ld_tr(MA, 16 * rb, ks, c16, g) : cs_ld_row(MA, 16 * rb, ks, c16, g);
#pragma unroll
        for (int q = 0; q < 2; ++q) { const bf16x8 b = BTR ? cs_ld_tr(MB, 16 * (cb0 + q), ks, c16, g) : cs_ld_row(MB, 16 * (cb0 + q), ks, c16, g); acc[q] = mfma16(b, a, acc[q]); } }
}
__device__ __forceinline__ void cs_st(LAS unsigned char* M, int rb, int cb, const f32x4 v, int c16, int g) {
    u32x2 o; o.x = pk2(v[0], v[1]); o.y = pk2(v[2], v[3]); *(LAS u32x2*)(M + (16 * rb + c16) * CS_ST + (16 * cb + 4 * g) * 2) = o;
}
#define CS_ZERO2(a) do { a[0] = (f32x4){0.f, 0.f, 0.f, 0.f}; a[1] = (f32x4){0.f, 0.f, 0.f, 0.f}; } while (0)

__device__ __forceinline__ void scan_phase2(const Frame& F, LAS unsigned char* lds) {
    const bf16* PROJ = (const bf16*)(F.ws + WS_PROJ); float* WKV = (float*)(F.ws + WS_WKV); float* SBG = (float*)(F.ws + WS_SB);
    const float* mu_prev = gptr(F.in[6]); const float* mu_next = gptr(F.in[7]); const float* w0 = gptr(F.in[8]); const float* w2 = gptr(F.in[9]); const float* a0 = gptr(F.in[10]); const float* a2 = gptr(F.in[11]);
    const float* k_k = gptr(F.in[13]); const float* k_a = gptr(F.in[14]); const float* r_k = gptr(F.in[15]);
    const int tid = F.tid, lane = F.lane, w = F.wave;
    const int tl = lane & 7, cg = lane >> 3, trow = 8 * w + tl, cg8 = 8 * cg;
    const int c16 = lane & 15, g = lane >> 4, rb = w >> 1, cb0 = 2 * (w & 1);
    for (int sid = F.c; sid < 256; sid += F.G) {
        const int z = sid >> 7, b = (sid >> 4) & 7, h = sid & 15;
        __syncthreads();
        LAS unsigned char* L1 = lds; asm volatile("" : "+v"(L1));
        for (int i = tid; i < 4096; i += NTHR) { const int l = i >> 6, c = i & 63;
            *(LAS bf16*)(L1 + CL_LW2 + l * CS_ST + c * 2) = (bf16)f2bf(w2[((size_t)z * 64 + l) * RWW + h * 64 + c]);
            *(LAS bf16*)(L1 + CL_LA2 + l * CS_ST + c * 2) = (bf16)f2bf(a2[((size_t)z * 64 + l) * RWW + h * 64 + c]);
            *(LAS bf16*)(L1 + CL_S + l * CS_ST + c * 2) = (bf16)0; }
        const int fc0 = 64 * h, fc1 = 1024 + 64 * h, fc2 = 2048 + 64 * h, fc3 = 3072 + 64 * z, fc4 = 3200 + 64 * z;
        { LAS float* MU = (LAS float*)(L1 + CL_MU); LAS float* CST = (LAS float*)(L1 + CL_CST);
            if (tid < 64) { const int c = tid; const int fcs[5] = {fc0, fc1, fc2, fc3, fc4};
#pragma unroll
                for (int f = 0; f < 5; ++f) { const float mp_ = mu_prev[fcs[f] + c], mn_ = mu_next[fcs[f] + c]; MU[(3 * f) * 64 + c] = 1.0f - mp_ - mn_; MU[(3 * f + 1) * 64 + c] = mp_; MU[(3 * f + 2) * 64 + c] = mn_; }
                const float ka_ = k_a[64 * h + c];
                CST[c] = w0[z * RWW + 64 * h + c]; CST[64 + c] = a0[z * RWW + 64 * h + c]; CST[128 + c] = k_k[64 * h + c]; CST[192 + c] = ka_; CST[256 + c] = 1.0f - ka_; CST[320 + c] = r_k[h * 64 + c]; } }
        f32x4 sst[2]; CS_ZERO2(sst);
        u32x4 raw[15];
#define CS_ISSUE(cj) do { const int sidx_ = (cj) * 64 + trow; const int t_ = z ? (SEQ - 1 - sidx_) : sidx_; const bf16* p0_ = PROJ + ((size_t)b * SEQ + t_) * LDP + PC_RW + cg8; \
            const int dm_ = t_ > 0 ? -LDP : 0, dn_ = t_ < SEQ - 1 ? LDP : 0; \
            _Pragma("unroll") for (int f = 0; f < 5; ++f) { const int fc = (f == 0) ? fc0 : (f == 1) ? fc1 : (f == 2) ? fc2 : (f == 3) ? fc3 : fc4; \
                raw[3 * f] = *(const u32x4*)(p0_ + fc); raw[3 * f + 1] = *(const u32x4*)(p0_ + fc + dm_); raw[3 * f + 2] = *(const u32x4*)(p0_ + fc + dn_); } } while (0)
        CS_ISSUE(0);
        f32x2 xr[4], xk[4], xv[4];
#define CS_S0(CJ) do { \
            { const int sidx0_ = (CJ) * 64 + trow; const int t0_ = z ? (SEQ - 1 - sidx0_) : sidx0_; const bool edge = ((CJ) == 0) || ((CJ) == 31); const float fpm = t0_ > 0 ? 1.f : 0.f, fpn = t0_ < SEQ - 1 ? 1.f : 0.f; \
            _Pragma("unroll") \
                for (int f = 0; f < 5; ++f) { \
                    f32x2 c0[4], pm[4], pn[4], xs[4]; unpack8v(raw[3 * f], c0); unpack8v(raw[3 * f + 1], pm); unpack8v(raw[3 * f + 2], pn); \
                    if (edge) { \
            _Pragma("unroll") \
                        for (int i = 0; i < 4; ++i) { pm[i] = pm[i] * fpm; pn[i] = pn[i] * fpn; } } \
                    const LAS f32x4* mu = (const LAS f32x4*)&MU[(3 * f) * 64 + cg8];                   \
                    const f32x4 k0A = mu[0], k0B = mu[1], mpA = mu[16], mpB = mu[17], mnA = mu[32], mnB = mu[33]; \
                    xs[0] = c0[0] * k0A.xy + pm[0] * mpA.xy + pn[0] * mnA.xy; xs[1] = c0[1] * k0A.zw + pm[1] * mpA.zw + pn[1] * mnA.zw; \
                    xs[2] = c0[2] * k0B.xy + pm[2] * mpB.xy + pn[2] * mnB.xy; xs[3] = c0[3] * k0B.zw + pm[3] * mpB.zw + pn[3] * mnB.zw; \
                    if (f == 0) { \
            _Pragma("unroll") \
                        for (int i = 0; i < 4; ++i) xr[i] = xs[i]; } \
                    else if (f == 1) { \
            _Pragma("unroll") \
                        for (int i = 0; i < 4; ++i) xk[i] = xs[i]; } \
                    else if (f == 2) { \
            _Pragma("unroll") \
                        for (int i = 0; i < 4; ++i) xv[i] = xs[i]; } \
                    else { if (f == 3) { \
            _Pragma("unroll") \
                            for (int i = 0; i < 4; ++i) { const f32x2 a2 = xs[i] * 2.885390082f; f32x2 e2; e2.x = __builtin_amdgcn_exp2f(a2.x); e2.y = __builtin_amdgcn_exp2f(a2.y); e2 = e2 + 1.0f; \
                                f32x2 rr; rr.x = __builtin_amdgcn_rcpf(e2.x); rr.y = __builtin_amdgcn_rcpf(e2.y); xs[i] = rr * (-2.0f) + 1.0f; } }                    \
                        u32x4 pk; pk.x = pk2(xs[0].x, xs[0].y); pk.y = pk2(xs[1].x, xs[1].y); pk.z = pk2(xs[2].x, xs[2].y); pk.w = pk2(xs[3].x, xs[3].y); \
                        *(LAS u32x4*)(L0 + (f == 3 ? CL_X1 : CL_X2) + trow * CS_ST + cg8 * 2) = pk; } } } \
            } while (0)
        __syncthreads();
        { LAS unsigned char* L0 = lds; asm volatile("" : "+v"(L0)); LAS float* MU = (LAS float*)(L0 + CL_MU); CS_S0(0); }
        __syncthreads();
        for (int ci = 0; ci < 32; ++ci) {
            LAS unsigned char* L0 = lds; asm volatile("" : "+v"(L0));
            LAS float* MU = (LAS float*)(L0 + CL_MU); LAS float* CST = (LAS float*)(L0 + CL_CST);
            { f32x4 wa[2], aa[2]; CS_ZERO2(wa); CS_ZERO2(aa);
                { bf16x8 a1[2], a2_[2], b10[2], b11[2], b20[2], b21[2];
                    a1[0] = cs_ld_row(L0 + CL_X1, 16 * rb, 0, c16, g); a1[1] = cs_ld_row(L0 + CL_X1, 16 * rb, 1, c16, g); a2_[0] = cs_ld_row(L0 + CL_X2, 16 * rb, 0, c16, g); a2_[1] = cs_ld_row(L0 + CL_X2, 16 * rb, 1, c16, g);
                    b10[0] = cs_ld_tr(L0 + CL_LW2, 16 * cb0, 0, c16, g); b10[1] = cs_ld_tr(L0 + CL_LW2, 16 * cb0, 1, c16, g); b11[0] = cs_ld_tr(L0 + CL_LW2, 16 * cb0 + 16, 0, c16, g); b11[1] = cs_ld_tr(L0 + CL_LW2, 16 * cb0 + 16, 1, c16, g);
                    b20[0] = cs_ld_tr(L0 + CL_LA2, 16 * cb0, 0, c16, g); b20[1] = cs_ld_tr(L0 + CL_LA2, 16 * cb0, 1, c16, g); b21[0] = cs_ld_tr(L0 + CL_LA2, 16 * cb0 + 16, 0, c16, g); b21[1] = cs_ld_tr(L0 + CL_LA2, 16 * cb0 + 16, 1, c16, g);
                    __builtin_amdgcn_sched_barrier(0);
                    wa[0] = mfma16(b10[0], a1[0], wa[0]); wa[1] = mfma16(b11[0], a1[0], wa[1]); wa[0] = mfma16(b10[1], a1[1], wa[0]); wa[1] = mfma16(b11[1], a1[1], wa[1]);
                    aa[0] = mfma16(b20[0], a2_[0], aa[0]); aa[1] = mfma16(b21[0], a2_[0], aa[1]); aa[0] = mfma16(b20[1], a2_[1], aa[0]); aa[1] = mfma16(b21[1], a2_[1], aa[1]); }
#pragma unroll
                for (int q = 0; q < 2; ++q) { const int off = (16 * rb + c16) * WR_ST + (16 * (cb0 + q) + 4 * g) * 4; *(LAS f32x4*)(L0 + CL_WR + off) = wa[q]; *(LAS f32x4*)(L0 + CL_AR + off) = aa[q]; } }
            __syncthreads();
            f32x2 lw[4], av[4], bv[4]; float lam[8];
            { const LAS f32x4* wrp = (const LAS f32x4*)(L0 + CL_WR + trow * WR_ST + cg8 * 4); const LAS f32x4* arp = (const LAS f32x4*)(L0 + CL_AR + trow * WR_ST + cg8 * 4);
                const f32x4 wA = wrp[0], wB = wrp[1], aA = arp[0], aB = arp[1];
                const LAS f32x4* cst = (const LAS f32x4*)&CST[cg8];
                const f32x4 w0A = cst[0], w0B = cst[1], a0A = cst[16], a0B = cst[17], kkA = cst[32], kkB = cst[33], kaA = cst[48], kaB = cst[49], okA = cst[64], okB = cst[65], rkA = cst[80], rkB = cst[81];
                const f32x2 wr_[4] = {wA.xy + w0A.xy, wA.zw + w0A.zw, wB.xy + w0B.xy, wB.zw + w0B.zw}, ar_[4] = {aA.xy + a0A.xy, aA.zw + a0A.zw, aB.xy + a0B.xy, aB.zw + a0B.zw};
                const f32x2 kkc[4] = {kkA.xy, kkA.zw, kkB.xy, kkB.zw}, kac[4] = {kaA.xy, kaA.zw, kaB.xy, kaB.zw}, okc[4] = {okA.xy, okA.zw, okB.xy, okB.zw}, rkc[4] = {rkA.xy, rkA.zw, rkB.xy, rkB.zw};
                f32x2 kk[4], ss2 = (f32x2){0.f, 0.f}, bo2 = (f32x2){0.f, 0.f};
#pragma unroll
                for (int i = 0; i < 4; ++i) { kk[i] = xk[i] * kkc[i]; ss2 = kk[i] * kk[i] + ss2; }
                float ssq = ss2.x + ss2.y;
                ssq += dppf<0x128>(ssq); ssq += __shfl_xor(ssq, 16); ssq += __shfl_xor(ssq, 32);
                const float ninv = -__builtin_amdgcn_rcpf(fmaxf(__builtin_amdgcn_sqrtf(ssq), 1e-12f));
#pragma unroll
                for (int i = 0; i < 4; ++i) { f32x2 ew = wr_[i] * (-1.442695041f), ea = ar_[i] * (-1.442695041f);
                    ew.x = __builtin_amdgcn_exp2f(ew.x); ew.y = __builtin_amdgcn_exp2f(ew.y); ea.x = __builtin_amdgcn_exp2f(ea.x); ea.y = __builtin_amdgcn_exp2f(ea.y); ew = ew + 1.0f; ea = ea + 1.0f;
                    f32x2 sw, as; sw.x = __builtin_amdgcn_rcpf(ew.x); sw.y = __builtin_amdgcn_rcpf(ew.y); as.x = __builtin_amdgcn_rcpf(ea.x); as.y = __builtin_amdgcn_rcpf(ea.y);
                    lw[i] = sw * (-0.6065306597f); av[i] = kk[i] * ninv; bv[i] = -(av[i] * as);
                    const f32x2 kd = xk[i] * (as * kac[i] + okc[i]); bo2 = xr[i] * (kd * rkc[i]) + bo2; xk[i] = kd; }
                float bon = bo2.x + bo2.y;
                bon += dppf<0x128>(bon); bon += __shfl_xor(bon, 16); bon += __shfl_xor(bon, 32);
                if (cg == 0) { const int sidx = ci * 64 + trow; const int t = z ? (SEQ - 1 - sidx) : sidx; SBG[((size_t)z * MTOK + (size_t)b * SEQ + t) * 16 + h] = 0.5f * bon; }
#pragma unroll
                for (int j = 0; j < 8; ++j) { float y = lw[j >> 1][j & 1]; float s1 = dppf<0x111>(y); y += (tl >= 1) ? s1 : 0.f; float s2 = dppf<0x112>(y); y += (tl >= 2) ? s2 : 0.f; float s4 = dppf<0x114>(y); y += (tl >= 4) ? s4 : 0.f; lam[j] = y; }
                if (tl == 7) { LAS float* TOT = (LAS float*)(L0 + CL_TOT) + w * 64 + cg8; *(LAS f32x4*)TOT = (f32x4){lam[0], lam[1], lam[2], lam[3]}; *(LAS f32x4*)(TOT + 4) = (f32x4){lam[4], lam[5], lam[6], lam[7]}; } }
            __syncthreads();
            { f32x2 pre[4];
#pragma unroll
                for (int i = 0; i < 4; ++i) pre[i] = (f32x2){lam[2 * i], lam[2 * i + 1]};
                for (int ww = 0; ww < w; ++ww) { const LAS f32x4* TOT = (const LAS f32x4*)((const LAS float*)(L0 + CL_TOT) + ww * 64 + cg8); const f32x4 tA = TOT[0], tB = TOT[1];
                    pre[0] = pre[0] + tA.xy; pre[1] = pre[1] + tA.zw; pre[2] = pre[2] + tB.xy; pre[3] = pre[3] + tB.zw; }
                u32x4 pA, pB, pK, pR, pV; unsigned* qa = (unsigned*)&pA; unsigned* qb = (unsigned*)&pB; unsigned* qk = (unsigned*)&pK; unsigned* qr = (unsigned*)&pR; unsigned* qv = (unsigned*)&pV;
#pragma unroll
                for (int i = 0; i < 4; ++i) { const f32x2 l2 = pre[i] * 1.442695041f, m2 = (pre[i] - lw[i]) * 1.442695041f; f32x2 E, Em, Ei;
                    E.x = __builtin_amdgcn_exp2f(l2.x); E.y = __builtin_amdgcn_exp2f(l2.y); Em.x = __builtin_amdgcn_exp2f(m2.x); Em.y = __builtin_amdgcn_exp2f(m2.y); Ei.x = __builtin_amdgcn_rcpf(E.x); Ei.y = __builtin_amdgcn_rcpf(E.y);
                    const f32x2 at = av[i] * Em, bt = bv[i] * Ei, kt = xk[i] * Ei, rt = xr[i] * E;
                    qa[i] = pk2(at.x, at.y); qb[i] = pk2(bt.x, bt.y); qk[i] = pk2(kt.x, kt.y); qr[i] = pk2(rt.x, rt.y); qv[i] = pk2(xv[i].x, xv[i].y);
                    if (trow == 63) *(LAS f32x2*)(L0 + CL_GL + (cg8 + 2 * i) * 4) = E; }
                *(LAS u32x4*)(L0 + CL_AT + trow * CS_ST + cg8 * 2) = pA; *(LAS u32x4*)(L0 + CL_BT + trow * CS_ST + cg8 * 2) = pB; *(LAS u32x4*)(L0 + CL_KT + trow * CS_ST + cg8 * 2) = pK;
                *(LAS u32x4*)(L0 + CL_RT + trow * CS_ST + cg8 * 2) = pR; *(LAS u32x4*)(L0 + CL_VM + trow * CS_ST + cg8 * 2) = pV; }
            __syncthreads();
            f32x4 P[2], vk[2], pkv[2]; LAS unsigned char* TM = L0 + CL_PB1;
#define LDROW2(dst, M, row0) do { dst[0] = cs_ld_row(M, row0, 0, c16, g); dst[1] = cs_ld_row(M, row0, 1, c16, g); } while (0)
#define LDTR2(dst, M, col0) do { dst[0] = cs_ld_tr(M, col0, 0, c16, g); dst[1] = cs_ld_tr(M, col0, 1, c16, g); } while (0)
#define MM2(acc, a, b0, b1) do { acc[0] = mfma16(b0[0], a[0], acc[0]); acc[1] = mfma16(b1[0], a[0], acc[1]); acc[0] = mfma16(b0[1], a[1], acc[0]); acc[1] = mfma16(b1[1], a[1], acc[1]); } while (0)
#define SB0() __builtin_amdgcn_sched_barrier(0)
            { f32x4 nn[2], mk[2], pb[2], pkk[2]; CS_ZERO2(nn); CS_ZERO2(mk); CS_ZERO2(pb); CS_ZERO2(pkk); CS_ZERO2(vk);
                bf16x8 aA[2], aR[2], bB0[2], bB1[2], bK0[2], bK1[2], aV[2], tK0[2], tK1[2];
                LDROW2(aA, L0 + CL_AT, 16 * rb); LDROW2(aR, L0 + CL_RT, 16 * rb); LDROW2(bB0, L0 + CL_BT, 16 * cb0); LDROW2(bB1, L0 + CL_BT, 16 * cb0 + 16); LDROW2(bK0, L0 + CL_KT, 16 * cb0); LDROW2(bK1, L0 + CL_KT, 16 * cb0 + 16);
                LDTR2(aV, L0 + CL_VM, 16 * rb); LDTR2(tK0, L0 + CL_KT, 16 * cb0); LDTR2(tK1, L0 + CL_KT, 16 * cb0 + 16);
                SB0();
                MM2(nn, aA, bB0, bB1); MM2(mk, aA, bK0, bK1); MM2(pb, aR, bB0, bB1); MM2(pkk, aR, bK0, bK1); MM2(vk, aV, tK0, tK1);
#pragma unroll
                for (int q = 0; q < 2; ++q) {
#pragma unroll
                    for (int reg = 0; reg < 4; ++reg) { const int tt_ = 16 * rb + c16, ii = 16 * (cb0 + q) + 4 * g + reg; const bool lo = ii < tt_, le = ii <= tt_;
                        nn[q][reg] = lo ? nn[q][reg] : 0.f; mk[q][reg] = lo ? mk[q][reg] : 0.f; pb[q][reg] = le ? pb[q][reg] : 0.f; pkk[q][reg] = le ? pkk[q][reg] : 0.f;
                        P[q][reg] = nn[q][reg] + (ii == tt_ ? 1.0f : 0.f); }
                    cs_st(L0 + CL_XB0, rb, cb0 + q, nn[q], c16, g); cs_st(L0 + CL_PB0, rb, cb0 + q, P[q], c16, g); cs_st(L0 + CL_MK, rb, cb0 + q, mk[q], c16, g);
                    cs_st(L0 + CL_PBM, rb, cb0 + q, pb[q], c16, g); cs_st(L0 + CL_PKM, rb, cb0 + q, pkk[q], c16, g); } }
            __syncthreads();
            { f32x4 xx[2], zz[2]; CS_ZERO2(xx); CS_ZERO2(zz); CS_ZERO2(pkv);
                bf16x8 ax[2], bx0[2], bx1[2], aA[2], aM[2], aP[2], aR[2], bS0[2], bS1[2], bV0[2], bV1[2];
                LDROW2(ax, L0 + CL_XB0, 16 * rb); LDTR2(bx0, L0 + CL_XB0, 16 * cb0); LDTR2(bx1, L0 + CL_XB0, 16 * cb0 + 16);
                LDROW2(aA, L0 + CL_AT, 16 * rb); LDROW2(aM, L0 + CL_MK, 16 * rb); LDROW2(aP, L0 + CL_PKM, 16 * rb); LDROW2(aR, L0 + CL_RT, 16 * rb);
                LDROW2(bS0, L0 + CL_S, 16 * cb0); LDROW2(bS1, L0 + CL_S, 16 * cb0 + 16); LDTR2(bV0, L0 + CL_VM, 16 * cb0); LDTR2(bV1, L0 + CL_VM, 16 * cb0 + 16);
                SB0();
                MM2(xx, ax, bx0, bx1); MM2(zz, aA, bS0, bS1); MM2(zz, aM, bV0, bV1); MM2(pkv, aP, bV0, bV1); MM2(pkv, aR, bS0, bS1);
                cs_st(L0 + CL_XB1, rb, cb0, xx[0], c16, g); cs_st(L0 + CL_XB1, rb, cb0 + 1, xx[1], c16, g); cs_st(L0 + CL_Z, rb, cb0, zz[0], c16, g); cs_st(L0 + CL_Z, rb, cb0 + 1, zz[1], c16, g); }
            __syncthreads();

            CS_ISSUE(ci < 31 ? ci + 1 : 31);
#pragma unroll
            for (int j = 2; j <= 6; ++j) { LAS unsigned char* Xp = L0 + (((j - 1) & 1) ? CL_XB1 : CL_XB0); LAS unsigned char* Xn = L0 + ((j & 1) ? CL_XB1 : CL_XB0);
                LAS unsigned char* Pp = L0 + ((j & 1) ? CL_PB1 : CL_PB0); LAS unsigned char* Pn = L0 + (((j - 1) & 1) ? CL_PB1 : CL_PB0);
                bf16x8 ax[2], ap[2], bx0[2], bx1[2];
                if (j <= 5) LDROW2(ax, Xp, 16 * rb);
                LDROW2(ap, Pp, 16 * rb);
                LDTR2(bx0, Xp, 16 * cb0); LDTR2(bx1, Xp, 16 * cb0 + 16);
                SB0();
                if (j <= 5) { f32x4 xx[2]; CS_ZERO2(xx); MM2(xx, ax, bx0, bx1); cs_st(Xn, rb, cb0, xx[0], c16, g); cs_st(Xn, rb, cb0 + 1, xx[1], c16, g); }
                MM2(P, ap, bx0, bx1); cs_st(Pn, rb, cb0, P[0], c16, g); cs_st(Pn, rb, cb0 + 1, P[1], c16, g);
                __syncthreads(); }
            { f32x4 u[2]; CS_ZERO2(u);
                bf16x8 aT[2], bZ0[2], bZ1[2];
                LDROW2(aT, TM, 16 * rb); LDTR2(bZ0, L0 + CL_Z, 16 * cb0); LDTR2(bZ1, L0 + CL_Z, 16 * cb0 + 16);
                SB0();
                MM2(u, aT, bZ0, bZ1);
                cs_st(L0 + CL_U, rb, cb0, u[0], c16, g); cs_st(L0 + CL_U, rb, cb0 + 1, u[1], c16, g); }
            __syncthreads();
            { bf16x8 aPb[2], bU0[2], bU1[2], aU[2], bB0[2], bB1[2];
                LDROW2(aPb, L0 + CL_PBM, 16 * rb); LDTR2(bU0, L0 + CL_U, 16 * cb0); LDTR2(bU1, L0 + CL_U, 16 * cb0 + 16); LDTR2(aU, L0 + CL_U, 16 * rb); LDTR2(bB0, L0 + CL_BT, 16 * cb0); LDTR2(bB1, L0 + CL_BT, 16 * cb0 + 16);
                const f32x4 gl0 = *(LAS f32x4*)(L0 + CL_GL + (16 * cb0 + 4 * g) * 4), gl1 = *(LAS f32x4*)(L0 + CL_GL + (16 * cb0 + 16 + 4 * g) * 4);
                SB0();
                MM2(pkv, aPb, bU0, bU1); MM2(vk, aU, bB0, bB1);
                { const int ts = ci * 64 + 16 * rb + c16; const int tt_ = z ? (SEQ - 1 - ts) : ts; float* dst = WKV + ((size_t)z * MTOK + (size_t)b * SEQ + tt_) * RWW + h * 64 + 16 * cb0 + 4 * g;
                    *(f32x4*)dst = pkv[0]; *(f32x4*)(dst + 16) = pkv[1]; }
                sst[0] = (sst[0] + vk[0]) * gl0; sst[1] = (sst[1] + vk[1]) * gl1;
                cs_st(L0 + CL_S, rb, cb0, sst[0], c16, g); cs_st(L0 + CL_S, rb, cb0 + 1, sst[1], c16, g); }
            if (ci < 31) { CS_S0(ci + 1); }
            __syncthreads();
        }
    }
}
#ifndef PROBE_PHASE
#define PROBE_PHASE -1
#endif
#ifdef PROBE_NOBAR
#define PROBE_SEAM() __syncthreads()
#else
#define PROBE_SEAM() xcd_barrier(xbar)
#endif
#define REP(k) for (int rep_ = 0; rep_ < ((k) == PROBE_PHASE ? 2 : 1); ++rep_)
#ifndef SP2
#define SP2 true
#endif
#ifndef FP8_SP2
#define FP8_SP2 true
#endif
#ifndef ALIGN_EPI
#define ALIGN_EPI true
#endif
__global__ void __launch_bounds__(NTHR, 2) fwd_kernel(Args args) {
    extern __shared__ __attribute__((aligned(16))) unsigned char lds_raw[];
    cg::grid_group grid = cg::this_grid();
    LAS unsigned char* lds = (LAS unsigned char*)lds_raw;
#define MKFRAME() Frame F; { int t_ = threadIdx.x; asm volatile("" : "+v"(t_)); unsigned char* w_ = args.ws; asm volatile("" : "+s"(w_)); \
    F.lds = lds_raw; F.tid = t_; F.lane = t_ & 63; F.wave = __builtin_amdgcn_readfirstlane(t_ >> 6); F.G = gridDim.x; F.c = blockIdx.x; F.in = args.in; F.out = gptr(args.out); F.ws = (GAS unsigned char*)w_; } \
    GAS unsigned char* ws = F.ws; (void)ws
    if (args.out == nullptr) grid.sync();
    { volatile LAS unsigned* st = (volatile LAS unsigned*)(lds + LDS_BYTES - 16); if (threadIdx.x < 4) st[threadIdx.x] = 0u; }
    __syncthreads();
    const XcdBarrier xbar = xcd_barrier_post((unsigned*)(args.ws + WS_CTL), (volatile LAS unsigned*)(lds + LDS_BYTES - 16));
#if !defined(ONLY) || ONLY==0
    REP(0) { if (rep_) { __syncthreads(); } MKFRAME(); p0_prologue(F, lds); }
#endif
    xcd_barrier(xbar);
#if !defined(ONLY) || ONLY==1
    REP(1) { if (rep_) xcd_barrier(xbar);
    { MKFRAME();
      const bool even = (F.G == 256);
      { pg8::Gemm g{(const pg8::bf16_t*)(ws + WS_HQ), (const pg8::bf16_t*)(ws + WS_WINQ), MTOK, 3072, DM / 2}; pg8::SplitOrder S; S.init3(MTOK, 3072, F.G, F.c, even ? 2 : (1 << 20), even ? 2 : 0, 128, 256);
        pg8::EpiStoreBf16 E{(pg8::bf16_t*)(ws + WS_PROJ), LDP};
        pg8::gemm_phase<pg8::EpiStoreBf16, pg8::SplitOrder, ALIGN_EPI, FP8_SP2, true, 0x7A7A7A7A>(lds, g, S, E); }
      { pg8::Gemm g{(const pg8::bf16_t*)(ws + WS_H), (const pg8::bf16_t*)(ws + WS_WIN) + (size_t)3072 * DM, MTOK, 3584, DM}; pg8::SplitOrder S; S.init3(MTOK, 3584, F.G, F.c, even ? 3 : (1 << 20), even ? 1 : 0, 0, 128);
        pg8::EpiStoreBf16 E{(pg8::bf16_t*)(ws + WS_PROJ) + 3072, LDP};
        pg8::gemm_phase<pg8::EpiStoreBf16, pg8::SplitOrder, ALIGN_EPI, SP2>(lds, g, S, E); } } }
#endif
    xcd_barrier(xbar);
#if !defined(ONLY) || ONLY==2
    REP(2) { if (rep_) { PROBE_SEAM(); } MKFRAME(); na_phase(F, lds); }
#endif
#if !defined(ONLY) || ONLY==3
    REP(3) { if (rep_) { PROBE_SEAM(); } MKFRAME(); scan_phase2(F, lds); }
#endif
    xcd_barrier(xbar);
#if !defined(ONLY) || ONLY==4
    REP(4) { if (rep_) { PROBE_SEAM(); } MKFRAME(); post_phase(F, lds); }
#endif
    xcd_barrier(xbar);
#if !defined(ONLY) || ONLY==5
    REP(5) { if (rep_) xcd_barrier(xbar);
    { MKFRAME(); pg8::Gemm g{(const pg8::bf16_t*)(ws + WS_MIX), (const pg8::bf16_t*)(ws + WS_WOUT), MTOK, DM, DM}; pg8::StaticOrder S; S.init(MTOK, DM, F.G, F.c);
      pg8::EpiResBf16 E{gptr(args.in[0]), (pg8::bf16_t*)(ws + WS_X2), DM};
      pg8::gemm_phase<pg8::EpiResBf16, pg8::StaticOrder, ALIGN_EPI, SP2>(lds, g, S, E); } }
#endif
    xcd_barrier(xbar);
#if !defined(ONLY) || ONLY==6
    REP(6) { if (rep_) xcd_barrier(xbar); MKFRAME(); norm2_router_phase(F, lds); }
#endif
    xcd_barrier(xbar);
#if !defined(ONLY) || ONLY==7
    REP(7) { if (rep_) xcd_barrier(xbar); MKFRAME(); topk_gather_phase(F, lds); }
#endif
    xcd_barrier(xbar);
#if !defined(ONLY) || ONLY==8
    REP(8) { if (rep_) xcd_barrier(xbar);
    { MKFRAME(); pg8::Gemm g{(const pg8::bf16_t*)(ws + WS_XE), (const pg8::bf16_t*)(ws + WS_WGU), MEXP, 4096, DM / 2}; pg8::MoeOrder S; S.init2(16, F.G, F.c);
      pg8::EpiSwiGLU E{(unsigned char*)(ws + WS_HID)};
      pg8::gemm_phase<pg8::EpiSwiGLU, pg8::MoeOrder, ALIGN_EPI, FP8_SP2, true, 0x7A7A7A7A>(lds, g, S, E); } }
#endif
    xcd_barrier(xbar);
#if !defined(ONLY) || ONLY==9
    REP(9) { if (rep_) xcd_barrier(xbar);
    { MKFRAME(); pg8::Gemm g{(const pg8::bf16_t*)(ws + WS_HID), (const pg8::bf16_t*)(ws + WS_WD), MEXP, 2048, FF / 2}; pg8::MoeOrder S; S.init2(8, F.G, F.c);
      pg8::EpiDownScale E{(pg8::bf16_t*)(ws + WS_XE), (const float*)(ws + WS_GATE)};
      pg8::gemm_phase<pg8::EpiDownScale, pg8::MoeOrder, ALIGN_EPI, FP8_SP2, true, 0x7A7A7A7A>(lds, g, S, E); } }
#endif
    xcd_barrier(xbar);
#ifdef PROBE_BARRIERS
    for (int pb_ = 0; pb_ < PROBE_BARRIERS; ++pb_) xcd_barrier(xbar);
#endif
#if !defined(ONLY) || ONLY==10
    { MKFRAME(); combine_phase(F); }
#endif
}

extern "C" void kernel_launch(void* const* d_in, const int* in_sizes, int n_in, void* d_out, int out_size, void* d_ws, size_t ws_size, hipStream_t stream) {
    static int grid = 0;
    if (grid == 0) {
        if (n_in != 24 || out_size != MTOK * DM || ws_size < WS_END) { fprintf(stderr, "kernel_launch: unexpected shapes (n_in %d, out %d, ws %zu)\n", n_in, out_size, ws_size); grid = -1; return; }
        int dev = 0, cus = 0, per_cu = 0;
        if (hipGetDevice(&dev) != hipSuccess || hipDeviceGetAttribute(&cus, hipDeviceAttributeMultiprocessorCount, dev) != hipSuccess) { grid = -1; return; }
        if (hipFuncSetAttribute((const void*)fwd_kernel, hipFuncAttributeMaxDynamicSharedMemorySize, LDS_BYTES) != hipSuccess) { fprintf(stderr, "kernel_launch: hipFuncSetAttribute failed\n"); grid = -1; return; }
        if (hipOccupancyMaxActiveBlocksPerMultiprocessor(&per_cu, (const void*)fwd_kernel, NTHR, LDS_BYTES) != hipSuccess || per_cu < 1) { fprintf(stderr, "kernel_launch: occupancy query failed (%d)\n", per_cu); (void)hipGetLastError(); per_cu = 1; }
        grid = cus * per_cu;
    }
    if (grid < 0) return;
    if (hipMemsetAsync((char*)d_ws + WS_CTL, 0, 65536, stream) != hipSuccess) { fprintf(stderr, "kernel_launch: memset failed\n"); return; }
    Args a{};
    for (int i = 0; i < 24; ++i) a.in[i] = (const float*)d_in[i];
    a.out = (float*)d_out; a.ws = (unsigned char*)d_ws;
    void* kargs[] = {&a};
    hipError_t e = hipLaunchCooperativeKernel((const void*)fwd_kernel, dim3(grid), dim3(NTHR), kargs, LDS_BYTES, stream);
    if (e != hipSuccess) fprintf(stderr, "kernel_launch: cooperative launch failed: %s (grid %d)\n", hipGetErrorString(e), grid);
}
```

```cpp
#include <hip/hip_runtime.h>
#include <hip/hip_cooperative_groups.h>
#include <cstdio>
#include <cstdint>
namespace cg = cooperative_groups;

namespace pg8 {
#define PG8_LAS __attribute__((address_space(3)))
typedef unsigned short bf16_t;
typedef short bf16x8 __attribute__((ext_vector_type(8)));
typedef float f32x4 __attribute__((ext_vector_type(4)));
typedef unsigned u32x4 __attribute__((ext_vector_type(4)));
constexpr int BM = 256, BK = 64, HALF = 128, HTB = HALF * BK * 2  , STAGE_BYTES = 8 * HTB, NXCD = 8, WGM = 8;

__host__ __device__ __forceinline__ int lds_byte(int r, int c) { const int st = (r >> 4) * 2 + (c >> 5), rr = r & 15, cc = c & 31, ob = rr * 64 + cc * 2; return st * 1024 + (ob ^ (((ob >> 9) & 1) << 5)); }
__host__ __device__ __forceinline__ void stage_rc(int b, int& R, int& C) { const int st = b / 1024, sb = b % 1024, swz = sb ^ (((sb >> 9) & 1) << 5); R = (st >> 1) * 16 + swz / 64; C = (st & 1) * 32 + (swz % 64) / 2; }
__host__ __device__ __forceinline__ int perm32(int rho) { const int n = rho >> 4, i = rho & 15; return 8 * (i >> 2) + 4 * n + (i & 3); }

struct Unit { int pm, pn; };
struct Gemm { const bf16_t* A; const bf16_t* Bt; int M, N, K; };

struct StaticOrder {
    int nM, nN, nwg, G, c;
    __host__ __device__ void init(int M, int N, int G_, int c_) { nM = M / BM; nN = N / BM; nwg = nM * nN; G = G_; c = c_; }
    __host__ __device__ bool next(int i, Unit& u) const {
        const long L = (long)i * G + c; if (L >= nwg) return false;
        int wgid = (int)L; { const int q = nwg / NXCD, r = nwg % NXCD, xcd = wgid % NXCD, off = wgid / NXCD; wgid = (xcd < r ? xcd * (q + 1) : r * (q + 1) + (xcd - r) * q) + off; }
        const int nig = WGM * nN, gid = wgid / nig, fm = gid * WGM, gsz = (nM - fm) < WGM ? (nM - fm) : WGM;
        u.pm = fm + ((wgid % nig) % gsz); u.pn = (wgid % nig) / gsz; return true;
    }
    __device__ __forceinline__ void a_ready(const Unit&) const {}
    __device__ __forceinline__ void done(const Unit&) const {}
};

__device__ __forceinline__ unsigned cvt_pk_bf16(float lo, float hi) { unsigned r; asm volatile("v_cvt_pk_bf16_f32 %0, %1, %2" : "=v"(r) : "v"(lo), "v"(hi)); return r; }

struct EpiStoreBf16 {
    static constexpr bool PERM = true, AFTER_DRAIN = false;
    bf16_t* O; int ldc;
    __device__ __forceinline__ void operator()(const f32x4 (&acc)[2][2][4][2], const Unit& u, int wr, int wc, int fr, int fq) const {
        const int row0 = u.pm * BM + wr * 64 + fr, col0 = u.pn * BM + wc * 32 + 8 * fq;
#pragma unroll
        for (int ai = 0; ai < 2; ++ai)
#pragma unroll
            for (int m = 0; m < 4; ++m) { bf16_t* rowp = O + (size_t)(row0 + ai * HALF + m * 16) * ldc + col0;
#pragma unroll
                for (int bj = 0; bj < 2; ++bj) { const f32x4 v0 = acc[ai][bj][m][0], v1 = acc[ai][bj][m][1];
                    u32x4 w; w.x = cvt_pk_bf16(v0[0], v0[1]); w.y = cvt_pk_bf16(v0[2], v0[3]); w.z = cvt_pk_bf16(v1[0], v1[1]); w.w = cvt_pk_bf16(v1[2], v1[3]);
                    *(u32x4*)(rowp + bj * HALF) = w; } }
    }
};
struct EpiResF32 {
    static constexpr bool PERM = false, AFTER_DRAIN = false;
    const float* base; float* out; int ldc;
    __device__ __forceinline__ void operator()(const f32x4 (&acc)[2][2][4][2], const Unit& u, int wr, int wc, int fr, int fq) const {
        const int row0 = u.pm * BM + wr * 64 + fr, col0 = u.pn * BM + wc * 32 + 4 * fq;
#pragma unroll
        for (int ai = 0; ai < 2; ++ai)
#pragma unroll
            for (int m = 0; m < 4; ++m) { const size_t off = (size_t)(row0 + ai * HALF + m * 16) * ldc + col0;
#pragma unroll
                for (int bj = 0; bj < 2; ++bj)
#pragma unroll
                    for (int n = 0; n < 2; ++n) { const f32x4 b = *(const f32x4*)(base + off + bj * HALF + n * 16); *(f32x4*)(out + off + bj * HALF + n * 16) = b + acc[ai][bj][m][n]; } }
    }
};
struct EpiResBf16 {
    static constexpr bool PERM = true, AFTER_DRAIN = false;
    const float* base; bf16_t* out; int ldc;
    __device__ __forceinline__ void operator()(const f32x4 (&acc)[2][2][4][2], const Unit& u, int wr, int wc, int fr, int fq) const {
        const int row0 = u.pm * BM + wr * 64 + fr, col0 = u.pn * BM + wc * 32 + 8 * fq;
#pragma unroll
        for (int ai = 0; ai < 2; ++ai)
#pragma unroll
            for (int m = 0; m < 4; ++m) { const size_t off = (size_t)(row0 + ai * HALF + m * 16) * ldc + col0;
#pragma unroll
                for (int bj = 0; bj < 2; ++bj) { const f32x4 v0 = __builtin_nontemporal_load((const f32x4*)(base + off + bj * HALF)) + acc[ai][bj][m][0], v1 = __builtin_nontemporal_load((const f32x4*)(base + off + bj * HALF + 4)) + acc[ai][bj][m][1];
                    u32x4 w; w.x = cvt_pk_bf16(v0[0], v0[1]); w.y = cvt_pk_bf16(v0[2], v0[3]); w.z = cvt_pk_bf16(v1[0], v1[1]); w.w = cvt_pk_bf16(v1[2], v1[3]);
                    *(u32x4*)(out + off + bj * HALF) = w; } }
    }
};
struct EpiSwiGLU {
    static constexpr bool PERM = true, AFTER_DRAIN = false;
    unsigned char* O;
    __device__ __forceinline__ void operator()(const f32x4 (&acc)[2][2][4][2], const Unit& u, int wr, int wc, int fr, int fq) const {
        const int row0 = u.pm * BM + wr * 64 + fr, col0 = (u.pn & 15) * HALF + wc * 32 + 8 * fq;
#pragma unroll
        for (int ai = 0; ai < 2; ++ai)
#pragma unroll
            for (int m = 0; m < 4; ++m) { unsigned char* rowp = O + (size_t)(row0 + ai * HALF + m * 16) * 2048 + col0;
                float h[8];
#pragma unroll
                for (int n = 0; n < 2; ++n)
#pragma unroll
                    for (int j = 0; j < 4; ++j) { const float gt = acc[ai][0][m][n][j], up = acc[ai][1][m][n][j];
                        h[n * 4 + j] = gt * __builtin_amdgcn_rcpf(1.0f + __expf(-gt)) * up; }
                int p0 = __builtin_amdgcn_cvt_pk_fp8_f32(h[0], h[1], 0, false); p0 = __builtin_amdgcn_cvt_pk_fp8_f32(h[2], h[3], p0, true);
                int p1 = __builtin_amdgcn_cvt_pk_fp8_f32(h[4], h[5], 0, false); p1 = __builtin_amdgcn_cvt_pk_fp8_f32(h[6], h[7], p1, true);
                typedef int i32x2 __attribute__((ext_vector_type(2))); *(i32x2*)rowp = (i32x2){p0, p1}; }
    }
};
struct EpiDownScale {
    static constexpr bool PERM = true, AFTER_DRAIN = false;
    bf16_t* O; const float* gate;
    __device__ __forceinline__ void operator()(const f32x4 (&acc)[2][2][4][2], const Unit& u, int wr, int wc, int fr, int fq) const {
        const int row0 = u.pm * BM + wr * 64 + fr, col0 = (u.pn & 7) * BM + wc * 32 + 8 * fq;
#pragma unroll
        for (int ai = 0; ai < 2; ++ai)
#pragma unroll
            for (int m = 0; m < 4; ++m) { const int row = row0 + ai * HALF + m * 16; const float gs = gate[row]; bf16_t* rowp = O + (size_t)row * 2048 + col0;
#pragma unroll
                for (int bj = 0; bj < 2; ++bj) { const f32x4 v0 = acc[ai][bj][m][0] * gs, v1 = acc[ai][bj][m][1] * gs;
                    u32x4 w; w.x = cvt_pk_bf16(v0[0], v0[1]); w.y = cvt_pk_bf16(v0[2], v0[3]); w.z = cvt_pk_bf16(v1[0], v1[1]); w.w = cvt_pk_bf16(v1[2], v1[3]);
                    *(u32x4*)(rowp + bj * HALF) = w; } }
    }
};
struct MoeOrder : StaticOrder {
    int nNl;
    __device__ void init2(int nNl_, int G_, int c_) { nNl = nNl_; init(32768, nNl_ * BM, G_, c_); }
    __device__ bool next(int i, Unit& u) const { if (!StaticOrder::next(i, u)) return false; u.pn += (u.pm >> 3) * nNl; return true; }
};

struct SplitOrder : StaticOrder {
    int full_rounds, xrounds, xlo, xhi;
    __device__ void init3(int M, int N, int G_, int c_, int fr_, int xr_, int xlo_, int xhi_) { init(M, N, G_, c_); full_rounds = fr_; xrounds = xr_; xlo = xlo_; xhi = xhi_; }
    __device__ bool next(int i, Unit& u) const {
        long L;
        if (i < full_rounds) L = (long)i * G + c;
        else { const int j = i - full_rounds; if (j >= xrounds || c < xlo || c >= xhi) return false; L = (long)full_rounds * G + (long)j * (xhi - xlo) + (c - xlo); }
        if (L >= nwg) return false;
        int wgid = (int)L; { const int q = nwg / NXCD, r = nwg % NXCD, xcd = wgid % NXCD, off = wgid / NXCD; wgid = (xcd < r ? xcd * (q + 1) : r * (q + 1) + (xcd - r) * q) + off; }
        const int nig = WGM * nN, gid = wgid / nig, fm = gid * WGM, gsz = (nM - fm) < WGM ? (nM - fm) : WGM;
        u.pm = fm + ((wgid % nig) % gsz); u.pn = (wgid % nig) / gsz; return true;
    }
};
template <class Epi, class Sched, bool ALIGN_EPI = false, bool SP2 = false, bool FP8 = false, int WSC = 0x7F7F7F7F>
__device__ __forceinline__ void gemm_phase(PG8_LAS unsigned char* lds, const Gemm g, const Sched& S, const Epi& E) {
    int tid_ = threadIdx.x; asm volatile("" : "+v"(tid_));
    const int tid = tid_, wid = __builtin_amdgcn_readfirstlane(tid >> 6), lane = tid & 63, wr = wid >> 2, wc = wid & 3, fr = lane & 15, fq = lane >> 4;
    const int K = g.K, nt = K / BK;
    unsigned voffA[2], voffB[2];
#pragma unroll
    for (int i = 0; i < 2; ++i) { int R, C; stage_rc(tid * 16 + i * 8192, R, C); const int Rb = Epi::PERM ? ((R & ~31) + perm32(R & 31)) : R;
        voffA[i] = (unsigned)(R * K + C) * 2u; voffB[i] = (unsigned)(Rb * K + C) * 2u; }
    const size_t kstep = (size_t)(BK * 2);
    const size_t hstep = (size_t)HALF * K * 2;
    const size_t tstep = 2 * hstep;
    const unsigned ldsw = (unsigned)wid * 1024u;
    const int aoff = lds_byte(wr * 64 + fr, fq * 8), boff = lds_byte(wc * 32 + fr, fq * 8);
typedef int pg8_v8i __attribute__((ext_vector_type(8))); typedef short pg8_s16 __attribute__((ext_vector_type(16)));
#define PG8_CAT(lo, hi) __builtin_bit_cast(pg8_v8i, __builtin_shufflevector(lo, hi, 0, 1, 2, 3, 4, 5, 6, 7, 8, 9, 10, 11, 12, 13, 14, 15))
#define PG8_SA(b, h) (((b) * 2 + (h)) * HTB)
#define PG8_SB(b, h) ((4 + (b) * 2 + (h)) * HTB)
#define PG8_STAGE(bufoff, gbase, voff) do { _Pragma("unroll") for (int _i = 0; _i < 2; ++_i) \
        __builtin_amdgcn_global_load_lds((const unsigned*)((const char*)(gbase) + (voff)[_i]), (PG8_LAS unsigned*)(lds + (bufoff) + ldsw + _i * 8192), 16, 0, 0); } while (0)
#define PG8_LDA(dst, b, h) do { if constexpr (FP8) { _Pragma("unroll") for (int m = 0; m < 4; ++m) { const bf16x8 lo_ = *(const PG8_LAS bf16x8*)(lds + PG8_SA(b, h) + aoff + m * 2048), hi_ = *(const PG8_LAS bf16x8*)(lds + PG8_SA(b, h) + aoff + m * 2048 + 1024); dst##8[m] = PG8_CAT(lo_, hi_); } } \
        else { _Pragma("unroll") for (int m = 0; m < 4; ++m) _Pragma("unroll") for (int k = 0; k < 2; ++k) dst[m][k] = *(const PG8_LAS bf16x8*)(lds + PG8_SA(b, h) + aoff + m * 2048 + k * 1024); } } while (0)
#define PG8_LDB(dst, b, h) do { if constexpr (FP8) { _Pragma("unroll") for (int n = 0; n < 2; ++n) { const bf16x8 lo_ = *(const PG8_LAS bf16x8*)(lds + PG8_SB(b, h) + boff + n * 2048), hi_ = *(const PG8_LAS bf16x8*)(lds + PG8_SB(b, h) + boff + n * 2048 + 1024); dst##8[n] = PG8_CAT(lo_, hi_); } } \
        else { _Pragma("unroll") for (int n = 0; n < 2; ++n) _Pragma("unroll") for (int k = 0; k < 2; ++k) dst[n][k] = *(const PG8_LAS bf16x8*)(lds + PG8_SB(b, h) + boff + n * 2048 + k * 1024); } } while (0)
#define PG8_MMA(ai, bj, At, Bt) do { __builtin_amdgcn_s_setprio(1); \
        if constexpr (FP8) { _Pragma("unroll") for (int m = 0; m < 4; ++m) _Pragma("unroll") for (int n = 0; n < 2; ++n) \
            asm volatile("v_mfma_scale_f32_16x16x128_f8f6f4 %0, %1, %2, %0, %3, %4 op_sel_hi:[0,0,0]" : "+v"(acc[ai][bj][m][n]) : "v"(Bt##8[n]), "v"(At##8[m]), "v"(fp8_wsc), "v"(fp8_one)); }     \
        else { _Pragma("unroll") for (int m = 0; m < 4; ++m) _Pragma("unroll") for (int n = 0; n < 2; ++n) _Pragma("unroll") for (int k = 0; k < 2; ++k) \
            acc[ai][bj][m][n] = __builtin_amdgcn_mfma_f32_16x16x32_bf16(Bt[n][k], At[m][k], acc[ai][bj][m][n], 0, 0, 0); } \
        __builtin_amdgcn_s_setprio(0); } while (0)
#define PG8_WAIT_V(n) asm volatile("s_waitcnt vmcnt(" #n ")" ::: "memory")
#define PG8_WAIT_L(n) asm volatile("s_waitcnt lgkmcnt(" #n ")" ::: "memory")
#define PG8_BAR __builtin_amdgcn_s_barrier()
#define PG8_SCHED __builtin_amdgcn_sched_barrier(0)
    Unit cur, nxt; int ui = 0;
    if (!S.next(0, cur)) return;
    f32x4 acc[2][2][4][2];
#pragma unroll
    for (int a = 0; a < 2; ++a)
#pragma unroll
        for (int b = 0; b < 2; ++b)
#pragma unroll
            for (int m = 0; m < 4; ++m)
#pragma unroll
                for (int n = 0; n < 2; ++n) acc[a][b][m][n] = (f32x4){0.f, 0.f, 0.f, 0.f};
    int fp8_wsc = WSC, fp8_one = 0x7F7F7F7F; if constexpr (FP8) asm volatile("" : "+v"(fp8_wsc), "+v"(fp8_one));
    bf16x8 At[4][2], B0[2][2], B1[2][2]; pg8_v8i At8[4], B08[2], B18[2];
    const char* cA = (const char*)g.A + (size_t)cur.pm * tstep; const char* cB = (const char*)g.Bt + (size_t)cur.pn * tstep;
    S.a_ready(cur);
    if constexpr (SP2) {
        PG8_STAGE(PG8_SB(0, 0), cB, voffB); PG8_STAGE(PG8_SB(0, 1), cB + hstep, voffB); PG8_STAGE(PG8_SA(0, 0), cA, voffA); PG8_STAGE(PG8_SA(0, 1), cA + hstep, voffA);
        if (wr == 1) PG8_BAR;
        PG8_WAIT_V(2); PG8_BAR;
        PG8_STAGE(PG8_SB(1, 0), cB + kstep, voffB); PG8_STAGE(PG8_SA(1, 0), cA + kstep, voffA); PG8_STAGE(PG8_SB(1, 1), cB + hstep + kstep, voffB);
        PG8_WAIT_V(6); PG8_BAR;
    } else {
        PG8_STAGE(PG8_SB(0, 0), cB, voffB); PG8_STAGE(PG8_SA(0, 0), cA, voffA); PG8_STAGE(PG8_SB(0, 1), cB + hstep, voffB); PG8_STAGE(PG8_SA(0, 1), cA + hstep, voffA);
        if (wr == 1) PG8_BAR;
        PG8_WAIT_V(4); PG8_BAR;
        PG8_STAGE(PG8_SB(1, 0), cB + kstep, voffB); PG8_STAGE(PG8_SA(1, 0), cA + kstep, voffA); PG8_STAGE(PG8_SB(1, 1), cB + hstep + kstep, voffB);
        PG8_WAIT_V(6); PG8_BAR;
    }
    for (;;) {
        const bool has_next = S.next(ui + 1, nxt);
        const char* nA = has_next ? (const char*)g.A + (size_t)nxt.pm * tstep : cA; const char* nB = has_next ? (const char*)g.Bt + (size_t)nxt.pn * tstep : cB;
        for (int t = 0; t < nt; t += 2) {
            const bool last = (t == nt - 2);
            const char* a1 = cA + (size_t)(t + 1) * kstep;
            const char* a2 = last ? nA : cA + (size_t)(t + 2) * kstep; const char* b2 = last ? nB : cB + (size_t)(t + 2) * kstep;
            const char* a3 = a2 + kstep; const char* b3 = b2 + kstep;
            if (last && has_next) S.a_ready(nxt);
            if constexpr (SP2) {
            PG8_LDB(B0, 0, 0); PG8_LDB(B1, 0, 1); PG8_SCHED; PG8_LDA(At, 0, 0); PG8_STAGE(PG8_SA(1, 1), a1 + hstep, voffA);
            PG8_WAIT_V(8); PG8_WAIT_L(0); PG8_BAR; PG8_MMA(0, 0, At, B0); PG8_MMA(0, 1, At, B1); PG8_BAR; PG8_SCHED;
            PG8_LDA(At, 0, 1); PG8_STAGE(PG8_SB(0, 0), b2, voffB); PG8_STAGE(PG8_SB(0, 1), b2 + hstep, voffB); PG8_STAGE(PG8_SA(0, 0), a2, voffA);
            PG8_WAIT_V(8); PG8_WAIT_L(0); PG8_BAR; PG8_MMA(1, 0, At, B0); PG8_MMA(1, 1, At, B1); PG8_BAR; PG8_SCHED;
            PG8_LDB(B0, 1, 0); PG8_LDB(B1, 1, 1); PG8_SCHED; PG8_LDA(At, 1, 0); PG8_STAGE(PG8_SA(0, 1), a2 + hstep, voffA);
            PG8_WAIT_V(8); PG8_WAIT_L(0); PG8_BAR; PG8_MMA(0, 0, At, B0); PG8_MMA(0, 1, At, B1); PG8_BAR; PG8_SCHED;
            PG8_LDA(At, 1, 1); PG8_STAGE(PG8_SB(1, 0), b3, voffB); PG8_STAGE(PG8_SB(1, 1), b3 + hstep, voffB); PG8_STAGE(PG8_SA(1, 0), a3, voffA);
            PG8_WAIT_V(8); PG8_WAIT_L(0); PG8_BAR; PG8_MMA(1, 0, At, B0); PG8_MMA(1, 1, At, B1); PG8_BAR; PG8_SCHED;
            } else {
            PG8_LDB(B0, 0, 0); PG8_SCHED; PG8_LDA(At, 0, 0); PG8_STAGE(PG8_SA(1, 1), a1 + hstep, voffA);
            PG8_WAIT_L(8); PG8_BAR; PG8_WAIT_L(0); PG8_MMA(0, 0, At, B0); PG8_BAR; PG8_SCHED;
            PG8_LDB(B1, 0, 1); PG8_STAGE(PG8_SB(0, 0), b2, voffB);
            PG8_BAR; PG8_WAIT_L(0); PG8_MMA(0, 1, At, B1); PG8_BAR;
            PG8_LDA(At, 0, 1); PG8_STAGE(PG8_SA(0, 0), a2, voffA);
            PG8_BAR; PG8_WAIT_L(0); PG8_MMA(1, 0, At, B0); PG8_BAR; PG8_SCHED;
            PG8_STAGE(PG8_SB(0, 1), b2 + hstep, voffB);
            PG8_WAIT_V(6); PG8_BAR; PG8_MMA(1, 1, At, B1); PG8_BAR;
            PG8_LDB(B0, 1, 0); PG8_SCHED; PG8_LDA(At, 1, 0); PG8_STAGE(PG8_SA(0, 1), a2 + hstep, voffA);
            PG8_WAIT_L(8); PG8_BAR; PG8_WAIT_L(0); PG8_MMA(0, 0, At, B0); PG8_BAR; PG8_SCHED;
            PG8_LDB(B1, 1, 1); PG8_STAGE(PG8_SB(1, 0), b3, voffB);
            PG8_BAR; PG8_WAIT_L(0); PG8_MMA(0, 1, At, B1); PG8_BAR;
            PG8_LDA(At, 1, 1); PG8_STAGE(PG8_SA(1, 0), a3, voffA);
            PG8_BAR; PG8_WAIT_L(0); PG8_MMA(1, 0, At, B0); PG8_BAR; PG8_SCHED;
            PG8_STAGE(PG8_SB(1, 1), b3 + hstep, voffB);
            PG8_WAIT_V(6); PG8_BAR; PG8_MMA(1, 1, At, B1); PG8_BAR;
            }
        }
        if constexpr (ALIGN_EPI) { if (wr == 0) PG8_BAR; }
        if constexpr (FP8) asm volatile("s_nop 15\n\ts_nop 15" ::: "memory");
        if constexpr (!Epi::AFTER_DRAIN) { E(acc, cur, wr, wc, fr, fq); S.done(cur); }
        if (!has_next) break;
#pragma unroll
        for (int a = 0; a < 2; ++a)
#pragma unroll
            for (int b = 0; b < 2; ++b)
#pragma unroll
                for (int m = 0; m < 4; ++m)
#pragma unroll
                    for (int n = 0; n < 2; ++n) acc[a][b][m][n] = (f32x4){0.f, 0.f, 0.f, 0.f};
        cur = nxt; cA = nA; cB = nB; ++ui;
        if constexpr (ALIGN_EPI) { if (wr == 1) PG8_BAR; }
    }
    PG8_WAIT_V(0);
    if constexpr (!ALIGN_EPI) { if (wr == 0) PG8_BAR; }
    PG8_BAR;
    if constexpr (Epi::AFTER_DRAIN) { E.fused(acc, cur, wr, wc, fr, fq, lds, wid, lane); S.done(cur); }
#undef PG8_SA
#undef PG8_SB
#undef PG8_STAGE
#undef PG8_LDA
#undef PG8_LDB
#undef PG8_MMA
#undef PG8_CAT
#undef PG8_WAIT_V
#undef PG8_WAIT_L
#undef PG8_BAR
#undef PG8_SCHED
}
}
constexpr int DM = 2048, NB = 8, SEQ = 2048, MTOK = NB * SEQ;
constexpr int HD = 64, NAW = 1024, RWW = 1024, NHEAD = 16;
constexpr int RWP = 3488, INP = 6560, LDP = 6656;
constexpr int NE = 16, CAP = 256, FF = 2048, MEXP = NE * NB * CAP;
constexpr int GLORA = 160;
constexpr int PC_Q = 0, PC_K = 1024, PC_V = 2048, PC_RW = 3072;

constexpr size_t MiB = 1u << 20;
constexpr size_t WS_CTL = 0, CTL_ZERO_BYTES = 1 * MiB;
constexpr size_t WS_WIN = 2 * MiB;
constexpr size_t WS_WOUT = 28 * MiB;
constexpr size_t WS_G2T = 36 * MiB;
constexpr size_t WS_WGU = 38 * MiB;
constexpr size_t WS_WD = 294 * MiB;
constexpr size_t WS_H = 422 * MiB;
constexpr size_t WS_PROJ = 486 * MiB;
constexpr size_t WS_MIX = 694 * MiB;
constexpr size_t WS_WKV = 758 * MiB;
constexpr size_t WS_SB = 886 * MiB;
constexpr size_t WS_AFF = 888 * MiB;
constexpr size_t WS_GATE = 889 * MiB;
constexpr size_t WS_TOKSLOT = 890 * MiB;
constexpr size_t WS_WINQ = 892 * MiB;
constexpr size_t WS_HQ = 898 * MiB;
constexpr size_t WS_X2 = 930 * MiB;
constexpr size_t WS_END = 994 * MiB;
constexpr size_t WS_XE = WS_PROJ;
constexpr size_t WS_HID = 614 * MiB;
static_assert(WS_HID + 128 * MiB <= WS_WKV && WS_XE + 128 * MiB <= WS_HID, "overlay map");

constexpr int NWAVES = 8, NTHR = 512;
constexpr int LDS_BYTES = 163840;

#define LAS __attribute__((address_space(3)))
#define GAS __attribute__((address_space(1)))
typedef unsigned short bf16;
typedef float f32x4 __attribute__((ext_vector_type(4)));
typedef float f32x2 __attribute__((ext_vector_type(2)));
typedef short bf16x8 __attribute__((ext_vector_type(8)));
typedef short s16x4 __attribute__((ext_vector_type(4)));
typedef unsigned u32x4 __attribute__((ext_vector_type(4)));
typedef unsigned u32x2 __attribute__((ext_vector_type(2)));
#define LDS_WAIT() asm volatile("s_waitcnt lgkmcnt(0)" ::: "memory")

__device__ __forceinline__ unsigned f2bf(float f) { unsigned u = __builtin_bit_cast(unsigned, f); return (u + 0x7fffu + ((u >> 16) & 1u)) >> 16; }
typedef __bf16 bf16x2_t __attribute__((ext_vector_type(2)));
__device__ __forceinline__ unsigned pk2(float lo, float hi) { const f32x2 v = {lo, hi}; const bf16x2_t b = __builtin_convertvector(v, bf16x2_t); return __builtin_bit_cast(unsigned, b); }
__device__ __forceinline__ float bflo(unsigned u) { return __builtin_bit_cast(float, u << 16); }
__device__ __forceinline__ float bfhi(unsigned u) { return __builtin_bit_cast(float, u & 0xffff0000u); }
__device__ __forceinline__ float bf2f(unsigned short b) { return __builtin_bit_cast(float, (unsigned)b << 16); }
__device__ __forceinline__ void unpack8(const u32x4 v, float* f) { f[0] = bflo(v.x); f[1] = bfhi(v.x); f[2] = bflo(v.y); f[3] = bfhi(v.y); f[4] = bflo(v.z); f[5] = bfhi(v.z); f[6] = bflo(v.w); f[7] = bfhi(v.w); }
__device__ __forceinline__ void unpack8v(const u32x4 v, f32x2* f) { f[0] = (f32x2){bflo(v.x), bfhi(v.x)}; f[1] = (f32x2){bflo(v.y), bfhi(v.y)}; f[2] = (f32x2){bflo(v.z), bfhi(v.z)}; f[3] = (f32x2){bflo(v.w), bfhi(v.w)}; }
__device__ __forceinline__ float sigmoidf_(float x) { return __builtin_amdgcn_rcpf(1.0f + __expf(-x)); }
template <int CTRL> __device__ __forceinline__ float dppf(float x) { return __builtin_bit_cast(float, __builtin_amdgcn_update_dpp(0, __builtin_bit_cast(int, x), CTRL, 0xF, 0xF, true)); }
__device__ __forceinline__ float red8(float x) { x += dppf<0xB1>(x); x += dppf<0x4E>(x); x += dppf<0x141>(x); return x; }
__device__ __forceinline__ float wave_sum(float v) {
#pragma unroll
    for (int o = 1; o < 64; o <<= 1) v += __shfl_xor(v, o);
    return v;
}

template <class T> __device__ __forceinline__ T* gptr(T* p) {
#if defined(__HIP_DEVICE_COMPILE__)
    __builtin_assume(!__builtin_amdgcn_is_shared((const void*)p)); __builtin_assume(!__builtin_amdgcn_is_private((const void*)p));
#endif
    return p; }
struct Args {
    const float* in[24]; float* out; unsigned char* ws;
};

struct Frame {
    unsigned char* lds;
    int tid, lane, wave, G, c;
    const float* const* in;
    float* out; __attribute__((address_space(1))) unsigned char* ws;
};

__device__ __forceinline__ void p0_transpose_item(const float* W, int ldw, int k0, int n0, bf16* outp, int ldo, LAS float* scr, int lane) {
#pragma unroll
    for (int i = 0; i < 32; ++i) { const int kk = 2 * i + (lane >> 5); scr[kk * 33 + (lane & 31)] = __builtin_nontemporal_load(&W[(size_t)(k0 + kk) * ldw + n0 + (lane & 31)]); }
    LDS_WAIT(); asm volatile("" ::: "memory");
    const int c = lane & 7;
#pragma unroll
    for (int j = 0; j < 4; ++j) { const int n = (lane >> 3) + 8 * j; const LAS float* s = scr + (8 * c) * 33 + n;
        u32x4 o; o.x = pk2(s[0 * 33], s[1 * 33]); o.y = pk2(s[2 * 33], s[3 * 33]); o.z = pk2(s[4 * 33], s[5 * 33]); o.w = pk2(s[6 * 33], s[7 * 33]);
        *(u32x4*)(outp + (size_t)n * ldo + 8 * c) = o; }
    LDS_WAIT(); asm volatile("" ::: "memory");
}
__device__ __forceinline__ void p0_transpose_item_fp8(const float* W, int ldw, int k0, int n0, unsigned char* outp, int ldo, LAS float* scr, int lane) {
#pragma unroll 32
    for (int i = 0; i < 64; ++i) { const int kk = 2 * i + (lane >> 5); scr[kk * 33 + (lane & 31)] = __builtin_nontemporal_load(&W[(size_t)(k0 + kk) * ldw + n0 + (lane & 31)]); }
    LDS_WAIT(); asm volatile("" ::: "memory");
    const int c = lane & 7;
#pragma unroll
    for (int j = 0; j < 4; ++j) { const int n = (lane >> 3) + 8 * j; const LAS float* s = scr + (16 * c) * 33 + n; int o[4];
#pragma unroll
        for (int q = 0; q < 4; ++q) { int pw = __builtin_amdgcn_cvt_pk_fp8_f32(s[(4 * q) * 33] * 32.0f, s[(4 * q + 1) * 33] * 32.0f, 0, false); o[q] = __builtin_amdgcn_cvt_pk_fp8_f32(s[(4 * q + 2) * 33] * 32.0f, s[(4 * q + 3) * 33] * 32.0f, pw, true); }
        __builtin_nontemporal_store((u32x4){(unsigned)o[0], (unsigned)o[1], (unsigned)o[2], (unsigned)o[3]}, (u32x4*)(outp + (size_t)n * ldo + 16 * c)); }
    LDS_WAIT(); asm volatile("" ::: "memory");
}
__device__ __forceinline__ void rms_row_to_bf16(const float* xrow, const float* g, bf16* orow, unsigned char* qrow, int lane) {
    const f32x4* xr = (const f32x4*)xrow + lane; const f32x4* gr = (const f32x4*)g + lane;
    f32x4 v[8]; float s = 0.f;
#pragma unroll
    for (int j = 0; j < 8; ++j) { v[j] = __builtin_nontemporal_load(&xr[64 * j]); s += (v[j].x * v[j].x + v[j].y * v[j].y) + (v[j].z * v[j].z + v[j].w * v[j].w); }
    const float rstd = 1.0f / sqrtf(wave_sum(s) * (1.0f / DM) + 1e-6f);
    u32x2* o8 = (u32x2*)orow + lane; unsigned* o4 = (unsigned*)qrow + lane;
#pragma unroll
    for (int j = 0; j < 8; ++j) { const f32x4 hv = v[j] * rstd * gr[64 * j]; u32x2 w; w.x = pk2(hv.x, hv.y); w.y = pk2(hv.z, hv.w); o8[64 * j] = w;
        int pw = __builtin_amdgcn_cvt_pk_fp8_f32(hv.x, hv.y, 0, false); pw = __builtin_amdgcn_cvt_pk_fp8_f32(hv.z, hv.w, pw, true); o4[64 * j] = (unsigned)pw; }
}
__device__ __forceinline__ void p0_prologue(const Frame& F, LAS unsigned char* lds) {
    LAS float* scr = (LAS float*)(lds + F.wave * 17408);
    const int gw = F.c * NWAVES + F.wave, NGW = F.G * NWAVES;
    const float* w_in = gptr(F.in[2]); const float* w_out = gptr(F.in[18]); const float* w_gate = gptr(F.in[21]); const float* w_up = gptr(F.in[22]); const float* w_down = gptr(F.in[23]);
    bf16* WIN = (bf16*)(F.ws + WS_WIN); bf16* WOUT = (bf16*)(F.ws + WS_WOUT); unsigned char* WGU = (unsigned char*)(F.ws + WS_WGU); unsigned char* WD = (unsigned char*)(F.ws + WS_WD);
    constexpr int I_IN = 32 * 109, I_OUT = 32 * 64;
    constexpr int NITEMS = I_IN + I_OUT;
    for (int it = gw; it < NITEMS; it += NGW) {
        int r = it;
        if (r < I_IN) { const int kb = r / 109, nb = 96 + r % 109; p0_transpose_item(w_in, INP, 64 * kb, 32 * nb, WIN + (size_t)(32 * nb) * DM + 64 * kb, DM, scr, F.lane); continue; } r -= I_IN;
        { const int kb = r / 64, nb = r % 64; p0_transpose_item(w_out, DM, 64 * kb, 32 * nb, WOUT + (size_t)(32 * nb) * DM + 64 * kb, DM, scr, F.lane); }
    }
    { unsigned char* WINQ = (unsigned char*)(F.ws + WS_WINQ); for (int it = gw; it < 16 * 96; it += NGW) { const int kb = it / 96, nb = it % 96; p0_transpose_item_fp8(w_in, INP, 128 * kb, 32 * nb, WINQ + (size_t)(32 * nb) * DM + 128 * kb, DM, scr, F.lane); } }
    for (int it = gw; it < 48 * 1024; it += NGW) { const int mat = it >> 10, e = mat / 3, which = mat - 3 * e, r = it & 1023, kb = r >> 6, nb = r & 63, n0 = 32 * nb;
        if (which == 2) p0_transpose_item_fp8(w_down + (size_t)e * FF * DM, DM, 128 * kb, n0, WD + ((size_t)e * DM + n0) * FF + 128 * kb, FF, scr, F.lane);
        else { const float* W = (which == 0 ? w_gate : w_up) + (size_t)e * DM * FF; const int orow = (n0 >> 7) * 256 + which * 128 + (n0 & 127);
            p0_transpose_item_fp8(W, FF, 128 * kb, n0, WGU + ((size_t)e * 4096 + orow) * DM + 128 * kb, DM, scr, F.lane); } }
    { u32x4* z = (u32x4*)(WIN + (size_t)INP * DM); const int n16 = 96 * DM * 2 / 16; for (int i = F.c * NTHR + F.tid; i < n16; i += F.G * NTHR) z[i] = (u32x4){0u, 0u, 0u, 0u}; }
    { const float* g2 = gptr(F.in[12]); bf16* G2T = (bf16*)(F.ws + WS_G2T); for (int i = F.c * NTHR + F.tid; i < GLORA * RWW; i += F.G * NTHR) { const int n = i / GLORA, k = i % GLORA; G2T[i] = (bf16)f2bf(g2[(size_t)k * RWW + n]); } }
    { const float* x = gptr(F.in[0]); const float* g = gptr(F.in[1]); bf16* H = (bf16*)(F.ws + WS_H); unsigned char* HQ = (unsigned char*)(F.ws + WS_HQ); for (int m = gw; m < MTOK; m += NGW) rms_row_to_bf16(x + (size_t)m * DM, g, H + (size_t)m * DM, HQ + (size_t)m * DM, F.lane); }
}
#define XB_TMO      128
#define XB_XCNT(j)  (256  + 64 * (j))
#define XB_XSUB(j)  (1280 + 64 * (j))
#define XB_XGEN(j)  (2304 + 64 * (j))
#define XB_TOP      3328
#define XB_TOPGEN   3392
#define XCD_BAR_WORDS 3456
#define XB_SPIN_CAP (1u << 18)

__device__ __forceinline__ unsigned xb_ld(unsigned* p)              { return __hip_atomic_load(p, __ATOMIC_RELAXED, __HIP_MEMORY_SCOPE_AGENT); }
__device__ __forceinline__ unsigned xb_add(unsigned* p, unsigned v) { return __hip_atomic_fetch_add(p, v, __ATOMIC_RELAXED, __HIP_MEMORY_SCOPE_AGENT); }
__device__ __forceinline__ unsigned xb_xcc_id() { return (unsigned)__builtin_amdgcn_s_getreg((3 << 11) | 20) & 0xFu; }
#define XB_SPIN(cond, bar) do { unsigned _sp = 0; while (cond) { __builtin_amdgcn_s_sleep(1); \
    if ((++_sp & 255u) == 0u) { if (xb_ld(&(bar)[XB_TMO])) break; if (_sp > XB_SPIN_CAP) { atomicAdd(&(bar)[XB_TMO], 1u); break; } } } } while (0)

struct XcdBarrier {
    unsigned* bar; unsigned x;
    volatile LAS unsigned* st;
};

__device__ __forceinline__ XcdBarrier xcd_barrier_post(unsigned* bar, volatile LAS unsigned* st) {
    XcdBarrier b; b.bar = bar; b.x = xb_xcc_id(); b.st = st;
    if (threadIdx.x == 0) (void)xb_add(&bar[XB_XCNT(b.x)], 1u);
    return b;
}
__device__ __forceinline__ void xcd_barrier_complete(unsigned* bar, unsigned x, unsigned& nloc, unsigned& nx) {
    const unsigned G = gridDim.x * gridDim.y * gridDim.z;
    unsigned sum, cnt, mine, sp = 0u;
    for (;;) {
        sum = 0u; cnt = 0u; mine = 0u;
#pragma unroll
        for (unsigned j = 0; j < 16; ++j) { const unsigned c = xb_ld(&bar[XB_XCNT(j)]); sum += c; cnt += (c > 0u) ? 1u : 0u; mine = (j == x) ? c : mine; }
        if (sum == G) break;
        __builtin_amdgcn_s_sleep(1);
        if ((++sp & 255u) == 0u) { if (xb_ld(&bar[XB_TMO])) break; if (sp > XB_SPIN_CAP) { atomicAdd(&bar[XB_TMO], 1u); break; } }
    }
    nloc = mine > 0u ? mine : 1u; nx = cnt > 0u ? cnt : 1u;
}

__device__ __forceinline__ void xcd_barrier(const XcdBarrier& b) {
    asm volatile("s_waitcnt vmcnt(0)" ::: "memory");
    __syncthreads();
    if (threadIdx.x == 0) {
        unsigned* bar = b.bar;
        __builtin_amdgcn_s_waitcnt(0);
        unsigned nloc = b.st[0], nx = b.st[1];
        if (nloc == 0u) { xcd_barrier_complete(bar, b.x, nloc, nx); b.st[0] = nloc; b.st[1] = nx; }
        const unsigned old = xb_add(&bar[XB_XSUB(b.x)], 1u);
        const unsigned gen = old / nloc;
        if (old + 1u == (gen + 1u) * nloc) {
            __builtin_amdgcn_fence(__ATOMIC_RELEASE, "agent");
            asm volatile("s_waitcnt vmcnt(0)" ::: "memory");
            const unsigned og = xb_add(&bar[XB_TOP], 1u);
            const unsigned tg = og / nx;
            if (og + 1u == (tg + 1u) * nx) xb_add(&bar[XB_TOPGEN], 1u);
            else XB_SPIN(xb_ld(&bar[XB_TOPGEN]) == tg, bar);
            __builtin_amdgcn_fence(__ATOMIC_ACQUIRE, "agent");
            xb_add(&bar[XB_XGEN(b.x)], 1u);
            asm volatile("s_waitcnt vmcnt(0)" ::: "memory");
        } else {
            XB_SPIN(xb_ld(&bar[XB_XGEN(b.x)]) == gen, bar);
            __builtin_amdgcn_fence(__ATOMIC_ACQUIRE, "agent");
            asm volatile("s_waitcnt vmcnt(0)" ::: "memory");
        }
    }
    __syncthreads();
}

constexpr int NA_VSTR = 160;
constexpr int NA_OFF_V = 0, NA_OFF_RK = 512 * NA_VSTR, NA_OFF_BIAS = NA_OFF_RK + 2048, NA_OFF_ML = NA_OFF_BIAS + 1920, NA_OFF_O = NA_OFF_ML + 1024, NA_END = NA_OFF_O + 16384;
typedef short v4i16_t __attribute__((ext_vector_type(4)));
__device__ __forceinline__ s16x4 tr_read(LAS unsigned char* p) { return __builtin_bit_cast(s16x4, __builtin_amdgcn_ds_read_tr16_b64_v4i16((LAS v4i16_t*)p)); }
__device__ __forceinline__ f32x4 mfma16(bf16x8 a, bf16x8 b, f32x4 c) { return __builtin_amdgcn_mfma_f32_16x16x32_bf16(a, b, c, 0, 0, 0); }

constexpr int NA2_SLOT = 64 * NA_VSTR;
constexpr int NA2_V = 0, NA2_RK = 9 * NA2_SLOT, NA2_BIAS = NA2_RK + 9 * 256, NA2_MRG = NA2_BIAS + 1920, NA2_END = NA2_MRG + 4 * 64 * 18 * 4;
static_assert(NA2_END <= LDS_BYTES - 16, "NA LDS map");
__device__ __forceinline__ void na_phase(const Frame& F, LAS unsigned char* lds) {
    const bf16* PROJ = (const bf16*)(F.ws + WS_PROJ); bf16* MIX = (bf16*)(F.ws + WS_MIX);
    const float* qg = gptr(F.in[3]); const float* kg = gptr(F.in[4]); const float* rpb = gptr(F.in[5]);
    LAS float* BI = (LAS float*)(lds + NA2_BIAS); LAS float* MRG = (LAS float*)(lds + NA2_MRG);
    const int tid = F.tid, lane = F.lane, w = F.wave, c16 = lane & 15, g = lane >> 4, qb = w & 3, kh = w >> 2;
    constexpr float LOG2E = 1.442695041f;
    f32x2 gg[8];
#pragma unroll
    for (int j = 0; j < 4; ++j) { gg[j] = (f32x2){qg[8 * g + 2 * j] * kg[8 * g + 2 * j], qg[8 * g + 2 * j + 1] * kg[8 * g + 2 * j + 1]} * (0.125f * LOG2E);
        gg[4 + j] = (f32x2){qg[32 + 8 * g + 2 * j] * kg[32 + 8 * g + 2 * j], qg[32 + 8 * g + 2 * j + 1] * kg[32 + 8 * g + 2 * j + 1]} * (0.125f * LOG2E); }
    const int cw0 = (qb == 0) ? 0 : (qb == 1) ? 8 : (qb == 2) ? 24 : 32;
    const int qcol = 16 * qb + c16; const int cs = (qcol - 8) < 0 ? 0 : ((qcol - 8) > 48 ? 48 : (qcol - 8));
    int dcv[2][4];
#pragma unroll
    for (int cb = 0; cb < 2; ++cb)
#pragma unroll
        for (int reg = 0; reg < 4; ++reg) { const int kcol = cw0 + cb * 16 + 4 * g + reg; const bool valid = (kcol >= cs) && (kcol < cs + 16); dcv[cb][reg] = valid ? (kcol - qcol + 15) : -1; }
    const int skey = tid >> 3, sch = tid & 7;
    const unsigned koff0 = (unsigned)(((cw0 + c16) * LDP + 8 * g) * 2), koff1 = koff0 + 16 * LDP * 2, qoff = (unsigned)((qcol * LDP + 8 * g) * 2), soff = (unsigned)((skey * LDP + sch * 8) * 2);
    for (int unit = F.c; unit < 256; unit += F.G) {
        const int b = unit >> 5, h = (unit >> 1) & 15, r0 = (unit & 1) * 16;
        const size_t tokb = (size_t)b * SEQ;
        const char* rowK = (const char*)(PROJ + tokb * LDP + PC_K + h * 64); const char* rowV = (const char*)(PROJ + tokb * LDP + PC_V + h * 64); const char* rowQ = (const char*)(PROJ + tokb * LDP + PC_Q + h * 64);
        constexpr size_t ROWB = (size_t)64 * LDP * 2;
        __syncthreads();
        if (tid < 465) BI[tid] = rpb[h * 465 + tid] * LOG2E;
        { const int rs0 = (r0 - 4) < 0 ? 0 : ((r0 - 4) > 24 ? 24 : (r0 - 4)); u32x4 pv_[8], pk_[8];
#pragma unroll
            for (int i = 0; i < 8; ++i) { pv_[i] = *(const u32x4*)(rowV + (size_t)(rs0 + i) * ROWB + soff); pk_[i] = *(const u32x4*)(rowK + (size_t)(rs0 + i) * ROWB + soff); }
#pragma unroll
            for (int i = 0; i < 8; ++i) { const int slot = (rs0 + i) % 9;
                *(LAS u32x4*)(lds + NA2_V + slot * NA2_SLOT + skey * NA_VSTR + sch * 16) = pv_[i];
                float f[8]; unpack8(pk_[i], f); float ss = 0.f;
#pragma unroll
                for (int j = 0; j < 8; ++j) ss += f[j] * f[j];
                ss = red8(ss); if (sch == 0) *(LAS float*)(lds + NA2_RK + slot * 256 + skey * 4) = __builtin_amdgcn_rsqf(ss * (1.0f / 64.0f) + 1e-6f); } }
        u32x4 qraw[2], kraw[8][2];
#define NA2_ISSUE(rr) do { const int rs_ = ((rr) - 4) < 0 ? 0 : (((rr) - 4) > 24 ? 24 : ((rr) - 4)); \
            const char* qp_ = rowQ + (size_t)(rr) * ROWB + qoff; qraw[0] = *(const u32x4*)qp_; qraw[1] = *(const u32x4*)(qp_ + 64); \
            _Pragma("unroll") for (int i_ = 0; i_ < 8; ++i_) { const char* kp_ = rowK + (size_t)(rs_ + kh * 4 + (i_ >> 1)) * ROWB + ((i_ & 1) ? koff1 : koff0); kraw[i_][0] = *(const u32x4*)kp_; kraw[i_][1] = *(const u32x4*)(kp_ + 64); } } while (0)
        NA2_ISSUE(r0);
        f32x2 bs[4][2][2]; int cur_dro = 99;
        __syncthreads();
        for (int r = r0; r < r0 + 16; ++r) {
            const int rs = (r - 4) < 0 ? 0 : ((r - 4) > 24 ? 24 : (r - 4));
            const int rn = r + 1; const int rsn = (rn - 4) < 0 ? 0 : ((rn - 4) > 24 ? 24 : (rn - 4)); const bool moves = (rn < r0 + 16) && (rsn != rs);
            u32x4 nv, nk;
            { nv = *(const u32x4*)(rowV + (size_t)(rsn + 7) * ROWB + soff); nk = *(const u32x4*)(rowK + (size_t)(rsn + 7) * ROWB + soff); }
            if (rs - r != cur_dro) { cur_dro = rs - r;
#pragma unroll
                for (int kr = 0; kr < 4; ++kr)
#pragma unroll
                    for (int cb = 0; cb < 2; ++cb)
#pragma unroll
                        for (int reg = 0; reg < 4; ++reg) { const int dc = dcv[cb][reg]; const float bv_ = BI[(cur_dro + kh * 4 + kr + 7) * 31 + (dc < 0 ? 0 : dc)]; bs[kr][cb][reg >> 1][reg & 1] = dc < 0 ? -1e30f : bv_; } }
            f32x2 qf[8]; unpack8v(qraw[0], qf); unpack8v(qraw[1], qf + 4);
            f32x2 s2 = (f32x2){0.f, 0.f};
#pragma unroll
            for (int j = 0; j < 8; ++j) s2 = qf[j] * qf[j] + s2;
            float ss = s2.x + s2.y; ss += __shfl_xor(ss, 16); ss += __shfl_xor(ss, 32);
            const float rq = __builtin_amdgcn_rsqf(ss * (1.0f / 64.0f) + 1e-6f);
            u32x4 q0u, q1u; unsigned* q0p = (unsigned*)&q0u; unsigned* q1p = (unsigned*)&q1u;
#pragma unroll
            for (int j = 0; j < 4; ++j) { const f32x2 a = qf[j] * gg[j], c = qf[4 + j] * gg[4 + j]; q0p[j] = pk2(a.x, a.y); q1p[j] = pk2(c.x, c.y); }
            const bf16x8 q0 = __builtin_bit_cast(bf16x8, q0u), q1 = __builtin_bit_cast(bf16x8, q1u);
            f32x4 acc[4][2];
#pragma unroll
            for (int kr = 0; kr < 4; ++kr)
#pragma unroll
                for (int cb = 0; cb < 2; ++cb) { f32x4 a = (f32x4){0.f, 0.f, 0.f, 0.f};
                    a = mfma16(__builtin_bit_cast(bf16x8, kraw[kr * 2 + cb][0]), q0, a); a = mfma16(__builtin_bit_cast(bf16x8, kraw[kr * 2 + cb][1]), q1, a); acc[kr][cb] = a; }
            asm volatile("" : "+v"(acc[0][0]), "+v"(acc[0][1]), "+v"(acc[1][0]), "+v"(acc[1][1]), "+v"(acc[2][0]), "+v"(acc[2][1]), "+v"(acc[3][0]), "+v"(acc[3][1]));
            NA2_ISSUE(rn < r0 + 16 ? rn : r);
            f32x2 sc[4][2][2]; float mx = -1e30f;
#pragma unroll
            for (int kr = 0; kr < 4; ++kr) { const int slot = (rs + kh * 4 + kr) % 9;
#pragma unroll
                for (int cb = 0; cb < 2; ++cb) { const f32x4 rk = *(LAS f32x4*)(lds + NA2_RK + slot * 256 + (cw0 + cb * 16 + 4 * g) * 4);
                    sc[kr][cb][0] = (acc[kr][cb].xy * rk.xy) * rq + bs[kr][cb][0]; sc[kr][cb][1] = (acc[kr][cb].zw * rk.zw) * rq + bs[kr][cb][1];
                    mx = fmaxf(fmaxf(mx, fmaxf(sc[kr][cb][0].x, sc[kr][cb][0].y)), fmaxf(sc[kr][cb][1].x, sc[kr][cb][1].y)); } }
            mx = fmaxf(mx, __shfl_xor(mx, 16)); mx = fmaxf(mx, __shfl_xor(mx, 32));
            f32x2 ls2 = (f32x2){0.f, 0.f};
#pragma unroll
            for (int kr = 0; kr < 4; ++kr)
#pragma unroll
                for (int cb = 0; cb < 2; ++cb)
#pragma unroll
                    for (int hh = 0; hh < 2; ++hh) { const f32x2 d = sc[kr][cb][hh] - mx; f32x2 p; p.x = __builtin_amdgcn_exp2f(d.x); p.y = __builtin_amdgcn_exp2f(d.y); sc[kr][cb][hh] = p; ls2 = ls2 + p; }
            float lsum = ls2.x + ls2.y; lsum += __shfl_xor(lsum, 16); lsum += __shfl_xor(lsum, 32);
            f32x4 o[4];
#pragma unroll
            for (int db = 0; db < 4; ++db) o[db] = (f32x4){0.f, 0.f, 0.f, 0.f};
#pragma unroll
            for (int kr = 0; kr < 4; ++kr) {
                u32x4 pu; pu.x = pk2(sc[kr][0][0].x, sc[kr][0][0].y); pu.y = pk2(sc[kr][0][1].x, sc[kr][0][1].y); pu.z = pk2(sc[kr][1][0].x, sc[kr][1][0].y); pu.w = pk2(sc[kr][1][1].x, sc[kr][1][1].y);
                const bf16x8 pa = __builtin_bit_cast(bf16x8, pu);
                const int slot = (rs + kh * 4 + kr) % 9;
                LAS unsigned char* a0 = lds + NA2_V + slot * NA2_SLOT + (cw0 + 4 * g + (c16 >> 2)) * NA_VSTR + (c16 & 3) * 8;
#pragma unroll
                for (int db = 0; db < 4; ++db) { const s16x4 lo = tr_read(a0 + db * 32), hi = tr_read(a0 + 16 * NA_VSTR + db * 32);
                    const bf16x8 vb = (bf16x8){lo[0], lo[1], lo[2], lo[3], hi[0], hi[1], hi[2], hi[3]};
                    o[db] = mfma16(vb, pa, o[db]); } }
            LAS float* mp = MRG + (qb * 64 + lane) * 18;
            if (kh == 1) { *(LAS f32x2*)(mp + 16) = (f32x2){mx, lsum};
#pragma unroll
                for (int db = 0; db < 4; ++db) { *(LAS f32x2*)(mp + db * 4) = o[db].xy; *(LAS f32x2*)(mp + db * 4 + 2) = o[db].zw; } }
            __syncthreads();
            if (moves) { const int slot = (rsn + 7) % 9;
                *(LAS u32x4*)(lds + NA2_V + slot * NA2_SLOT + skey * NA_VSTR + sch * 16) = nv;
                float f[8]; unpack8(nk, f); float sq = 0.f;
#pragma unroll
                for (int j = 0; j < 8; ++j) sq += f[j] * f[j];
                sq = red8(sq); if (sch == 0) *(LAS float*)(lds + NA2_RK + slot * 256 + skey * 4) = __builtin_amdgcn_rsqf(sq * (1.0f / 64.0f) + 1e-6f); }
            if (kh == 0) { const f32x2 ml = *(LAS f32x2*)(mp + 16); const float mm = fmaxf(mx, ml.x); const float f0 = __builtin_amdgcn_exp2f(mx - mm), f1 = __builtin_amdgcn_exp2f(ml.x - mm); const float inv = __builtin_amdgcn_rcpf(lsum * f0 + ml.y * f1);
                const float g0 = f0 * inv, g1 = f1 * inv;
                bf16* dst = MIX + (tokb + (size_t)r * 64 + qcol) * DM + h * 64 + 4 * g;
#pragma unroll
                for (int db = 0; db < 4; ++db) { const f32x2 pa_ = *(LAS f32x2*)(mp + db * 4), pb_ = *(LAS f32x2*)(mp + db * 4 + 2);
                    const f32x2 oa = o[db].xy * g0 + pa_ * g1, ob = o[db].zw * g0 + pb_ * g1;
                    u32x2 ov; ov.x = pk2(oa.x, oa.y); ov.y = pk2(ob.x, ob.y);
                    *(u32x2*)(dst + db * 16) = ov; } }
            __syncthreads();
        }
    }
}

constexpr int PO_SGSTR = 336;
__device__ __forceinline__ void post_phase(const Frame& F, LAS unsigned char* lds) {
    const bf16* PROJ = (const bf16*)(F.ws + WS_PROJ); const bf16* G2T = (const bf16*)(F.ws + WS_G2T); const float* WKV = (const float*)(F.ws + WS_WKV); const float* SB = (const float*)(F.ws + WS_SB);
    bf16* MIX = (bf16*)(F.ws + WS_MIX); const float* mu_prev = gptr(F.in[6]); const float* mu_next = gptr(F.in[7]); const float* lnx_w = gptr(F.in[16]); const float* lnx_b = gptr(F.in[17]);
    const int lane = F.lane, w = F.wave, c16 = lane & 15, g = lane >> 4;
    for (int tile = F.c; tile < MTOK / 64; tile += F.G) {
        const int m0 = tile * 64;
        __syncthreads();
        for (int i = F.tid; i < 64 * (GLORA / 8); i += NTHR) { const int tok = i / (GLORA / 8), ch = i - tok * (GLORA / 8); const int m = m0 + tok, t = m & (SEQ - 1);
            const bf16* p = PROJ + (size_t)m * LDP + PC_RW + 3328 + 8 * ch; float c0[8], pm[8], pn[8]; unpack8(*(const u32x4*)p, c0);
            if (t > 0) unpack8(*(const u32x4*)(p - LDP), pm); else {
#pragma unroll
                for (int j = 0; j < 8; ++j) pm[j] = 0.f; }
            if (t < SEQ - 1) unpack8(*(const u32x4*)(p + LDP), pn); else {
#pragma unroll
                for (int j = 0; j < 8; ++j) pn[j] = 0.f; }
            const f32x4 mpA = *(const f32x4*)(mu_prev + 3328 + 8 * ch), mpB = *(const f32x4*)(mu_prev + 3328 + 8 * ch + 4), mnA = *(const f32x4*)(mu_next + 3328 + 8 * ch), mnB = *(const f32x4*)(mu_next + 3328 + 8 * ch + 4);
            float sg[8];
#pragma unroll
            for (int j = 0; j < 8; ++j) { const float mp = j < 4 ? mpA[j & 3] : mpB[j & 3], mn = j < 4 ? mnA[j & 3] : mnB[j & 3]; sg[j] = sigmoidf_(c0[j] + mp * (pm[j] - c0[j]) + mn * (pn[j] - c0[j])); }
            u32x4 o; o.x = pk2(sg[0], sg[1]); o.y = pk2(sg[2], sg[3]); o.z = pk2(sg[4], sg[5]); o.w = pk2(sg[6], sg[7]);
            *(LAS u32x4*)(lds + tok * PO_SGSTR + ch * 16) = o; }
        __syncthreads();
#pragma unroll 1
        for (int hd = 0; hd < 2; ++hd) {
            const int head = 2 * w + hd;
            f32x4 acc[4][4];
#pragma unroll
            for (int q = 0; q < 4; ++q)
#pragma unroll
                for (int mb = 0; mb < 4; ++mb) acc[q][mb] = (f32x4){0.f, 0.f, 0.f, 0.f};
#pragma unroll
            for (int ks = 0; ks < 5; ++ks) { bf16x8 bfr[4];
#pragma unroll
                for (int mb = 0; mb < 4; ++mb) bfr[mb] = *(LAS bf16x8*)(lds + (16 * mb + c16) * PO_SGSTR + (32 * ks + 8 * g) * 2);
#pragma unroll
                for (int q = 0; q < 4; ++q) { const bf16x8 af = *(const bf16x8*)(G2T + (size_t)(64 * head + 16 * q + c16) * GLORA + 32 * ks + 8 * g);
#pragma unroll
                    for (int mb = 0; mb < 4; ++mb) acc[q][mb] = mfma16(af, bfr[mb], acc[q][mb]); } }
#pragma unroll
            for (int mb = 0; mb < 4; ++mb) { const int m = m0 + 16 * mb + c16, t = m & (SEQ - 1); f32x4 x[4]; float s1 = 0.f;
#pragma unroll
                for (int q = 0; q < 4; ++q) { const int ch = 64 * head + 16 * q + 4 * g; x[q] = __builtin_nontemporal_load((const f32x4*)(WKV + (size_t)m * RWW + ch)) + __builtin_nontemporal_load((const f32x4*)(WKV + ((size_t)MTOK + m) * RWW + ch)); s1 += (x[q][0] + x[q][1]) + (x[q][2] + x[q][3]); }
                s1 += __shfl_xor(s1, 16); s1 += __shfl_xor(s1, 32); const float mean = s1 * (1.0f / 64.0f); float s2 = 0.f;
#pragma unroll
                for (int q = 0; q < 4; ++q) { const f32x4 d = x[q] - mean; s2 += (d[0] * d[0] + d[1] * d[1]) + (d[2] * d[2] + d[3] * d[3]); }
                s2 += __shfl_xor(s2, 16); s2 += __shfl_xor(s2, 32); const float rstd = 1.0f / sqrtf(s2 * (1.0f / 64.0f) + 64e-5f);
                const float sbv = SB[(size_t)m * 16 + head] + SB[((size_t)MTOK + m) * 16 + head];
#pragma unroll
                for (int q = 0; q < 4; ++q) { const int ch = 64 * head + 16 * q + 4 * g;
                    const bf16* pv = PROJ + (size_t)m * LDP + PC_RW + 2048 + ch; const u32x2 c0u = *(const u32x2*)pv; u32x2 pmu = (u32x2){0u, 0u}, pnu = (u32x2){0u, 0u};
                    if (t > 0) pmu = *(const u32x2*)(pv - LDP); if (t < SEQ - 1) pnu = *(const u32x2*)(pv + LDP);
                    const f32x4 c0 = (f32x4){bflo(c0u.x), bfhi(c0u.x), bflo(c0u.y), bfhi(c0u.y)}, pm = (f32x4){bflo(pmu.x), bfhi(pmu.x), bflo(pmu.y), bfhi(pmu.y)}, pn = (f32x4){bflo(pnu.x), bfhi(pnu.x), bflo(pnu.y), bfhi(pnu.y)};
                    const f32x4 mp = *(const f32x4*)(mu_prev + 2048 + ch), mn = *(const f32x4*)(mu_next + 2048 + ch);
                    const f32x4 vs = c0 + mp * (pm - c0) + mn * (pn - c0);
                    const f32x4 lw = *(const f32x4*)(lnx_w + ch), lb = *(const f32x4*)(lnx_b + ch);
                    const f32x4 y = ((x[q] - mean) * rstd * lw + lb + sbv * vs) * acc[q][mb];
                    u32x2 o; o.x = pk2(y[0], y[1]); o.y = pk2(y[2], y[3]); *(u32x2*)(MIX + (size_t)m * DM + NAW + ch) = o; }
                asm volatile("" ::: "memory"); }
        }
    }
}

__device__ __forceinline__ void norm2_router_phase(const Frame& F, LAS unsigned char* lds) {
    LAS float* WR = (LAS float*)lds; const float* wrt = gptr(F.in[20]); const float* gn = gptr(F.in[19]);
    for (int i = F.tid; i < DM * NE; i += NTHR) WR[(i & 15) * DM + (i >> 4)] = wrt[i];
    __syncthreads();
    const bf16* X2 = (const bf16*)(F.ws + WS_X2); unsigned char* H2 = (unsigned char*)(F.ws + WS_H); float* AFF = (float*)(F.ws + WS_AFF);
    const int lane = F.lane, gw = F.c * NWAVES + F.wave, NGW = F.G * NWAVES;
    for (int m = gw; m < MTOK; m += NGW) {
        const u32x2* xr = (const u32x2*)(X2 + (size_t)m * DM) + lane; const f32x4* gr = (const f32x4*)gn + lane;
        f32x4 v[8]; float s = 0.f;
#pragma unroll
        for (int j = 0; j < 8; ++j) { const u32x2 xv = xr[64 * j]; v[j] = (f32x4){bflo(xv.x), bfhi(xv.x), bflo(xv.y), bfhi(xv.y)}; s += (v[j].x * v[j].x + v[j].y * v[j].y) + (v[j].z * v[j].z + v[j].w * v[j].w); }
        const float rstd = 1.0f / sqrtf(wave_sum(s) * (1.0f / DM) + 1e-6f);
        float acc[16];
#pragma unroll
        for (int e = 0; e < 16; ++e) acc[e] = 0.f;
        unsigned* o4 = (unsigned*)(H2 + (size_t)m * DM) + lane;
#pragma unroll
        for (int j = 0; j < 8; ++j) { const f32x4 hv = v[j] * rstd * gr[64 * j]; { int pw = __builtin_amdgcn_cvt_pk_fp8_f32(hv.x, hv.y, 0, false); pw = __builtin_amdgcn_cvt_pk_fp8_f32(hv.z, hv.w, pw, true); o4[64 * j] = (unsigned)pw; }
            LAS float* wj0 = WR + 4 * (64 * j + lane); LAS float* wj1 = wj0 + 8 * DM; asm volatile("" : "+v"(wj0), "+v"(wj1));
#pragma unroll
            for (int e = 0; e < 8; ++e) { const f32x4 wa = *(const LAS f32x4*)(wj0 + e * DM), wb = *(const LAS f32x4*)(wj1 + e * DM);
                acc[e] += (hv[0] * wa[0] + hv[1] * wa[1]) + (hv[2] * wa[2] + hv[3] * wa[3]); acc[8 + e] += (hv[0] * wb[0] + hv[1] * wb[1]) + (hv[2] * wb[2] + hv[3] * wb[3]); }
            asm volatile("" ::: "memory"); }
        float r8[8], r4[4], r2[2], r1;
        { const bool up = (lane & 32) != 0;
#pragma unroll
            for (int i = 0; i < 8; ++i) { const float send = up ? acc[i] : acc[8 + i], keep = up ? acc[8 + i] : acc[i]; r8[i] = keep + __shfl_xor(send, 32); } }
        { const bool up = (lane & 16) != 0;
#pragma unroll
            for (int i = 0; i < 4; ++i) { const float send = up ? r8[i] : r8[4 + i], keep = up ? r8[4 + i] : r8[i]; r4[i] = keep + __shfl_xor(send, 16); } }
        { const bool up = (lane & 8) != 0;
#pragma unroll
            for (int i = 0; i < 2; ++i) { const float send = up ? r4[i] : r4[2 + i], keep = up ? r4[2 + i] : r4[i]; r2[i] = keep + __shfl_xor(send, 8); } }
        { const bool up = (lane & 4) != 0; const float send = up ? r2[0] : r2[1], keep = up ? r2[1] : r2[0]; r1 = keep + __shfl_xor(send, 4); }
        r1 += __shfl_xor(r1, 2); r1 += __shfl_xor(r1, 1);
        float mx = r1;
#pragma unroll
        for (int o = 4; o < 64; o <<= 1) mx = fmaxf(mx, __shfl_xor(mx, o));
        const float ex = __expf(r1 - mx); float sum = ex;
#pragma unroll
        for (int o = 4; o < 64; o <<= 1) sum += __shfl_xor(sum, o);
        if ((lane & 3) == 0) { const int e = (lane >> 2) & 15, b = m >> 11, t = m & (SEQ - 1); AFF[((size_t)b * NE + e) * SEQ + t] = ex / sum; }
    }
}

__device__ __forceinline__ int block_excl_scan(int v, int& total, LAS int* part, int lane, int wave) {
    int inc = v;
#pragma unroll
    for (int o = 1; o < 64; o <<= 1) { const int y = __shfl_up(inc, o); inc += (lane >= o) ? y : 0; }
    if (lane == 63) part[wave] = inc;
    __syncthreads();
    int base = 0, tot = 0;
#pragma unroll
    for (int ww = 0; ww < NWAVES; ++ww) { const int p = part[ww]; base += (ww < wave) ? p : 0; tot += p; }
    __syncthreads();
    total = tot; return base + inc - v;
}
__device__ __forceinline__ void topk_gather_phase(const Frame& F, LAS unsigned char* lds) {
    LAS int* IDX = (LAS int*)lds; LAS int* PART = (LAS int*)(lds + 1024); LAS int* CNT = (LAS int*)(lds + 1024 + 64);
    const float* AFF = (const float*)(F.ws + WS_AFF); float* GATE = (float*)(F.ws + WS_GATE); int* TOKSLOT = (int*)(F.ws + WS_TOKSLOT);
    const unsigned char* H2 = (unsigned char*)(F.ws + WS_H); unsigned char* XE = (unsigned char*)(F.ws + WS_XE);
    const int tid = F.tid, lane = F.lane, wave = F.wave;
    for (int uu = F.c; uu < 2 * NB * NE; uu += F.G) {
        const int u = uu >> 1, half = uu & 1, b = u >> 4, e = u & 15;
        __syncthreads();
        const u32x4 kv = *(const u32x4*)(AFF + (size_t)u * SEQ + 4 * tid);
        unsigned key[4]; key[0] = kv.x; key[1] = kv.y; key[2] = kv.z; key[3] = kv.w;
        asm volatile("" : "+v"(key[0]), "+v"(key[1]), "+v"(key[2]), "+v"(key[3]));
        unsigned T = 0u;
        for (int bit = 31; bit >= 0; --bit) { const unsigned cand = T | (1u << bit);
            int c = 0;
#pragma unroll
            for (int j = 0; j < 4; ++j) c += (key[j] >= cand) ? 1 : 0;
#pragma unroll
            for (int o = 1; o < 64; o <<= 1) c += __shfl_xor(c, o);
            if (lane == 0) CNT[(bit & 1) * 8 + wave] = c;
            __syncthreads();
            int tot = 0;
#pragma unroll
            for (int ww = 0; ww < NWAVES; ++ww) tot += CNT[(bit & 1) * 8 + ww];
            if (tot >= CAP) T = cand; }
        int ngt = 0, neq = 0;
#pragma unroll
        for (int j = 0; j < 4; ++j) { ngt += (key[j] > T) ? 1 : 0; neq += (key[j] == T) ? 1 : 0; }
        int tot_gt, tot_eq; const int eq_before = block_excl_scan(neq, tot_eq, PART, lane, wave); (void)block_excl_scan(ngt, tot_gt, PART, lane, wave);
        const int need = CAP - tot_gt;
        bool sel[4]; int nsel = 0, eqr = eq_before;
#pragma unroll
        for (int j = 0; j < 4; ++j) { const bool iseq = key[j] == T; sel[j] = (key[j] > T) || (iseq && eqr < need); eqr += iseq ? 1 : 0; nsel += sel[j] ? 1 : 0; }
        int tot_sel; int slot = block_excl_scan(nsel, tot_sel, PART, lane, wave);
#pragma unroll
        for (int j = 0; j < 4; ++j) { const int t = 4 * tid + j; const int sl = sel[j] ? slot : -1; if (half == 0) TOKSLOT[((size_t)b * SEQ + t) * NE + e] = sl;
            if (sel[j]) { IDX[slot] = t; if (half == 0) GATE[e * 2048 + b * CAP + slot] = __builtin_bit_cast(float, key[j]); ++slot; } }
        __syncthreads();
        for (int s8 = wave; s8 < CAP / 2; s8 += NWAVES) { const int sl = half * (CAP / 2) + s8; const int t = IDX[sl];
            const u32x4* src = (const u32x4*)(H2 + ((size_t)b * SEQ + t) * DM) + lane; u32x4* dst = (u32x4*)(XE + ((size_t)e * 2048 + b * CAP + sl) * DM) + lane;
#pragma unroll
            for (int j = 0; j < 2; ++j) dst[64 * j] = src[64 * j]; }
    }
}

__device__ __forceinline__ void combine_phase(const Frame& F) {
    const int* TOKSLOT = (const int*)(F.ws + WS_TOKSLOT); const bf16* YE = (const bf16*)(F.ws + WS_XE);
    const int lane = F.lane, gw = F.c * NWAVES + F.wave, NGW = F.G * NWAVES;
    for (int m = gw; m < MTOK; m += NGW) { const int b = m >> 11; const int myslot = lane < NE ? TOKSLOT[(size_t)m * NE + lane] : -1;
        f32x4* orow = (f32x4*)(F.out + (size_t)m * DM) + lane; const u32x2* xrow = (const u32x2*)((const bf16*)(F.ws + WS_X2) + (size_t)m * DM) + lane; f32x4 acc[8];
#pragma unroll
        for (int j = 0; j < 8; ++j) { const u32x2 xv = xrow[64 * j]; acc[j] = (f32x4){bflo(xv.x), bfhi(xv.x), bflo(xv.y), bfhi(xv.y)}; }
#pragma unroll
        for (int e = 0; e < NE; ++e) { const int sl = __builtin_amdgcn_readlane(myslot, e);
            if (sl >= 0) { const u32x2* yr = (const u32x2*)(YE + ((size_t)e * 2048 + b * CAP + sl) * DM) + lane;
#pragma unroll
                for (int j = 0; j < 8; ++j) { const u32x2 v = __builtin_nontemporal_load(&yr[64 * j]); acc[j] += (f32x4){bflo(v.x), bfhi(v.x), bflo(v.y), bfhi(v.y)}; } } }
#pragma unroll
        for (int j = 0; j < 8; ++j) __builtin_nontemporal_store(acc[j], &orow[64 * j]);
    }
}
constexpr int CS_ST = 160, CS_MAT = 64 * CS_ST;
constexpr int CL_LW2 = 0, CL_LA2 = CS_MAT, CL_AT = 2 * CS_MAT, CL_BT = 3 * CS_MAT, CL_KT = 4 * CS_MAT, CL_RT = 5 * CS_MAT, CL_VM = 6 * CS_MAT;
constexpr int CL_NT = 7 * CS_MAT, CL_MK = 8 * CS_MAT, CL_PBM = 9 * CS_MAT, CL_PKM = 10 * CS_MAT, CL_X1 = 11 * CS_MAT, CL_X2 = 12 * CS_MAT;
constexpr int CL_TOT = 13 * CS_MAT, CL_GL = CL_TOT + 2048, CL_CST = CL_GL + 256, CL_MU = CL_CST + 1536, CL_END = CL_MU + 3840;
constexpr int CL_WR = CL_NT, WR_ST = 272, CL_AR = CL_WR + 64 * WR_ST;
static_assert(CL_AR + 64 * WR_ST <= CL_X1 && CL_END <= LDS_BYTES - 16, "scan LDS map");
__device__ __forceinline__ bf16x8 cs_ld_row(LAS unsigned char* M, int row0, int ks, int c16, int g) { return *(LAS bf16x8*)(M + (row0 + c16) * CS_ST + (32 * ks + 8 * g) * 2); }
__device__ __forceinline__ bf16x8 cs_ld_tr(LAS unsigned char* M, int col0, int ks, int c16, int g) {
    LAS unsigned char* p = M + (32 * ks + 8 * g + (c16 >> 2)) * CS_ST + (col0 + 4 * (c16 & 3)) * 2;
    const s16x4 lo = tr_read(p), hi = tr_read(p + 4 * CS_ST);
    return (bf16x8){lo[0], lo[1], lo[2], lo[3], hi[0], hi[1], hi[2], hi[3]};
}
template <bool ATR, bool BTR> __device__ __forceinline__ void cs_mm(f32x4 (&acc)[2], LAS unsigned char* MA, LAS unsigned char* MB, int rb, int cb0, int c16, int g) {
#pragma unroll
    for (int ks = 0; ks < 2; ++ks) { const bf16x8 a = ATR ? cs_ld_tr(MA, 16 * rb, ks, c16, g) : cs_ld_row(MA, 16 * rb, ks, c16, g);
#pragma unroll
        for (int q = 0; q < 2; ++q) { const bf16x8 b = BTR ? cs_ld_tr(MB, 16 * (cb0 + q), ks, c16, g) : cs_ld_row(MB, 16 * (cb0 + q), ks, c16, g); acc[q] = mfma16(b, a, acc[q]); } }
}
__device__ __forceinline__ void cs_st(LAS unsigned char* M, int rb, int cb, const f32x4 v, int c16, int g) {
    u32x2 o; o.x = pk2(v[0], v[1]); o.y = pk2(v[2], v[3]); *(LAS u32x2*)(M + (16 * rb + c16) * CS_ST + (16 * cb + 4 * g) * 2) = o;
}
#define CS_ZERO2(a) do { a[0] = (f32x4){0.f, 0.f, 0.f, 0.f}; a[1] = (f32x4){0.f, 0.f, 0.f, 0.f}; } while (0)

__device__ __forceinline__ bf16x8 cs_ld_perm(LAS unsigned char* M, int row0, int c0, int c16, int g) { LAS unsigned char* p = M + (row0 + c16) * CS_ST + (c0 + 4 * g) * 2;
    const u32x2 lo = *(LAS u32x2*)p, hi = *(LAS u32x2*)(p + 32); return __builtin_bit_cast(bf16x8, (u32x4){lo.x, lo.y, hi.x, hi.y}); }
__device__ __forceinline__ bf16x8 cs_ld_perm16(LAS unsigned char* M, int row0, int c0, int c16, int g) { const u32x2 lo = *(LAS u32x2*)(M + (row0 + c16) * CS_ST + (c0 + 4 * g) * 2); return __builtin_bit_cast(bf16x8, (u32x4){lo.x, lo.y, 0u, 0u}); }
__device__ __forceinline__ bf16x8 cs_ld_trp(LAS unsigned char* M, int r0, int col0, int c16, int g) { LAS unsigned char* p = M + (r0 + 4 * g + (c16 >> 2)) * CS_ST + (col0 + 4 * (c16 & 3)) * 2;
    const s16x4 lo = tr_read(p), hi = tr_read(p + 16 * CS_ST); return (bf16x8){lo[0], lo[1], lo[2], lo[3], hi[0], hi[1], hi[2], hi[3]}; }
__device__ __forceinline__ bf16x8 cs_pack(const f32x4 a, const f32x4 b) { return __builtin_bit_cast(bf16x8, (u32x4){pk2(a[0], a[1]), pk2(a[2], a[3]), pk2(b[0], b[1]), pk2(b[2], b[3])}); }
__device__ __forceinline__ bf16x8 cs_pack1(const f32x4 a) { return __builtin_bit_cast(bf16x8, (u32x4){pk2(a[0], a[1]), pk2(a[2], a[3]), 0u, 0u}); }

__device__ __forceinline__ void scan_phase2(const Frame& F, LAS unsigned char* lds) {
    const bf16* PROJ = (const bf16*)(F.ws + WS_PROJ); float* WKV = (float*)(F.ws + WS_WKV); float* SBG = (float*)(F.ws + WS_SB);
    const float* mu_prev = gptr(F.in[6]); const float* mu_next = gptr(F.in[7]); const float* w0 = gptr(F.in[8]); const float* w2 = gptr(F.in[9]); const float* a0 = gptr(F.in[10]); const float* a2 = gptr(F.in[11]);
    const float* k_k = gptr(F.in[13]); const float* k_a = gptr(F.in[14]); const float* r_k = gptr(F.in[15]);
    const int tid = F.tid, lane = F.lane, w = F.wave;
    const int tl = lane & 7, cg = lane >> 3, trow = 8 * w + tl, cg8 = 8 * cg;
    const int c16 = lane & 15, g = lane >> 4, rb = w >> 1, cb0 = 2 * (w & 1);
    for (int sid = F.c; sid < 256; sid += F.G) {
        const int z = sid >> 7, b = (sid >> 4) & 7, h = sid & 15;
        __syncthreads();
        LAS unsigned char* L1 = lds; asm volatile("" : "+v"(L1));
        for (int i = tid; i < 4096; i += NTHR) { const int l = i >> 6, c = i & 63;
            *(LAS bf16*)(L1 + CL_LW2 + l * CS_ST + c * 2) = (bf16)f2bf(w2[((size_t)z * 64 + l) * RWW + h * 64 + c]);
            *(LAS bf16*)(L1 + CL_LA2 + l * CS_ST + c * 2) = (bf16)f2bf(a2[((size_t)z * 64 + l) * RWW + h * 64 + c]);
        }
        const int fc0 = 64 * h, fc1 = 1024 + 64 * h, fc2 = 2048 + 64 * h, fc3 = 3072 + 64 * z, fc4 = 3200 + 64 * z;
        { LAS float* MU = (LAS float*)(L1 + CL_MU); LAS float* CST = (LAS float*)(L1 + CL_CST);
            if (tid < 64) { const int c = tid; const int fcs[5] = {fc0, fc1, fc2, fc3, fc4};
#pragma unroll
                for (int f = 0; f < 5; ++f) { const float mp_ = mu_prev[fcs[f] + c], mn_ = mu_next[fcs[f] + c]; MU[(3 * f) * 64 + c] = 1.0f - mp_ - mn_; MU[(3 * f + 1) * 64 + c] = mp_; MU[(3 * f + 2) * 64 + c] = mn_; }
                const float ka_ = k_a[64 * h + c];
                CST[c] = w0[z * RWW + 64 * h + c]; CST[64 + c] = a0[z * RWW + 64 * h + c]; CST[128 + c] = k_k[64 * h + c]; CST[192 + c] = ka_; CST[256 + c] = 1.0f - ka_; CST[320 + c] = r_k[h * 64 + c]; } }
        f32x4 SK[4];
#pragma unroll
        for (int kb = 0; kb < 4; ++kb) SK[kb] = (f32x4){0.f, 0.f, 0.f, 0.f};
        u32x4 raw[15];
#define CS_ISSUE(cj) do { const int sidx_ = (cj) * 64 + trow; const int t_ = z ? (SEQ - 1 - sidx_) : sidx_; const bf16* p0_ = PROJ + ((size_t)b * SEQ + t_) * LDP + PC_RW + cg8; \
            const int dm_ = t_ > 0 ? -LDP : 0, dn_ = t_ < SEQ - 1 ? LDP : 0; \
            _Pragma("unroll") for (int f = 0; f < 5; ++f) { const int fc = (f == 0) ? fc0 : (f == 1) ? fc1 : (f == 2) ? fc2 : (f == 3) ? fc3 : fc4; \
                raw[3 * f] = *(const u32x4*)(p0_ + fc); raw[3 * f + 1] = *(const u32x4*)(p0_ + fc + dm_); raw[3 * f + 2] = *(const u32x4*)(p0_ + fc + dn_); } } while (0)
        CS_ISSUE(0);
        f32x2 xr[4], xk[4], xv[4];
#define CS_S0(CJ) do { \
            { const int sidx0_ = (CJ) * 64 + trow; const int t0_ = z ? (SEQ - 1 - sidx0_) : sidx0_; const bool edge = ((CJ) == 0) || ((CJ) == 31); const float fpm = t0_ > 0 ? 1.f : 0.f, fpn = t0_ < SEQ - 1 ? 1.f : 0.f; \
            _Pragma("unroll") \
                for (int f = 0; f < 5; ++f) { \
                    f32x2 c0[4], pm[4], pn[4], xs[4]; unpack8v(raw[3 * f], c0); unpack8v(raw[3 * f + 1], pm); unpack8v(raw[3 * f + 2], pn); \
                    if (edge) { \
            _Pragma("unroll") \
                        for (int i = 0; i < 4; ++i) { pm[i] = pm[i] * fpm; pn[i] = pn[i] * fpn; } } \
                    const LAS f32x4* mu = (const LAS f32x4*)&MU[(3 * f) * 64 + cg8];                   \
                    const f32x4 k0A = mu[0], k0B = mu[1], mpA = mu[16], mpB = mu[17], mnA = mu[32], mnB = mu[33]; \
                    xs[0] = c0[0] * k0A.xy + pm[0] * mpA.xy + pn[0] * mnA.xy; xs[1] = c0[1] * k0A.zw + pm[1] * mpA.zw + pn[1] * mnA.zw; \
                    xs[2] = c0[2] * k0B.xy + pm[2] * mpB.xy + pn[2] * mnB.xy; xs[3] = c0[3] * k0B.zw + pm[3] * mpB.zw + pn[3] * mnB.zw; \
                    if (f == 0) { \
            _Pragma("unroll") \
                        for (int i = 0; i < 4; ++i) xr[i] = xs[i]; } \
                    else if (f == 1) { \
            _Pragma("unroll") \
                        for (int i = 0; i < 4; ++i) xk[i] = xs[i]; } \
                    else if (f == 2) { \
            _Pragma("unroll") \
                        for (int i = 0; i < 4; ++i) xv[i] = xs[i]; } \
                    else { if (f == 3) { \
            _Pragma("unroll") \
                            for (int i = 0; i < 4; ++i) { const f32x2 a2 = xs[i] * 2.885390082f; f32x2 e2; e2.x = __builtin_amdgcn_exp2f(a2.x); e2.y = __builtin_amdgcn_exp2f(a2.y); e2 = e2 + 1.0f; \
                                f32x2 rr; rr.x = __builtin_amdgcn_rcpf(e2.x); rr.y = __builtin_amdgcn_rcpf(e2.y); xs[i] = rr * (-2.0f) + 1.0f; } }                    \
                        u32x4 pk; pk.x = pk2(xs[0].x, xs[0].y); pk.y = pk2(xs[1].x, xs[1].y); pk.z = pk2(xs[2].x, xs[2].y); pk.w = pk2(xs[3].x, xs[3].y); \
                        *(LAS u32x4*)(L0 + (f == 3 ? CL_X1 : CL_X2) + trow * CS_ST + cg8 * 2) = pk; } } } \
            } while (0)
        __syncthreads();
        { LAS unsigned char* L0 = lds; asm volatile("" : "+v"(L0)); LAS float* MU = (LAS float*)(L0 + CL_MU); CS_S0(0); }
        __syncthreads();
        for (int ci = 0; ci < 32; ++ci) {
            LAS unsigned char* L0 = lds; asm volatile("" : "+v"(L0));
            LAS float* MU = (LAS float*)(L0 + CL_MU); LAS float* CST = (LAS float*)(L0 + CL_CST);
            { f32x4 wa[2], aa[2]; CS_ZERO2(wa); CS_ZERO2(aa);
                { bf16x8 a1[2], a2_[2], b10[2], b11[2], b20[2], b21[2];
                    a1[0] = cs_ld_row(L0 + CL_X1, 16 * rb, 0, c16, g); a1[1] = cs_ld_row(L0 + CL_X1, 16 * rb, 1, c16, g); a2_[0] = cs_ld_row(L0 + CL_X2, 16 * rb, 0, c16, g); a2_[1] = cs_ld_row(L0 + CL_X2, 16 * rb, 1, c16, g);
                    b10[0] = cs_ld_tr(L0 + CL_LW2, 16 * cb0, 0, c16, g); b10[1] = cs_ld_tr(L0 + CL_LW2, 16 * cb0, 1, c16, g); b11[0] = cs_ld_tr(L0 + CL_LW2, 16 * cb0 + 16, 0, c16, g); b11[1] = cs_ld_tr(L0 + CL_LW2, 16 * cb0 + 16, 1, c16, g);
                    b20[0] = cs_ld_tr(L0 + CL_LA2, 16 * cb0, 0, c16, g); b20[1] = cs_ld_tr(L0 + CL_LA2, 16 * cb0, 1, c16, g); b21[0] = cs_ld_tr(L0 + CL_LA2, 16 * cb0 + 16, 0, c16, g); b21[1] = cs_ld_tr(L0 + CL_LA2, 16 * cb0 + 16, 1, c16, g);
                    __builtin_amdgcn_sched_barrier(0);
                    wa[0] = mfma16(b10[0], a1[0], wa[0]); wa[1] = mfma16(b11[0], a1[0], wa[1]); wa[0] = mfma16(b10[1], a1[1], wa[0]); wa[1] = mfma16(b11[1], a1[1], wa[1]);
                    aa[0] = mfma16(b20[0], a2_[0], aa[0]); aa[1] = mfma16(b21[0], a2_[0], aa[1]); aa[0] = mfma16(b20[1], a2_[1], aa[0]); aa[1] = mfma16(b21[1], a2_[1], aa[1]); }
#pragma unroll
                for (int q = 0; q < 2; ++q) { const int off = (16 * rb + c16) * WR_ST + (16 * (cb0 + q) + 4 * g) * 4; *(LAS f32x4*)(L0 + CL_WR + off) = wa[q]; *(LAS f32x4*)(L0 + CL_AR + off) = aa[q]; } }
            __syncthreads();
            CS_ISSUE(ci < 31 ? ci + 1 : 31);
            f32x2 lw[4], av[4], bv[4]; float lam[8];
            { const LAS f32x4* wrp = (const LAS f32x4*)(L0 + CL_WR + trow * WR_ST + cg8 * 4); const LAS f32x4* arp = (const LAS f32x4*)(L0 + CL_AR + trow * WR_ST + cg8 * 4);
                const f32x4 wA = wrp[0], wB = wrp[1], aA = arp[0], aB = arp[1];
                const LAS f32x4* cst = (const LAS f32x4*)&CST[cg8];
                const f32x4 w0A = cst[0], w0B = cst[1], a0A = cst[16], a0B = cst[17], kkA = cst[32], kkB = cst[33], kaA = cst[48], kaB = cst[49], okA = cst[64], okB = cst[65], rkA = cst[80], rkB = cst[81];
                const f32x2 wr_[4] = {wA.xy + w0A.xy, wA.zw + w0A.zw, wB.xy + w0B.xy, wB.zw + w0B.zw}, ar_[4] = {aA.xy + a0A.xy, aA.zw + a0A.zw, aB.xy + a0B.xy, aB.zw + a0B.zw};
                const f32x2 kkc[4] = {kkA.xy, kkA.zw, kkB.xy, kkB.zw}, kac[4] = {kaA.xy, kaA.zw, kaB.xy, kaB.zw}, okc[4] = {okA.xy, okA.zw, okB.xy, okB.zw}, rkc[4] = {rkA.xy, rkA.zw, rkB.xy, rkB.zw};
                f32x2 kk[4], ss2 = (f32x2){0.f, 0.f}, bo2 = (f32x2){0.f, 0.f};
#pragma unroll
                for (int i = 0; i < 4; ++i) { kk[i] = xk[i] * kkc[i]; ss2 = kk[i] * kk[i] + ss2; }
                float ssq = ss2.x + ss2.y;
                ssq += dppf<0x128>(ssq); ssq += __shfl_xor(ssq, 16); ssq += __shfl_xor(ssq, 32);
                const float ninv = -__builtin_amdgcn_rcpf(fmaxf(__builtin_amdgcn_sqrtf(ssq), 1e-12f));
#pragma unroll
                for (int i = 0; i < 4; ++i) { f32x2 ew = wr_[i] * (-1.442695041f), ea = ar_[i] * (-1.442695041f);
                    ew.x = __builtin_amdgcn_exp2f(ew.x); ew.y = __builtin_amdgcn_exp2f(ew.y); ea.x = __builtin_amdgcn_exp2f(ea.x); ea.y = __builtin_amdgcn_exp2f(ea.y); ew = ew + 1.0f; ea = ea + 1.0f;
                    f32x2 sw, as; sw.x = __builtin_amdgcn_rcpf(ew.x); sw.y = __builtin_amdgcn_rcpf(ew.y); as.x = __builtin_amdgcn_rcpf(ea.x); as.y = __builtin_amdgcn_rcpf(ea.y);
                    lw[i] = sw * (-0.6065306597f); av[i] = kk[i] * ninv; bv[i] = -(av[i] * as);
                    const f32x2 kd = xk[i] * (as * kac[i] + okc[i]); bo2 = xr[i] * (kd * rkc[i]) + bo2; xk[i] = kd; }
                float bon = bo2.x + bo2.y;
                bon += dppf<0x128>(bon); bon += __shfl_xor(bon, 16); bon += __shfl_xor(bon, 32);
                if (cg == 0) { const int sidx = ci * 64 + trow; const int t = z ? (SEQ - 1 - sidx) : sidx; SBG[((size_t)z * MTOK + (size_t)b * SEQ + t) * 16 + h] = 0.5f * bon; }
#pragma unroll
                for (int j = 0; j < 8; ++j) { float y = lw[j >> 1][j & 1]; float s1 = dppf<0x111>(y); y += (tl >= 1) ? s1 : 0.f; float s2 = dppf<0x112>(y); y += (tl >= 2) ? s2 : 0.f; float s4 = dppf<0x114>(y); y += (tl >= 4) ? s4 : 0.f; lam[j] = y; }
                if (tl == 7) { LAS float* TOT = (LAS float*)(L0 + CL_TOT) + w * 64 + cg8; *(LAS f32x4*)TOT = (f32x4){lam[0], lam[1], lam[2], lam[3]}; *(LAS f32x4*)(TOT + 4) = (f32x4){lam[4], lam[5], lam[6], lam[7]}; } }
            __syncthreads();
            { f32x2 pre[4];
#pragma unroll
                for (int i = 0; i < 4; ++i) pre[i] = (f32x2){lam[2 * i], lam[2 * i + 1]};
                for (int ww = 0; ww < w; ++ww) { const LAS f32x4* TOT = (const LAS f32x4*)((const LAS float*)(L0 + CL_TOT) + ww * 64 + cg8); const f32x4 tA = TOT[0], tB = TOT[1];
                    pre[0] = pre[0] + tA.xy; pre[1] = pre[1] + tA.zw; pre[2] = pre[2] + tB.xy; pre[3] = pre[3] + tB.zw; }
                u32x4 pA, pB, pK, pR, pV; unsigned* qa = (unsigned*)&pA; unsigned* qb = (unsigned*)&pB; unsigned* qk = (unsigned*)&pK; unsigned* qr = (unsigned*)&pR; unsigned* qv = (unsigned*)&pV;
#pragma unroll
                for (int i = 0; i < 4; ++i) { const f32x2 l2 = pre[i] * 1.442695041f, m2 = (pre[i] - lw[i]) * 1.442695041f; f32x2 E, Em, Ei;
                    E.x = __builtin_amdgcn_exp2f(l2.x); E.y = __builtin_amdgcn_exp2f(l2.y); Em.x = __builtin_amdgcn_exp2f(m2.x); Em.y = __builtin_amdgcn_exp2f(m2.y); Ei.x = __builtin_amdgcn_rcpf(E.x); Ei.y = __builtin_amdgcn_rcpf(E.y);
                    const f32x2 at = av[i] * Em, bt = bv[i] * Ei, kt = xk[i] * Ei, rt = xr[i] * E;
                    qa[i] = pk2(at.x, at.y); qb[i] = pk2(bt.x, bt.y); qk[i] = pk2(kt.x, kt.y); qr[i] = pk2(rt.x, rt.y); qv[i] = pk2(xv[i].x, xv[i].y);
                    if (trow == 63) *(LAS f32x2*)(L0 + CL_GL + (cg8 + 2 * i) * 4) = E; }
                *(LAS u32x4*)(L0 + CL_AT + trow * CS_ST + cg8 * 2) = pA; *(LAS u32x4*)(L0 + CL_BT + trow * CS_ST + cg8 * 2) = pB; *(LAS u32x4*)(L0 + CL_KT + trow * CS_ST + cg8 * 2) = pK;
                *(LAS u32x4*)(L0 + CL_RT + trow * CS_ST + cg8 * 2) = pR; *(LAS u32x4*)(L0 + CL_VM + trow * CS_ST + cg8 * 2) = pV; }
            __syncthreads();
#define LDROW2(dst, M, row0) do { dst[0] = cs_ld_row(M, row0, 0, c16, g); dst[1] = cs_ld_row(M, row0, 1, c16, g); } while (0)
#define LDTR2(dst, M, col0) do { dst[0] = cs_ld_tr(M, col0, 0, c16, g); dst[1] = cs_ld_tr(M, col0, 1, c16, g); } while (0)
#define MM2(acc, a, b0, b1) do { acc[0] = mfma16(b0[0], a[0], acc[0]); acc[1] = mfma16(b1[0], a[0], acc[1]); acc[0] = mfma16(b0[1], a[1], acc[0]); acc[1] = mfma16(b1[1], a[1], acc[1]); } while (0)
#define SB0() __builtin_amdgcn_sched_barrier(0)
            if (cb0 <= rb) {
                f32x4 nn[2], mk[2], pb[2], pkk[2]; CS_ZERO2(nn); CS_ZERO2(mk); CS_ZERO2(pb); CS_ZERO2(pkk);
                bf16x8 aA[2], aR[2], bB0[2], bB1[2], bK0[2], bK1[2];
                LDROW2(aA, L0 + CL_AT, 16 * rb); LDROW2(aR, L0 + CL_RT, 16 * rb); LDROW2(bB0, L0 + CL_BT, 16 * cb0); LDROW2(bB1, L0 + CL_BT, 16 * cb0 + 16); LDROW2(bK0, L0 + CL_KT, 16 * cb0); LDROW2(bK1, L0 + CL_KT, 16 * cb0 + 16);
                SB0();
                MM2(nn, aA, bB0, bB1); MM2(mk, aA, bK0, bK1); MM2(pb, aR, bB0, bB1); MM2(pkk, aR, bK0, bK1);
                const int qd = rb - cb0;
#pragma unroll
                for (int q = 0; q < 2; ++q) {
#pragma unroll
                    for (int reg = 0; reg < 4; ++reg) { const int tt_ = 16 * rb + c16, ii = 16 * (cb0 + q) + 4 * g + reg; const bool lo = ii < tt_, le = ii <= tt_;
                        nn[q][reg] = lo ? nn[q][reg] : 0.f; mk[q][reg] = lo ? mk[q][reg] : 0.f; pb[q][reg] = le ? pb[q][reg] : 0.f; pkk[q][reg] = le ? pkk[q][reg] : 0.f; }
                    if (q != qd) cs_st(L0 + CL_NT, rb, cb0 + q, nn[q], c16, g);
                    cs_st(L0 + CL_MK, rb, cb0 + q, mk[q], c16, g); cs_st(L0 + CL_PBM, rb, cb0 + q, pb[q], c16, g); cs_st(L0 + CL_PKM, rb, cb0 + q, pkk[q], c16, g); }
                if (qd < 2) {
                    const f32x4 z4 = (f32x4){0.f, 0.f, 0.f, 0.f};
                    const bf16x8 bD0 = qd ? bB1[0] : bB0[0], bD1 = qd ? bB1[1] : bB0[1];
                    f32x4 xX = mfma16(aA[0], bD0, z4); xX = mfma16(aA[1], bD1, xX);
                    const f32x4 xT = qd ? nn[1] : nn[0];
                    f32x4 pT = xT;
#pragma unroll
                    for (int reg = 0; reg < 4; ++reg) { xX[reg] = (c16 < 4 * g + reg) ? xX[reg] : 0.f; pT[reg] += (4 * g + reg == c16) ? 1.0f : 0.f; }
                    bf16x8 pX = cs_pack1(xX), pXT = cs_pack1(xT);
#pragma unroll
                    for (int lvl = 0; lvl < 3; ++lvl) {
                        const f32x4 x2 = mfma16(pXT, pX, z4);
                        const bf16x8 pPT = cs_pack1(pT);
                        f32x4 x2t = z4; if (lvl < 2) x2t = mfma16(pX, pXT, z4);
                        const bf16x8 pXn = cs_pack1(x2);
                        pT = mfma16(pXn, pPT, pT);
                        pX = pXn; if (lvl < 2) pXT = cs_pack1(x2t); }
                    cs_st(L0 + CL_NT, rb, rb, pT, c16, g); } }
            __syncthreads();
            if (w < 4) {
                const int vj = 16 * w; const f32x4 z4 = (f32x4){0.f, 0.f, 0.f, 0.f};
                bf16x8 sb[2], vB[2], ub[2]; f32x4 Zb[4], Ob[4];
                sb[0] = cs_pack(SK[0], SK[1]); sb[1] = cs_pack(SK[2], SK[3]);
                LDTR2(vB, L0 + CL_VM, vj);
#pragma unroll
                for (int tb = 0; tb < 4; ++tb) {
                    const bf16x8 aA0 = cs_ld_perm(L0 + CL_AT, 16 * tb, 0, c16, g), aA1 = cs_ld_perm(L0 + CL_AT, 16 * tb, 32, c16, g), aR0 = cs_ld_perm(L0 + CL_RT, 16 * tb, 0, c16, g), aR1 = cs_ld_perm(L0 + CL_RT, 16 * tb, 32, c16, g);
                    const bf16x8 aM0 = cs_ld_row(L0 + CL_MK, 16 * tb, 0, c16, g), aP0 = cs_ld_row(L0 + CL_PKM, 16 * tb, 0, c16, g);
                    f32x4 zz = mfma16(aA0, sb[0], z4), oo = mfma16(aR0, sb[0], z4);
                    zz = mfma16(aA1, sb[1], zz); oo = mfma16(aR1, sb[1], oo);
                    zz = mfma16(aM0, vB[0], zz); oo = mfma16(aP0, vB[0], oo);
                    if (tb >= 2) { const bf16x8 aM1 = cs_ld_row(L0 + CL_MK, 16 * tb, 1, c16, g), aP1 = cs_ld_row(L0 + CL_PKM, 16 * tb, 1, c16, g); zz = mfma16(aM1, vB[1], zz); oo = mfma16(aP1, vB[1], oo); }
                    Zb[tb] = zz; Ob[tb] = oo; }
                { const bf16x8 t00 = cs_ld_perm16(L0 + CL_NT, 0, 0, c16, g), n10 = cs_ld_perm16(L0 + CL_NT, 16, 0, c16, g), t11 = cs_ld_perm16(L0 + CL_NT, 16, 16, c16, g);
                  const bf16x8 n2x = cs_ld_perm(L0 + CL_NT, 32, 0, c16, g), n3x = cs_ld_perm(L0 + CL_NT, 48, 0, c16, g), t22 = cs_ld_perm16(L0 + CL_NT, 32, 32, c16, g), n32 = cs_ld_perm16(L0 + CL_NT, 48, 32, c16, g), t33 = cs_ld_perm16(L0 + CL_NT, 48, 48, c16, g);
                  const f32x4 u0 = mfma16(t00, cs_pack1(Zb[0]), z4);
                  const f32x4 z1 = mfma16(n10, cs_pack1(u0), Zb[1]);
                  const f32x4 u1 = mfma16(t11, cs_pack1(z1), z4);
                  ub[0] = cs_pack(u0, u1);
                  const f32x4 z2 = mfma16(n2x, ub[0], Zb[2]);
                  f32x4 z3 = mfma16(n3x, ub[0], Zb[3]);
                  const f32x4 u2 = mfma16(t22, cs_pack1(z2), z4);
                  z3 = mfma16(n32, cs_pack1(u2), z3);
                  const f32x4 u3 = mfma16(t33, cs_pack1(z3), z4);
                  ub[1] = cs_pack(u2, u3); }
#pragma unroll
                for (int tb = 0; tb < 4; ++tb) { f32x4 oo = mfma16(cs_ld_perm(L0 + CL_PBM, 16 * tb, 0, c16, g), ub[0], Ob[tb]);
                    if (tb >= 2) oo = mfma16(cs_ld_perm(L0 + CL_PBM, 16 * tb, 32, c16, g), ub[1], oo);
#pragma unroll
                    for (int i = 0; i < 4; ++i) { const int ts = ci * 64 + 16 * tb + 4 * g + i; const int tt_ = z ? (SEQ - 1 - ts) : ts; WKV[((size_t)z * MTOK + (size_t)b * SEQ + tt_) * RWW + h * 64 + vj + c16] = oo[i]; } }
#pragma unroll
                for (int kb = 0; kb < 4; ++kb) { f32x4 acc = SK[kb];
                    acc = mfma16(cs_ld_trp(L0 + CL_BT, 0, 16 * kb, c16, g), ub[0], acc); acc = mfma16(cs_ld_trp(L0 + CL_BT, 32, 16 * kb, c16, g), ub[1], acc);
                    acc = mfma16(cs_ld_tr(L0 + CL_KT, 16 * kb, 0, c16, g), vB[0], acc); acc = mfma16(cs_ld_tr(L0 + CL_KT, 16 * kb, 1, c16, g), vB[1], acc);
                    const f32x4 gl = *(LAS f32x4*)(L0 + CL_GL + (16 * kb + 4 * g) * 4); SK[kb] = acc * gl; }
            }
            if (ci < 31) { CS_S0(ci + 1); }
            __syncthreads();
        }
    }
}
#ifndef PROBE_PHASE
#define PROBE_PHASE -1
#endif
#ifdef PROBE_NOBAR
#define PROBE_SEAM() __syncthreads()
#else
#define PROBE_SEAM() xcd_barrier(xbar)
#endif
#define REP(k) for (int rep_ = 0; rep_ < ((k) == PROBE_PHASE ? 2 : 1); ++rep_)
#ifndef SP2
#define SP2 true
#endif
#ifndef FP8_SP2
#define FP8_SP2 true
#endif
#ifndef ALIGN_EPI
#define ALIGN_EPI true
#endif
__global__ void __launch_bounds__(NTHR, 2) fwd_kernel(Args args) {
    extern __shared__ __attribute__((aligned(16))) unsigned char lds_raw[];
    cg::grid_group grid = cg::this_grid();
    LAS unsigned char* lds = (LAS unsigned char*)lds_raw;
#define MKFRAME() Frame F; { int t_ = threadIdx.x; asm volatile("" : "+v"(t_)); unsigned char* w_ = args.ws; asm volatile("" : "+s"(w_)); \
    F.lds = lds_raw; F.tid = t_; F.lane = t_ & 63; F.wave = __builtin_amdgcn_readfirstlane(t_ >> 6); F.G = gridDim.x; F.c = blockIdx.x; F.in = args.in; F.out = gptr(args.out); F.ws = (GAS unsigned char*)w_; } \
    GAS unsigned char* ws = F.ws; (void)ws
    if (args.out == nullptr) grid.sync();
    { volatile LAS unsigned* st = (volatile LAS unsigned*)(lds + LDS_BYTES - 16); if (threadIdx.x < 4) st[threadIdx.x] = 0u; }
    __syncthreads();
    const XcdBarrier xbar = xcd_barrier_post((unsigned*)(args.ws + WS_CTL), (volatile LAS unsigned*)(lds + LDS_BYTES - 16));
#if !defined(ONLY) || ONLY==0
    REP(0) { if (rep_) { __syncthreads(); } MKFRAME(); p0_prologue(F, lds); }
#endif
    xcd_barrier(xbar);
#if !defined(ONLY) || ONLY==1
    REP(1) { if (rep_) xcd_barrier(xbar);
    { MKFRAME();
      const bool even = (F.G == 256);
      { pg8::Gemm g{(const pg8::bf16_t*)(ws + WS_HQ), (const pg8::bf16_t*)(ws + WS_WINQ), MTOK, 3072, DM / 2}; pg8::SplitOrder S; S.init3(MTOK, 3072, F.G, F.c, even ? 2 : (1 << 20), even ? 2 : 0, 128, 256);
        pg8::EpiStoreBf16 E{(pg8::bf16_t*)(ws + WS_PROJ), LDP};
        pg8::gemm_phase<pg8::EpiStoreBf16, pg8::SplitOrder, ALIGN_EPI, FP8_SP2, true, 0x7A7A7A7A>(lds, g, S, E); }
      { pg8::Gemm g{(const pg8::bf16_t*)(ws + WS_H), (const pg8::bf16_t*)(ws + WS_WIN) + (size_t)3072 * DM, MTOK, 3584, DM}; pg8::SplitOrder S; S.init3(MTOK, 3584, F.G, F.c, even ? 3 : (1 << 20), even ? 1 : 0, 0, 128);
        pg8::EpiStoreBf16 E{(pg8::bf16_t*)(ws + WS_PROJ) + 3072, LDP};
        pg8::gemm_phase<pg8::EpiStoreBf16, pg8::SplitOrder, ALIGN_EPI, SP2>(lds, g, S, E); } } }
#endif
    xcd_barrier(xbar);
#if !defined(ONLY) || ONLY==2
    REP(2) { if (rep_) { PROBE_SEAM(); } MKFRAME(); na_phase(F, lds); }
#endif
#if !defined(ONLY) || ONLY==3
    REP(3) { if (rep_) { PROBE_SEAM(); } MKFRAME(); scan_phase2(F, lds); }
#endif
    xcd_barrier(xbar);
#if !defined(ONLY) || ONLY==4
    REP(4) { if (rep_) { PROBE_SEAM(); } MKFRAME(); post_phase(F, lds); }
#endif
    xcd_barrier(xbar);
#if !defined(ONLY) || ONLY==5
    REP(5) { if (rep_) xcd_barrier(xbar);
    { MKFRAME(); pg8::Gemm g{(const pg8::bf16_t*)(ws + WS_MIX), (const pg8::bf16_t*)(ws + WS_WOUT), MTOK, DM, DM}; pg8::StaticOrder S; S.init(MTOK, DM, F.G, F.c);
      pg8::EpiResBf16 E{gptr(args.in[0]), (pg8::bf16_t*)(ws + WS_X2), DM};
      pg8::gemm_phase<pg8::EpiResBf16, pg8::StaticOrder, ALIGN_EPI, SP2>(lds, g, S, E); } }
#endif
    xcd_barrier(xbar);
#if !defined(ONLY) || ONLY==6
    REP(6) { if (rep_) xcd_barrier(xbar); MKFRAME(); norm2_router_phase(F, lds); }
#endif
    xcd_barrier(xbar);
#if !defined(ONLY) || ONLY==7
    REP(7) { if (rep_) xcd_barrier(xbar); MKFRAME(); topk_gather_phase(F, lds); }
#endif
    xcd_barrier(xbar);
#if !defined(ONLY) || ONLY==8
    REP(8) { if (rep_) xcd_barrier(xbar);
    { MKFRAME(); pg8::Gemm g{(const pg8::bf16_t*)(ws + WS_XE), (const pg8::bf16_t*)(ws + WS_WGU), MEXP, 4096, DM / 2}; pg8::MoeOrder S; S.init2(16, F.G, F.c);
      pg8::EpiSwiGLU E{(unsigned char*)(ws + WS_HID)};
      pg8::gemm_phase<pg8::EpiSwiGLU, pg8::MoeOrder, ALIGN_EPI, FP8_SP2, true, 0x7A7A7A7A>(lds, g, S, E); } }
#endif
    xcd_barrier(xbar);
#if !defined(ONLY) || ONLY==9
    REP(9) { if (rep_) xcd_barrier(xbar);
    { MKFRAME(); pg8::Gemm g{(const pg8::bf16_t*)(ws + WS_HID), (const pg8::bf16_t*)(ws + WS_WD), MEXP, 2048, FF / 2}; pg8::MoeOrder S; S.init2(8, F.G, F.c);
      pg8::EpiDownScale E{(pg8::bf16_t*)(ws + WS_XE), (const float*)(ws + WS_GATE)};
      pg8::gemm_phase<pg8::EpiDownScale, pg8::MoeOrder, ALIGN_EPI, FP8_SP2, true, 0x7A7A7A7A>(lds, g, S, E); } }
#endif
    xcd_barrier(xbar);
#ifdef PROBE_BARRIERS
    for (int pb_ = 0; pb_ < PROBE_BARRIERS; ++pb_) xcd_barrier(xbar);
#endif
#if !defined(ONLY) || ONLY==10
    { MKFRAME(); combine_phase(F); }
#endif
}

extern "C" void kernel_launch(void* const* d_in, const int* in_sizes, int n_in, void* d_out, int out_size, void* d_ws, size_t ws_size, hipStream_t stream) {
    static int grid = 0;
    if (grid == 0) {
        if (n_in != 24 || out_size != MTOK * DM || ws_size < WS_END) { fprintf(stderr, "kernel_launch: unexpected shapes (n_in %d, out %d, ws %zu)\n", n_in, out_size, ws_size); grid = -1; return; }
        int dev = 0, cus = 0, per_cu = 0;
        if (hipGetDevice(&dev) != hipSuccess || hipDeviceGetAttribute(&cus, hipDeviceAttributeMultiprocessorCount, dev) != hipSuccess) { grid = -1; return; }
        if (hipFuncSetAttribute((const void*)fwd_kernel, hipFuncAttributeMaxDynamicSharedMemorySize, LDS_BYTES) != hipSuccess) { fprintf(stderr, "kernel_launch: hipFuncSetAttribute failed\n"); grid = -1; return; }
        if (hipOccupancyMaxActiveBlocksPerMultiprocessor(&per_cu, (const void*)fwd_kernel, NTHR, LDS_BYTES) != hipSuccess || per_cu < 1) { fprintf(stderr, "kernel_launch: occupancy query failed (%d)\n", per_cu); (void)hipGetLastError(); per_cu = 1; }
        grid = cus * per_cu;
    }
    if (grid < 0) return;
    if (hipMemsetAsync((char*)d_ws + WS_CTL, 0, 65536, stream) != hipSuccess) { fprintf(stderr, "kernel_launch: memset failed\n"); return; }
    Args a{};
    for (int i = 0; i < 24; ++i) a.in[i] = (const float*)d_in[i];
    a.out = (float*)d_out; a.ws = (unsigned char*)d_ws;
    void* kargs[] = {&a};
    hipError_t e = hipLaunchCooperativeKernel((const void*)fwd_kernel, dim3(grid), dim3(NTHR), kargs, LDS_BYTES, stream);
    if (e != hipSuccess) fprintf(stderr, "kernel_launch: cooperative launch failed: %s (grid %d)\n", hipGetErrorString(e), grid);
}
```

```cpp
#include <hip/hip_runtime.h>
#include <hip/hip_cooperative_groups.h>
#include <cstdio>
#include <cstdint>
namespace cg = cooperative_groups;

namespace pg8 {
#define PG8_LAS __attribute__((address_space(3)))
typedef unsigned short bf16_t;
typedef short bf16x8 __attribute__((ext_vector_type(8)));
typedef float f32x4 __attribute__((ext_vector_type(4)));
typedef unsigned u32x4 __attribute__((ext_vector_type(4)));
constexpr int BM = 256, BK = 64, HALF = 128, HTB = HALF * BK * 2  , STAGE_BYTES = 8 * HTB, NXCD = 8, WGM = 8;

__host__ __device__ __forceinline__ int lds_byte(int r, int c) { const int st = (r >> 4) * 2 + (c >> 5), rr = r & 15, cc = c & 31, ob = rr * 64 + cc * 2; return st * 1024 + (ob ^ (((ob >> 9) & 1) << 5)); }
__host__ __device__ __forceinline__ void stage_rc(int b, int& R, int& C) { const int st = b / 1024, sb = b % 1024, swz = sb ^ (((sb >> 9) & 1) << 5); R = (st >> 1) * 16 + swz / 64; C = (st & 1) * 32 + (swz % 64) / 2; }
__host__ __device__ __forceinline__ int perm32(int rho) { const int n = rho >> 4, i = rho & 15; return 8 * (i >> 2) + 4 * n + (i & 3); }

struct Unit { int pm, pn; };
struct Gemm { const bf16_t* A; const bf16_t* Bt; int M, N, K; };

struct StaticOrder {
    int nM, nN, nwg, G, c;
    __host__ __device__ void init(int M, int N, int G_, int c_) { nM = M / BM; nN = N / BM; nwg = nM * nN; G = G_; c = c_; }
    __host__ __device__ bool next(int i, Unit& u) const {
        const long L = (long)i * G + c; if (L >= nwg) return false;
        int wgid = (int)L; { const int q = nwg / NXCD, r = nwg % NXCD, xcd = wgid % NXCD, off = wgid / NXCD; wgid = (xcd < r ? xcd * (q + 1) : r * (q + 1) + (xcd - r) * q) + off; }
        const int nig = WGM * nN, gid = wgid / nig, fm = gid * WGM, gsz = (nM - fm) < WGM ? (nM - fm) : WGM;
        u.pm = fm + ((wgid % nig) % gsz); u.pn = (wgid % nig) / gsz; return true;
    }
    __device__ __forceinline__ void a_ready(const Unit&) const {}
    __device__ __forceinline__ void done(const Unit&) const {}
};

__device__ __forceinline__ unsigned cvt_pk_bf16(float lo, float hi) { unsigned r; asm volatile("v_cvt_pk_bf16_f32 %0, %1, %2" : "=v"(r) : "v"(lo), "v"(hi)); return r; }

struct EpiStoreBf16 {
    static constexpr bool PERM = true, AFTER_DRAIN = false;
    bf16_t* O; int ldc;
    __device__ __forceinline__ void operator()(const f32x4 (&acc)[2][2][4][2], const Unit& u, int wr, int wc, int fr, int fq) const {
        const int row0 = u.pm * BM + wr * 64 + fr, col0 = u.pn * BM + wc * 32 + 8 * fq;
#pragma unroll
        for (int ai = 0; ai < 2; ++ai)
#pragma unroll
            for (int m = 0; m < 4; ++m) { bf16_t* rowp = O + (size_t)(row0 + ai * HALF + m * 16) * ldc + col0;
#pragma unroll
                for (int bj = 0; bj < 2; ++bj) { const f32x4 v0 = acc[ai][bj][m][0], v1 = acc[ai][bj][m][1];
                    u32x4 w; w.x = cvt_pk_bf16(v0[0], v0[1]); w.y = cvt_pk_bf16(v0[2], v0[3]); w.z = cvt_pk_bf16(v1[0], v1[1]); w.w = cvt_pk_bf16(v1[2], v1[3]);
                    *(u32x4*)(rowp + bj * HALF) = w; } }
    }
};
struct EpiResF32 {
    static constexpr bool PERM = false, AFTER_DRAIN = false;
    const float* base; float* out; int ldc;
    __device__ __forceinline__ void operator()(const f32x4 (&acc)[2][2][4][2], const Unit& u, int wr, int wc, int fr, int fq) const {
        const int row0 = u.pm * BM + wr * 64 + fr, col0 = u.pn * BM + wc * 32 + 4 * fq;
#pragma unroll
        for (int ai = 0; ai < 2; ++ai)
#pragma unroll
            for (int m = 0; m < 4; ++m) { const size_t off = (size_t)(row0 + ai * HALF + m * 16) * ldc + col0;
#pragma unroll
                for (int bj = 0; bj < 2; ++bj)
#pragma unroll
                    for (int n = 0; n < 2; ++n) { const f32x4 b = *(const f32x4*)(base + off + bj * HALF + n * 16); *(f32x4*)(out + off + bj * HALF + n * 16) = b + acc[ai][bj][m][n]; } }
    }
};
struct EpiResBf16 {
    static constexpr bool PERM = true, AFTER_DRAIN = false;
    const float* base; bf16_t* out; int ldc;
    __device__ __forceinline__ void operator()(const f32x4 (&acc)[2][2][4][2], const Unit& u, int wr, int wc, int fr, int fq) const {
        const int row0 = u.pm * BM + wr * 64 + fr, col0 = u.pn * BM + wc * 32 + 8 * fq;
#pragma unroll
        for (int ai = 0; ai < 2; ++ai)
#pragma unroll
            for (int m = 0; m < 4; ++m) { const size_t off = (size_t)(row0 + ai * HALF + m * 16) * ldc + col0;
#pragma unroll
                for (int bj = 0; bj < 2; ++bj) { const f32x4 v0 = __builtin_nontemporal_load((const f32x4*)(base + off + bj * HALF)) + acc[ai][bj][m][0], v1 = __builtin_nontemporal_load((const f32x4*)(base + off + bj * HALF + 4)) + acc[ai][bj][m][1];
                    u32x4 w; w.x = cvt_pk_bf16(v0[0], v0[1]); w.y = cvt_pk_bf16(v0[2], v0[3]); w.z = cvt_pk_bf16(v1[0], v1[1]); w.w = cvt_pk_bf16(v1[2], v1[3]);
                    *(u32x4*)(out + off + bj * HALF) = w; } }
    }
};
struct EpiSwiGLU {
    static constexpr bool PERM = true, AFTER_DRAIN = false;
    unsigned char* O;
    __device__ __forceinline__ void operator()(const f32x4 (&acc)[2][2][4][2], const Unit& u, int wr, int wc, int fr, int fq) const {
        const int row0 = u.pm * BM + wr * 64 + fr, col0 = (u.pn & 15) * HALF + wc * 32 + 8 * fq;
#pragma unroll
        for (int ai = 0; ai < 2; ++ai)
#pragma unroll
            for (int m = 0; m < 4; ++m) { unsigned char* rowp = O + (size_t)(row0 + ai * HALF + m * 16) * 2048 + col0;
                float h[8];
#pragma unroll
                for (int n = 0; n < 2; ++n)
#pragma unroll
                    for (int j = 0; j < 4; ++j) { const float gt = acc[ai][0][m][n][j], up = acc[ai][1][m][n][j];
                        h[n * 4 + j] = gt * __builtin_amdgcn_rcpf(1.0f + __expf(-gt)) * up; }
                int p0 = __builtin_amdgcn_cvt_pk_fp8_f32(h[0], h[1], 0, false); p0 = __builtin_amdgcn_cvt_pk_fp8_f32(h[2], h[3], p0, true);
                int p1 = __builtin_amdgcn_cvt_pk_fp8_f32(h[4], h[5], 0, false); p1 = __builtin_amdgcn_cvt_pk_fp8_f32(h[6], h[7], p1, true);
                typedef int i32x2 __attribute__((ext_vector_type(2))); *(i32x2*)rowp = (i32x2){p0, p1}; }
    }
};
struct EpiDownScale {
    static constexpr bool PERM = true, AFTER_DRAIN = false;
    bf16_t* O; const float* gate;
    __device__ __forceinline__ void operator()(const f32x4 (&acc)[2][2][4][2], const Unit& u, int wr, int wc, int fr, int fq) const {
        const int row0 = u.pm * BM + wr * 64 + fr, col0 = (u.pn & 7) * BM + wc * 32 + 8 * fq;
#pragma unroll
        for (int ai = 0; ai < 2; ++ai)
#pragma unroll
            for (int m = 0; m < 4; ++m) { const int row = row0 + ai * HALF + m * 16; const float gs = gate[row]; bf16_t* rowp = O + (size_t)row * 2048 + col0;
#pragma unroll
                for (int bj = 0; bj < 2; ++bj) { const f32x4 v0 = acc[ai][bj][m][0] * gs, v1 = acc[ai][bj][m][1] * gs;
                    u32x4 w; w.x = cvt_pk_bf16(v0[0], v0[1]); w.y = cvt_pk_bf16(v0[2], v0[3]); w.z = cvt_pk_bf16(v1[0], v1[1]); w.w = cvt_pk_bf16(v1[2], v1[3]);
                    *(u32x4*)(rowp + bj * HALF) = w; } }
    }
};
struct MoeOrder : StaticOrder {
    int nNl;
    __device__ void init2(int nNl_, int G_, int c_) { nNl = nNl_; init(32768, nNl_ * BM, G_, c_); }
    __device__ bool next(int i, Unit& u) const { if (!StaticOrder::next(i, u)) return false; u.pn += (u.pm >> 3) * nNl; return true; }
};

struct SplitOrder : StaticOrder {
    int full_rounds, xrounds, xlo, xhi;
    __device__ void init3(int M, int N, int G_, int c_, int fr_, int xr_, int xlo_, int xhi_) { init(M, N, G_, c_); full_rounds = fr_; xrounds = xr_; xlo = xlo_; xhi = xhi_; }
    __device__ bool next(int i, Unit& u) const {
        long L;
        if (i < full_rounds) L = (long)i * G + c;
        else { const int j = i - full_rounds; if (j >= xrounds || c < xlo || c >= xhi) return false; L = (long)full_rounds * G + (long)j * (xhi - xlo) + (c - xlo); }
        if (L >= nwg) return false;
        int wgid = (int)L; { const int q = nwg / NXCD, r = nwg % NXCD, xcd = wgid % NXCD, off = wgid / NXCD; wgid = (xcd < r ? xcd * (q + 1) : r * (q + 1) + (xcd - r) * q) + off; }
        const int nig = WGM * nN, gid = wgid / nig, fm = gid * WGM, gsz = (nM - fm) < WGM ? (nM - fm) : WGM;
        u.pm = fm + ((wgid % nig) % gsz); u.pn = (wgid % nig) / gsz; return true;
    }
};
template <class Epi, class Sched, bool ALIGN_EPI = false, bool SP2 = false, bool FP8 = false, int WSC = 0x7F7F7F7F>
__device__ __forceinline__ void gemm_phase(PG8_LAS unsigned char* lds, const Gemm g, const Sched& S, const Epi& E) {
    int tid_ = threadIdx.x; asm volatile("" : "+v"(tid_));
    const int tid = tid_, wid = __builtin_amdgcn_readfirstlane(tid >> 6), lane = tid & 63, wr = wid >> 2, wc = wid & 3, fr = lane & 15, fq = lane >> 4;
    const int K = g.K, nt = K / BK;
    unsigned voffA[2], voffB[2];
#pragma unroll
    for (int i = 0; i < 2; ++i) { int R, C; stage_rc(tid * 16 + i * 8192, R, C); const int Rb = Epi::PERM ? ((R & ~31) + perm32(R & 31)) : R;
        voffA[i] = (unsigned)(R * K + C) * 2u; voffB[i] = (unsigned)(Rb * K + C) * 2u; }
    const size_t kstep = (size_t)(BK * 2);
    const size_t hstep = (size_t)HALF * K * 2;
    const size_t tstep = 2 * hstep;
    const unsigned ldsw = (unsigned)wid * 1024u;
    const int aoff = lds_byte(wr * 64 + fr, fq * 8), boff = lds_byte(wc * 32 + fr, fq * 8);
typedef int pg8_v8i __attribute__((ext_vector_type(8))); typedef short pg8_s16 __attribute__((ext_vector_type(16)));
#define PG8_CAT(lo, hi) __builtin_bit_cast(pg8_v8i, __builtin_shufflevector(lo, hi, 0, 1, 2, 3, 4, 5, 6, 7, 8, 9, 10, 11, 12, 13, 14, 15))
#define PG8_SA(b, h) (((b) * 2 + (h)) * HTB)
#define PG8_SB(b, h) ((4 + (b) * 2 + (h)) * HTB)
#define PG8_STAGE(bufoff, gbase, voff) do { _Pragma("unroll") for (int _i = 0; _i < 2; ++_i) \
        __builtin_amdgcn_global_load_lds((const unsigned*)((const char*)(gbase) + (voff)[_i]), (PG8_LAS unsigned*)(lds + (bufoff) + ldsw + _i * 8192), 16, 0, 0); } while (0)
#define PG8_LDA(dst, b, h) do { if constexpr (FP8) { _Pragma("unroll") for (int m = 0; m < 4; ++m) { const bf16x8 lo_ = *(const PG8_LAS bf16x8*)(lds + PG8_SA(b, h) + aoff + m * 2048), hi_ = *(const PG8_LAS bf16x8*)(lds + PG8_SA(b, h) + aoff + m * 2048 + 1024); dst##8[m] = PG8_CAT(lo_, hi_); } } \
        else { _Pragma("unroll") for (int m = 0; m < 4; ++m) _Pragma("unroll") for (int k = 0; k < 2; ++k) dst[m][k] = *(const PG8_LAS bf16x8*)(lds + PG8_SA(b, h) + aoff + m * 2048 + k * 1024); } } while (0)
#define PG8_LDB(dst, b, h) do { if constexpr (FP8) { _Pragma("unroll") for (int n = 0; n < 2; ++n) { const bf16x8 lo_ = *(const PG8_LAS bf16x8*)(lds + PG8_SB(b, h) + boff + n * 2048), hi_ = *(const PG8_LAS bf16x8*)(lds + PG8_SB(b, h) + boff + n * 2048 + 1024); dst##8[n] = PG8_CAT(lo_, hi_); } } \
        else { _Pragma("unroll") for (int n = 0; n < 2; ++n) _Pragma("unroll") for (int k = 0; k < 2; ++k) dst[n][k] = *(const PG8_LAS bf16x8*)(lds + PG8_SB(b, h) + boff + n * 2048 + k * 1024); } } while (0)
#define PG8_MMA(ai, bj, At, Bt) do { __builtin_amdgcn_s_setprio(1); \
        if constexpr (FP8) { _Pragma("unroll") for (int m = 0; m < 4; ++m) _Pragma("unroll") for (int n = 0; n < 2; ++n) \
            asm volatile("v_mfma_scale_f32_16x16x128_f8f6f4 %0, %1, %2, %0, %3, %4 op_sel_hi:[0,0,0]" : "+v"(acc[ai][bj][m][n]) : "v"(Bt##8[n]), "v"(At##8[m]), "v"(fp8_wsc), "v"(fp8_one)); }     \
        else { _Pragma("unroll") for (int m = 0; m < 4; ++m) _Pragma("unroll") for (int n = 0; n < 2; ++n) _Pragma("unroll") for (int k = 0; k < 2; ++k) \
            acc[ai][bj][m][n] = __builtin_amdgcn_mfma_f32_16x16x32_bf16(Bt[n][k], At[m][k], acc[ai][bj][m][n], 0, 0, 0); } \
        __builtin_amdgcn_s_setprio(0); } while (0)
#define PG8_WAIT_V(n) asm volatile("s_waitcnt vmcnt(" #n ")" ::: "memory")
#define PG8_WAIT_L(n) asm volatile("s_waitcnt lgkmcnt(" #n ")" ::: "memory")
#define PG8_BAR __builtin_amdgcn_s_barrier()
#define PG8_SCHED __builtin_amdgcn_sched_barrier(0)
    Unit cur, nxt; int ui = 0;
    if (!S.next(0, cur)) return;
    f32x4 acc[2][2][4][2];
#pragma unroll
    for (int a = 0; a < 2; ++a)
#pragma unroll
        for (int b = 0; b < 2; ++b)
#pragma unroll
            for (int m = 0; m < 4; ++m)
#pragma unroll
                for (int n = 0; n < 2; ++n) acc[a][b][m][n] = (f32x4){0.f, 0.f, 0.f, 0.f};
    int fp8_wsc = WSC, fp8_one = 0x7F7F7F7F; if constexpr (FP8) asm volatile("" : "+v"(fp8_wsc), "+v"(fp8_one));
    bf16x8 At[4][2], B0[2][2], B1[2][2]; pg8_v8i At8[4], B08[2], B18[2];
    const char* cA = (const char*)g.A + (size_t)cur.pm * tstep; const char* cB = (const char*)g.Bt + (size_t)cur.pn * tstep;
    S.a_ready(cur);
    if constexpr (SP2) {
        PG8_STAGE(PG8_SB(0, 0), cB, voffB); PG8_STAGE(PG8_SB(0, 1), cB + hstep, voffB); PG8_STAGE(PG8_SA(0, 0), cA, voffA); PG8_STAGE(PG8_SA(0, 1), cA + hstep, voffA);
        if (wr == 1) PG8_BAR;
        PG8_WAIT_V(2); PG8_BAR;
        PG8_STAGE(PG8_SB(1, 0), cB + kstep, voffB); PG8_STAGE(PG8_SA(1, 0), cA + kstep, voffA); PG8_STAGE(PG8_SB(1, 1), cB + hstep + kstep, voffB);
        PG8_WAIT_V(6); PG8_BAR;
    } else {
        PG8_STAGE(PG8_SB(0, 0), cB, voffB); PG8_STAGE(PG8_SA(0, 0), cA, voffA); PG8_STAGE(PG8_SB(0, 1), cB + hstep, voffB); PG8_STAGE(PG8_SA(0, 1), cA + hstep, voffA);
        if (wr == 1) PG8_BAR;
        PG8_WAIT_V(4); PG8_BAR;
        PG8_STAGE(PG8_SB(1, 0), cB + kstep, voffB); PG8_STAGE(PG8_SA(1, 0), cA + kstep, voffA); PG8_STAGE(PG8_SB(1, 1), cB + hstep + kstep, voffB);
        PG8_WAIT_V(6); PG8_BAR;
    }
    for (;;) {
        const bool has_next = S.next(ui + 1, nxt);
        const char* nA = has_next ? (const char*)g.A + (size_t)nxt.pm * tstep : cA; const char* nB = has_next ? (const char*)g.Bt + (size_t)nxt.pn * tstep : cB;
        for (int t = 0; t < nt; t += 2) {
            const bool last = (t == nt - 2);
            const char* a1 = cA + (size_t)(t + 1) * kstep;
            const char* a2 = last ? nA : cA + (size_t)(t + 2) * kstep; const char* b2 = last ? nB : cB + (size_t)(t + 2) * kstep;
            const char* a3 = a2 + kstep; const char* b3 = b2 + kstep;
            if (last && has_next) S.a_ready(nxt);
            if constexpr (SP2) {
            PG8_LDB(B0, 0, 0); PG8_LDB(B1, 0, 1); PG8_SCHED; PG8_LDA(At, 0, 0); PG8_STAGE(PG8_SA(1, 1), a1 + hstep, voffA);
            PG8_WAIT_V(8); PG8_WAIT_L(0); PG8_BAR; PG8_MMA(0, 0, At, B0); PG8_MMA(0, 1, At, B1); PG8_BAR; PG8_SCHED;
            PG8_LDA(At, 0, 1); PG8_STAGE(PG8_SB(0, 0), b2, voffB); PG8_STAGE(PG8_SB(0, 1), b2 + hstep, voffB); PG8_STAGE(PG8_SA(0, 0), a2, voffA);
            PG8_WAIT_V(8); PG8_WAIT_L(0); PG8_BAR; PG8_MMA(1, 0, At, B0); PG8_MMA(1, 1, At, B1); PG8_BAR; PG8_SCHED;
            PG8_LDB(B0, 1, 0); PG8_LDB(B1, 1, 1); PG8_SCHED; PG8_LDA(At, 1, 0); PG8_STAGE(PG8_SA(0, 1), a2 + hstep, voffA);
            PG8_WAIT_V(8); PG8_WAIT_L(0); PG8_BAR; PG8_MMA(0, 0, At, B0); PG8_MMA(0, 1, At, B1); PG8_BAR; PG8_SCHED;
            PG8_LDA(At, 1, 1); PG8_STAGE(PG8_SB(1, 0), b3, voffB); PG8_STAGE(PG8_SB(1, 1), b3 + hstep, voffB); PG8_STAGE(PG8_SA(1, 0), a3, voffA);
            PG8_WAIT_V(8); PG8_WAIT_L(0); PG8_BAR; PG8_MMA(1, 0, At, B0); PG8_MMA(1, 1, At, B1); PG8_BAR; PG8_SCHED;
            } else {
            PG8_LDB(B0, 0, 0); PG8_SCHED; PG8_LDA(At, 0, 0); PG8_STAGE(PG8_SA(1, 1), a1 + hstep, voffA);
            PG8_WAIT_L(8); PG8_BAR; PG8_WAIT_L(0); PG8_MMA(0, 0, At, B0); PG8_BAR; PG8_SCHED;
            PG8_LDB(B1, 0, 1); PG8_STAGE(PG8_SB(0, 0), b2, voffB);
            PG8_BAR; PG8_WAIT_L(0); PG8_MMA(0, 1, At, B1); PG8_BAR;
            PG8_LDA(At, 0, 1); PG8_STAGE(PG8_SA(0, 0), a2, voffA);
            PG8_BAR; PG8_WAIT_L(0); PG8_MMA(1, 0, At, B0); PG8_BAR; PG8_SCHED;
            PG8_STAGE(PG8_SB(0, 1), b2 + hstep, voffB);
            PG8_WAIT_V(6); PG8_BAR; PG8_MMA(1, 1, At, B1); PG8_BAR;
            PG8_LDB(B0, 1, 0); PG8_SCHED; PG8_LDA(At, 1, 0); PG8_STAGE(PG8_SA(0, 1), a2 + hstep, voffA);
            PG8_WAIT_L(8); PG8_BAR; PG8_WAIT_L(0); PG8_MMA(0, 0, At, B0); PG8_BAR; PG8_SCHED;
            PG8_LDB(B1, 1, 1); PG8_STAGE(PG8_SB(1, 0), b3, voffB);
            PG8_BAR; PG8_WAIT_L(0); PG8_MMA(0, 1, At, B1); PG8_BAR;
            PG8_LDA(At, 1, 1); PG8_STAGE(PG8_SA(1, 0), a3, voffA);
            PG8_BAR; PG8_WAIT_L(0); PG8_MMA(1, 0, At, B0); PG8_BAR; PG8_SCHED;
            PG8_STAGE(PG8_SB(1, 1), b3 + hstep, voffB);
            PG8_WAIT_V(6); PG8_BAR; PG8_MMA(1, 1, At, B1); PG8_BAR;
            }
        }
        if constexpr (ALIGN_EPI) { if (wr == 0) PG8_BAR; }
        if constexpr (FP8) asm volatile("s_nop 15\n\ts_nop 15" ::: "memory");
        if constexpr (!Epi::AFTER_DRAIN) { E(acc, cur, wr, wc, fr, fq); S.done(cur); }
        if (!has_next) break;
#pragma unroll
        for (int a = 0; a < 2; ++a)
#pragma unroll
            for (int b = 0; b < 2; ++b)
#pragma unroll
                for (int m = 0; m < 4; ++m)
#pragma unroll
                    for (int n = 0; n < 2; ++n) acc[a][b][m][n] = (f32x4){0.f, 0.f, 0.f, 0.f};
        cur = nxt; cA = nA; cB = nB; ++ui;
        if constexpr (ALIGN_EPI) { if (wr == 1) PG8_BAR; }
    }
    PG8_WAIT_V(0);
    if constexpr (!ALIGN_EPI) { if (wr == 0) PG8_BAR; }
    PG8_BAR;
    if constexpr (Epi::AFTER_DRAIN) { E.fused(acc, cur, wr, wc, fr, fq, lds, wid, lane); S.done(cur); }
#undef PG8_SA
#undef PG8_SB
#undef PG8_STAGE
#undef PG8_LDA
#undef PG8_LDB
#undef PG8_MMA
#undef PG8_CAT
#undef PG8_WAIT_V
#undef PG8_WAIT_L
#undef PG8_BAR
#undef PG8_SCHED
}
}
constexpr int DM = 2048, NB = 8, SEQ = 2048, MTOK = NB * SEQ;
constexpr int HD = 64, NAW = 1024, RWW = 1024, NHEAD = 16;
constexpr int RWP = 3488, INP = 6560, LDP = 6656;
constexpr int NE = 16, CAP = 256, FF = 2048, MEXP = NE * NB * CAP;
constexpr int GLORA = 160;
constexpr int PC_Q = 0, PC_K = 1024, PC_V = 2048, PC_RW = 3072;

constexpr size_t MiB = 1u << 20;
constexpr size_t WS_CTL = 0, CTL_ZERO_BYTES = 1 * MiB;
constexpr size_t WS_WIN = 2 * MiB;
constexpr size_t WS_WOUT = 28 * MiB;
constexpr size_t WS_G2T = 36 * MiB;
constexpr size_t WS_WGU = 38 * MiB;
constexpr size_t WS_WD = 294 * MiB;
constexpr size_t WS_H = 422 * MiB;
constexpr size_t WS_PROJ = 486 * MiB;
constexpr size_t WS_MIX = 694 * MiB;
constexpr size_t WS_WKV = 758 * MiB;
constexpr size_t WS_SB = 886 * MiB;
constexpr size_t WS_AFF = 888 * MiB;
constexpr size_t WS_GATE = 889 * MiB;
constexpr size_t WS_TOKSLOT = 890 * MiB;
constexpr size_t WS_WINQ = 892 * MiB;
constexpr size_t WS_HQ = 898 * MiB;
constexpr size_t WS_X2 = 930 * MiB;
constexpr size_t WS_END = 994 * MiB;
constexpr size_t WS_XE = WS_PROJ;
constexpr size_t WS_HID = 614 * MiB;
static_assert(WS_HID + 128 * MiB <= WS_WKV && WS_XE + 128 * MiB <= WS_HID, "overlay map");

constexpr int NWAVES = 8, NTHR = 512;
constexpr int LDS_BYTES = 163840;

#define LAS __attribute__((address_space(3)))
#define GAS __attribute__((address_space(1)))
typedef unsigned short bf16;
typedef float f32x4 __attribute__((ext_vector_type(4)));
typedef float f32x2 __attribute__((ext_vector_type(2)));
typedef short bf16x8 __attribute__((ext_vector_type(8)));
typedef short s16x4 __attribute__((ext_vector_type(4)));
typedef unsigned u32x4 __attribute__((ext_vector_type(4)));
typedef unsigned u32x2 __attribute__((ext_vector_type(2)));
#define LDS_WAIT() asm volatile("s_waitcnt lgkmcnt(0)" ::: "memory")

__device__ __forceinline__ unsigned f2bf(float f) { unsigned u = __builtin_bit_cast(unsigned, f); return (u + 0x7fffu + ((u >> 16) & 1u)) >> 16; }
typedef __bf16 bf16x2_t __attribute__((ext_vector_type(2)));
__device__ __forceinline__ unsigned pk2(float lo, float hi) { const f32x2 v = {lo, hi}; const bf16x2_t b = __builtin_convertvector(v, bf16x2_t); return __builtin_bit_cast(unsigned, b); }
__device__ __forceinline__ float bflo(unsigned u) { return __builtin_bit_cast(float, u << 16); }
__device__ __forceinline__ float bfhi(unsigned u) { return __builtin_bit_cast(float, u & 0xffff0000u); }
__device__ __forceinline__ float bf2f(unsigned short b) { return __builtin_bit_cast(float, (unsigned)b << 16); }
__device__ __forceinline__ void unpack8(const u32x4 v, float* f) { f[0] = bflo(v.x); f[1] = bfhi(v.x); f[2] = bflo(v.y); f[3] = bfhi(v.y); f[4] = bflo(v.z); f[5] = bfhi(v.z); f[6] = bflo(v.w); f[7] = bfhi(v.w); }
__device__ __forceinline__ void unpack8v(const u32x4 v, f32x2* f) { f[0] = (f32x2){bflo(v.x), bfhi(v.x)}; f[1] = (f32x2){bflo(v.y), bfhi(v.y)}; f[2] = (f32x2){bflo(v.z), bfhi(v.z)}; f[3] = (f32x2){bflo(v.w), bfhi(v.w)}; }
__device__ __forceinline__ float sigmoidf_(float x) { return __builtin_amdgcn_rcpf(1.0f + __expf(-x)); }
template <int CTRL> __device__ __forceinline__ float dppf(float x) { return __builtin_bit_cast(float, __builtin_amdgcn_update_dpp(0, __builtin_bit_cast(int, x), CTRL, 0xF, 0xF, true)); }
__device__ __forceinline__ float red8(float x) { x += dppf<0xB1>(x); x += dppf<0x4E>(x); x += dppf<0x141>(x); return x; }
__device__ __forceinline__ float wave_sum(float v) {
#pragma unroll
    for (int o = 1; o < 64; o <<= 1) v += __shfl_xor(v, o);
    return v;
}

template <class T> __device__ __forceinline__ T* gptr(T* p) {
#if defined(__HIP_DEVICE_COMPILE__)
    __builtin_assume(!__builtin_amdgcn_is_shared((const void*)p)); __builtin_assume(!__builtin_amdgcn_is_private((const void*)p));
#endif
    return p; }
struct Args {
    const float* in[24]; float* out; unsigned char* ws;
};

struct Frame {
    unsigned char* lds;
    int tid, lane, wave, G, c;
    const float* const* in;
    float* out; __attribute__((address_space(1))) unsigned char* ws;
};

__device__ __forceinline__ void p0_transpose_item(const float* W, int ldw, int k0, int n0, bf16* outp, int ldo, LAS float* scr, int lane) {
#pragma unroll
    for (int i = 0; i < 32; ++i) { const int kk = 2 * i + (lane >> 5); scr[kk * 33 + (lane & 31)] = __builtin_nontemporal_load(&W[(size_t)(k0 + kk) * ldw + n0 + (lane & 31)]); }
    LDS_WAIT(); asm volatile("" ::: "memory");
    const int c = lane & 7;
#pragma unroll
    for (int j = 0; j < 4; ++j) { const int n = (lane >> 3) + 8 * j; const LAS float* s = scr + (8 * c) * 33 + n;
        u32x4 o; o.x = pk2(s[0 * 33], s[1 * 33]); o.y = pk2(s[2 * 33], s[3 * 33]); o.z = pk2(s[4 * 33], s[5 * 33]); o.w = pk2(s[6 * 33], s[7 * 33]);
        *(u32x4*)(outp + (size_t)n * ldo + 8 * c) = o; }
    LDS_WAIT(); asm volatile("" ::: "memory");
}
__device__ __forceinline__ void p0_transpose_item_fp8(const float* W, int ldw, int k0, int n0, unsigned char* outp, int ldo, LAS float* scr, int lane) {
#pragma unroll 32
    for (int i = 0; i < 64; ++i) { const int kk = 2 * i + (lane >> 5); scr[kk * 33 + (lane & 31)] = __builtin_nontemporal_load(&W[(size_t)(k0 + kk) * ldw + n0 + (lane & 31)]); }
    LDS_WAIT(); asm volatile("" ::: "memory");
    const int c = lane & 7;
#pragma unroll
    for (int j = 0; j < 4; ++j) { const int n = (lane >> 3) + 8 * j; const LAS float* s = scr + (16 * c) * 33 + n; int o[4];
#pragma unroll
        for (int q = 0; q < 4; ++q) { int pw = __builtin_amdgcn_cvt_pk_fp8_f32(s[(4 * q) * 33] * 32.0f, s[(4 * q + 1) * 33] * 32.0f, 0, false); o[q] = __builtin_amdgcn_cvt_pk_fp8_f32(s[(4 * q + 2) * 33] * 32.0f, s[(4 * q + 3) * 33] * 32.0f, pw, true); }
        __builtin_nontemporal_store((u32x4){(unsigned)o[0], (unsigned)o[1], (unsigned)o[2], (unsigned)o[3]}, (u32x4*)(outp + (size_t)n * ldo + 16 * c)); }
    LDS_WAIT(); asm volatile("" ::: "memory");
}
__device__ __forceinline__ void rms_row_to_bf16(const float* xrow, const float* g, bf16* orow, unsigned char* qrow, int lane) {
    const f32x4* xr = (const f32x4*)xrow + lane; const f32x4* gr = (const f32x4*)g + lane;
    f32x4 v[8]; float s = 0.f;
#pragma unroll
    for (int j = 0; j < 8; ++j) { v[j] = __builtin_nontemporal_load(&xr[64 * j]); s += (v[j].x * v[j].x + v[j].y * v[j].y) + (v[j].z * v[j].z + v[j].w * v[j].w); }
    const float rstd = 1.0f / sqrtf(wave_sum(s) * (1.0f / DM) + 1e-6f);
    u32x2* o8 = (u32x2*)orow + lane; unsigned* o4 = (unsigned*)qrow + lane;
#pragma unroll
    for (int j = 0; j < 8; ++j) { const f32x4 hv = v[j] * rstd * gr[64 * j]; u32x2 w; w.x = pk2(hv.x, hv.y); w.y = pk2(hv.z, hv.w); o8[64 * j] = w;
        int pw = __builtin_amdgcn_cvt_pk_fp8_f32(hv.x, hv.y, 0, false); pw = __builtin_amdgcn_cvt_pk_fp8_f32(hv.z, hv.w, pw, true); o4[64 * j] = (unsigned)pw; }
}
__device__ __forceinline__ void p0_prologue(const Frame& F, LAS unsigned char* lds) {
    LAS float* scr = (LAS float*)(lds + F.wave * 17408);
    const int gw = F.c * NWAVES + F.wave, NGW = F.G * NWAVES;
    const float* w_in = gptr(F.in[2]); const float* w_out = gptr(F.in[18]); const float* w_gate = gptr(F.in[21]); const float* w_up = gptr(F.in[22]); const float* w_down = gptr(F.in[23]);
    bf16* WIN = (bf16*)(F.ws + WS_WIN); bf16* WOUT = (bf16*)(F.ws + WS_WOUT); unsigned char* WGU = (unsigned char*)(F.ws + WS_WGU); unsigned char* WD = (unsigned char*)(F.ws + WS_WD);
    constexpr int I_IN = 32 * 109, I_OUT = 32 * 64;
    constexpr int NITEMS = I_IN + I_OUT;
    for (int it = gw; it < NITEMS; it += NGW) {
        int r = it;
        if (r < I_IN) { const int kb = r / 109, nb = 96 + r % 109; p0_transpose_item(w_in, INP, 64 * kb, 32 * nb, WIN + (size_t)(32 * nb) * DM + 64 * kb, DM, scr, F.lane); continue; } r -= I_IN;
        { const int kb = r / 64, nb = r % 64; p0_transpose_item(w_out, DM, 64 * kb, 32 * nb, WOUT + (size_t)(32 * nb) * DM + 64 * kb, DM, scr, F.lane); }
    }
    { unsigned char* WINQ = (unsigned char*)(F.ws + WS_WINQ); for (int it = gw; it < 16 * 96; it += NGW) { const int kb = it / 96, nb = it % 96; p0_transpose_item_fp8(w_in, INP, 128 * kb, 32 * nb, WINQ + (size_t)(32 * nb) * DM + 128 * kb, DM, scr, F.lane); } }
    for (int it = gw; it < 48 * 1024; it += NGW) { const int mat = it >> 10, e = mat / 3, which = mat - 3 * e, r = it & 1023, kb = r >> 6, nb = r & 63, n0 = 32 * nb;
        if (which == 2) p0_transpose_item_fp8(w_down + (size_t)e * FF * DM, DM, 128 * kb, n0, WD + ((size_t)e * DM + n0) * FF + 128 * kb, FF, scr, F.lane);
        else { const float* W = (which == 0 ? w_gate : w_up) + (size_t)e * DM * FF; const int orow = (n0 >> 7) * 256 + which * 128 + (n0 & 127);
            p0_transpose_item_fp8(W, FF, 128 * kb, n0, WGU + ((size_t)e * 4096 + orow) * DM + 128 * kb, DM, scr, F.lane); } }
    { u32x4* z = (u32x4*)(WIN + (size_t)INP * DM); const int n16 = 96 * DM * 2 / 16; for (int i = F.c * NTHR + F.tid; i < n16; i += F.G * NTHR) z[i] = (u32x4){0u, 0u, 0u, 0u}; }
    { const float* g2 = gptr(F.in[12]); bf16* G2T = (bf16*)(F.ws + WS_G2T); for (int i = F.c * NTHR + F.tid; i < GLORA * RWW; i += F.G * NTHR) { const int n = i / GLORA, k = i % GLORA; G2T[i] = (bf16)f2bf(g2[(size_t)k * RWW + n]); } }
    { const float* x = gptr(F.in[0]); const float* g = gptr(F.in[1]); bf16* H = (bf16*)(F.ws + WS_H); unsigned char* HQ = (unsigned char*)(F.ws + WS_HQ); for (int m = gw; m < MTOK; m += NGW) rms_row_to_bf16(x + (size_t)m * DM, g, H + (size_t)m * DM, HQ + (size_t)m * DM, F.lane); }
}
#define XB_TMO      128
#define XB_XCNT(j)  (256  + 64 * (j))
#define XB_XSUB(j)  (1280 + 64 * (j))
#define XB_XGEN(j)  (2304 + 64 * (j))
#define XB_TOP      3328
#define XB_TOPGEN   3392
#define XCD_BAR_WORDS 3456
#define XB_SPIN_CAP (1u << 18)

__device__ __forceinline__ unsigned xb_ld(unsigned* p)              { return __hip_atomic_load(p, __ATOMIC_RELAXED, __HIP_MEMORY_SCOPE_AGENT); }
__device__ __forceinline__ unsigned xb_add(unsigned* p, unsigned v) { return __hip_atomic_fetch_add(p, v, __ATOMIC_RELAXED, __HIP_MEMORY_SCOPE_AGENT); }
__device__ __forceinline__ unsigned xb_xcc_id() { return (unsigned)__builtin_amdgcn_s_getreg((3 << 11) | 20) & 0xFu; }
#define XB_SPIN(cond, bar) do { unsigned _sp = 0; while (cond) { __builtin_amdgcn_s_sleep(1); \
    if ((++_sp & 255u) == 0u) { if (xb_ld(&(bar)[XB_TMO])) break; if (_sp > XB_SPIN_CAP) { atomicAdd(&(bar)[XB_TMO], 1u); break; } } } } while (0)

struct XcdBarrier {
    unsigned* bar; unsigned x;
    volatile LAS unsigned* st;
};

__device__ __forceinline__ XcdBarrier xcd_barrier_post(unsigned* bar, volatile LAS unsigned* st) {
    XcdBarrier b; b.bar = bar; b.x = xb_xcc_id(); b.st = st;
    if (threadIdx.x == 0) (void)xb_add(&bar[XB_XCNT(b.x)], 1u);
    return b;
}
__device__ __forceinline__ void xcd_barrier_complete(unsigned* bar, unsigned x, unsigned& nloc, unsigned& nx) {
    const unsigned G = gridDim.x * gridDim.y * gridDim.z;
    unsigned sum, cnt, mine, sp = 0u;
    for (;;) {
        sum = 0u; cnt = 0u; mine = 0u;
#pragma unroll
        for (unsigned j = 0; j < 16; ++j) { const unsigned c = xb_ld(&bar[XB_XCNT(j)]); sum += c; cnt += (c > 0u) ? 1u : 0u; mine = (j == x) ? c : mine; }
        if (sum == G) break;
        __builtin_amdgcn_s_sleep(1);
        if ((++sp & 255u) == 0u) { if (xb_ld(&bar[XB_TMO])) break; if (sp > XB_SPIN_CAP) { atomicAdd(&bar[XB_TMO], 1u); break; } }
    }
    nloc = mine > 0u ? mine : 1u; nx = cnt > 0u ? cnt : 1u;
}

__device__ __forceinline__ void xcd_barrier(const XcdBarrier& b) {
    asm volatile("s_waitcnt vmcnt(0)" ::: "memory");
    __syncthreads();
    if (threadIdx.x == 0) {
        unsigned* bar = b.bar;
        __builtin_amdgcn_s_waitcnt(0);
        unsigned nloc = b.st[0], nx = b.st[1];
        if (nloc == 0u) { xcd_barrier_complete(bar, b.x, nloc, nx); b.st[0] = nloc; b.st[1] = nx; }
        const unsigned old = xb_add(&bar[XB_XSUB(b.x)], 1u);
        const unsigned gen = old / nloc;
        if (old + 1u == (gen + 1u) * nloc) {
            __builtin_amdgcn_fence(__ATOMIC_RELEASE, "agent");
            asm volatile("s_waitcnt vmcnt(0)" ::: "memory");
            const unsigned og = xb_add(&bar[XB_TOP], 1u);
            const unsigned tg = og / nx;
            if (og + 1u == (tg + 1u) * nx) xb_add(&bar[XB_TOPGEN], 1u);
            else XB_SPIN(xb_ld(&bar[XB_TOPGEN]) == tg, bar);
            __builtin_amdgcn_fence(__ATOMIC_ACQUIRE, "agent");
            xb_add(&bar[XB_XGEN(b.x)], 1u);
            asm volatile("s_waitcnt vmcnt(0)" ::: "memory");
        } else {
            XB_SPIN(xb_ld(&bar[XB_XGEN(b.x)]) == gen, bar);
            __builtin_amdgcn_fence(__ATOMIC_ACQUIRE, "agent");
            asm volatile("s_waitcnt vmcnt(0)" ::: "memory");
        }
    }
    __syncthreads();
}

constexpr int NA_VSTR = 160;
constexpr int NA_OFF_V = 0, NA_OFF_RK = 512 * NA_VSTR, NA_OFF_BIAS = NA_OFF_RK + 2048, NA_OFF_ML = NA_OFF_BIAS + 1920, NA_OFF_O = NA_OFF_ML + 1024, NA_END = NA_OFF_O + 16384;
typedef short v4i16_t __attribute__((ext_vector_type(4)));
__device__ __forceinline__ s16x4 tr_read(LAS unsigned char* p) { return __builtin_bit_cast(s16x4, __builtin_amdgcn_ds_read_tr16_b64_v4i16((LAS v4i16_t*)p)); }
__device__ __forceinline__ f32x4 mfma16(bf16x8 a, bf16x8 b, f32x4 c) { return __builtin_amdgcn_mfma_f32_16x16x32_bf16(a, b, c, 0, 0, 0); }

constexpr int NA2_SLOT = 64 * NA_VSTR;
constexpr int NA2_V = 0, NA2_RK = 9 * NA2_SLOT, NA2_BIAS = NA2_RK + 9 * 256, NA2_MRG = NA2_BIAS + 1920, NA2_END = NA2_MRG + 4 * 64 * 18 * 4;
static_assert(NA2_END <= LDS_BYTES - 16, "NA LDS map");
__device__ __forceinline__ void na_phase(const Frame& F, LAS unsigned char* lds) {
    const bf16* PROJ = (const bf16*)(F.ws + WS_PROJ); bf16* MIX = (bf16*)(F.ws + WS_MIX);
    const float* qg = gptr(F.in[3]); const float* kg = gptr(F.in[4]); const float* rpb = gptr(F.in[5]);
    LAS float* BI = (LAS float*)(lds + NA2_BIAS); LAS float* MRG = (LAS float*)(lds + NA2_MRG);
    const int tid = F.tid, lane = F.lane, w = F.wave, c16 = lane & 15, g = lane >> 4, qb = w & 3, kh = w >> 2;
    constexpr float LOG2E = 1.442695041f;
    f32x2 gg[8];
#pragma unroll
    for (int j = 0; j < 4; ++j) { gg[j] = (f32x2){qg[8 * g + 2 * j] * kg[8 * g + 2 * j], qg[8 * g + 2 * j + 1] * kg[8 * g + 2 * j + 1]} * (0.125f * LOG2E);
        gg[4 + j] = (f32x2){qg[32 + 8 * g + 2 * j] * kg[32 + 8 * g + 2 * j], qg[32 + 8 * g + 2 * j + 1] * kg[32 + 8 * g + 2 * j + 1]} * (0.125f * LOG2E); }
    const int cw0 = (qb == 0) ? 0 : (qb == 1) ? 8 : (qb == 2) ? 24 : 32;
    const int qcol = 16 * qb + c16; const int cs = (qcol - 8) < 0 ? 0 : ((qcol - 8) > 48 ? 48 : (qcol - 8));
    int dcv[2][4];
#pragma unroll
    for (int cb = 0; cb < 2; ++cb)
#pragma unroll
        for (int reg = 0; reg < 4; ++reg) { const int kcol = cw0 + cb * 16 + 4 * g + reg; const bool valid = (kcol >= cs) && (kcol < cs + 16); dcv[cb][reg] = valid ? (kcol - qcol + 15) : -1; }
    const int skey = tid >> 3, sch = tid & 7;
    const unsigned koff0 = (unsigned)(((cw0 + c16) * LDP + 8 * g) * 2), koff1 = koff0 + 16 * LDP * 2, qoff = (unsigned)((qcol * LDP + 8 * g) * 2), soff = (unsigned)((skey * LDP + sch * 8) * 2);
    for (int unit = F.c; unit < 256; unit += F.G) {
        const int b = unit >> 5, h = (unit >> 1) & 15, r0 = (unit & 1) * 16;
        const size_t tokb = (size_t)b * SEQ;
        const char* rowK = (const char*)(PROJ + tokb * LDP + PC_K + h * 64); const char* rowV = (const char*)(PROJ + tokb * LDP + PC_V + h * 64); const char* rowQ = (const char*)(PROJ + tokb * LDP + PC_Q + h * 64);
        constexpr size_t ROWB = (size_t)64 * LDP * 2;
        __syncthreads();
        if (tid < 465) BI[tid] = rpb[h * 465 + tid] * LOG2E;
        { const int rs0 = (r0 - 4) < 0 ? 0 : ((r0 - 4) > 24 ? 24 : (r0 - 4)); u32x4 pv_[8], pk_[8];
#pragma unroll
            for (int i = 0; i < 8; ++i) { pv_[i] = *(const u32x4*)(rowV + (size_t)(rs0 + i) * ROWB + soff); pk_[i] = *(const u32x4*)(rowK + (size_t)(rs0 + i) * ROWB + soff); }
#pragma unroll
            for (int i = 0; i < 8; ++i) { const int slot = (rs0 + i) % 9;
                *(LAS u32x4*)(lds + NA2_V + slot * NA2_SLOT + skey * NA_VSTR + sch * 16) = pv_[i];
                float f[8]; unpack8(pk_[i], f); float ss = 0.f;
#pragma unroll
                for (int j = 0; j < 8; ++j) ss += f[j] * f[j];
                ss = red8(ss); if (sch == 0) *(LAS float*)(lds + NA2_RK + slot * 256 + skey * 4) = __builtin_amdgcn_rsqf(ss * (1.0f / 64.0f) + 1e-6f); } }
        u32x4 qraw[2], kraw[8][2];
#define NA2_ISSUE(rr) do { const int rs_ = ((rr) - 4) < 0 ? 0 : (((rr) - 4) > 24 ? 24 : ((rr) - 4)); \
            const char* qp_ = rowQ + (size_t)(rr) * ROWB + qoff; qraw[0] = *(const u32x4*)qp_; qraw[1] = *(const u32x4*)(qp_ + 64); \
            _Pragma("unroll") for (int i_ = 0; i_ < 8; ++i_) { const char* kp_ = rowK + (size_t)(rs_ + kh * 4 + (i_ >> 1)) * ROWB + ((i_ & 1) ? koff1 : koff0); kraw[i_][0] = *(const u32x4*)kp_; kraw[i_][1] = *(const u32x4*)(kp_ + 64); } } while (0)
        NA2_ISSUE(r0);
        f32x2 bs[4][2][2]; int cur_dro = 99;
        __syncthreads();
        for (int r = r0; r < r0 + 16; ++r) {
            const int rs = (r - 4) < 0 ? 0 : ((r - 4) > 24 ? 24 : (r - 4));
            const int rn = r + 1; const int rsn = (rn - 4) < 0 ? 0 : ((rn - 4) > 24 ? 24 : (rn - 4)); const bool moves = (rn < r0 + 16) && (rsn != rs);
            u32x4 nv, nk;
            { nv = *(const u32x4*)(rowV + (size_t)(rsn + 7) * ROWB + soff); nk = *(const u32x4*)(rowK + (size_t)(rsn + 7) * ROWB + soff); }
            if (rs - r != cur_dro) { cur_dro = rs - r;
#pragma unroll
                for (int kr = 0; kr < 4; ++kr)
#pragma unroll
                    for (int cb = 0; cb < 2; ++cb)
#pragma unroll
                        for (int reg = 0; reg < 4; ++reg) { const int dc = dcv[cb][reg]; const float bv_ = BI[(cur_dro + kh * 4 + kr + 7) * 31 + (dc < 0 ? 0 : dc)]; bs[kr][cb][reg >> 1][reg & 1] = dc < 0 ? -1e30f : bv_; } }
            f32x2 qf[8]; unpack8v(qraw[0], qf); unpack8v(qraw[1], qf + 4);
            f32x2 s2 = (f32x2){0.f, 0.f};
#pragma unroll
            for (int j = 0; j < 8; ++j) s2 = qf[j] * qf[j] + s2;
            float ss = s2.x + s2.y; ss += __shfl_xor(ss, 16); ss += __shfl_xor(ss, 32);
            const float rq = __builtin_amdgcn_rsqf(ss * (1.0f / 64.0f) + 1e-6f);
            u32x4 q0u, q1u; unsigned* q0p = (unsigned*)&q0u; unsigned* q1p = (unsigned*)&q1u;
#pragma unroll
            for (int j = 0; j < 4; ++j) { const f32x2 a = qf[j] * gg[j], c = qf[4 + j] * gg[4 + j]; q0p[j] = pk2(a.x, a.y); q1p[j] = pk2(c.x, c.y); }
            const bf16x8 q0 = __builtin_bit_cast(bf16x8, q0u), q1 = __builtin_bit_cast(bf16x8, q1u);
            f32x4 acc[4][2];
#pragma unroll
            for (int kr = 0; kr < 4; ++kr)
#pragma unroll
                for (int cb = 0; cb < 2; ++cb) { f32x4 a = (f32x4){0.f, 0.f, 0.f, 0.f};
                    a = mfma16(__builtin_bit_cast(bf16x8, kraw[kr * 2 + cb][0]), q0, a); a = mfma16(__builtin_bit_cast(bf16x8, kraw[kr * 2 + cb][1]), q1, a); acc[kr][cb] = a; }
            asm volatile("" : "+v"(acc[0][0]), "+v"(acc[0][1]), "+v"(acc[1][0]), "+v"(acc[1][1]), "+v"(acc[2][0]), "+v"(acc[2][1]), "+v"(acc[3][0]), "+v"(acc[3][1]));
            NA2_ISSUE(rn < r0 + 16 ? rn : r);
            f32x2 sc[4][2][2]; float mx = -1e30f;
#pragma unroll
            for (int kr = 0; kr < 4; ++kr) { const int slot = (rs + kh * 4 + kr) % 9;
#pragma unroll
                for (int cb = 0; cb < 2; ++cb) { const f32x4 rk = *(LAS f32x4*)(lds + NA2_RK + slot * 256 + (cw0 + cb * 16 + 4 * g) * 4);
                    sc[kr][cb][0] = (acc[kr][cb].xy * rk.xy) * rq + bs[kr][cb][0]; sc[kr][cb][1] = (acc[kr][cb].zw * rk.zw) * rq + bs[kr][cb][1];
                    mx = fmaxf(fmaxf(mx, fmaxf(sc[kr][cb][0].x, sc[kr][cb][0].y)), fmaxf(sc[kr][cb][1].x, sc[kr][cb][1].y)); } }
            mx = fmaxf(mx, __shfl_xor(mx, 16)); mx = fmaxf(mx, __shfl_xor(mx, 32));
            f32x2 ls2 = (f32x2){0.f, 0.f};
#pragma unroll
            for (int kr = 0; kr < 4; ++kr)
#pragma unroll
                for (int cb = 0; cb < 2; ++cb)
#pragma unroll
                    for (int hh = 0; hh < 2; ++hh) { const f32x2 d = sc[kr][cb][hh] - mx; f32x2 p; p.x = __builtin_amdgcn_exp2f(d.x); p.y = __builtin_amdgcn_exp2f(d.y); sc[kr][cb][hh] = p; ls2 = ls2 + p; }
            float lsum = ls2.x + ls2.y; lsum += __shfl_xor(lsum, 16); lsum += __shfl_xor(lsum, 32);
            f32x4 o[4];
#pragma unroll
            for (int db = 0; db < 4; ++db) o[db] = (f32x4){0.f, 0.f, 0.f, 0.f};
#pragma unroll
            for (int kr = 0; kr < 4; ++kr) {
                u32x4 pu; pu.x = pk2(sc[kr][0][0].x, sc[kr][0][0].y); pu.y = pk2(sc[kr][0][1].x, sc[kr][0][1].y); pu.z = pk2(sc[kr][1][0].x, sc[kr][1][0].y); pu.w = pk2(sc[kr][1][1].x, sc[kr][1][1].y);
                const bf16x8 pa = __builtin_bit_cast(bf16x8, pu);
                const int slot = (rs + kh * 4 + kr) % 9;
                LAS unsigned char* a0 = lds + NA2_V + slot * NA2_SLOT + (cw0 + 4 * g + (c16 >> 2)) * NA_VSTR + (c16 & 3) * 8;
#pragma unroll
                for (int db = 0; db < 4; ++db) { const s16x4 lo = tr_read(a0 + db * 32), hi = tr_read(a0 + 16 * NA_VSTR + db * 32);
                    const bf16x8 vb = (bf16x8){lo[0], lo[1], lo[2], lo[3], hi[0], hi[1], hi[2], hi[3]};
                    o[db] = mfma16(vb, pa, o[db]); } }
            LAS float* mp = MRG + (qb * 64 + lane) * 18;
            if (kh == 1) { *(LAS f32x2*)(mp + 16) = (f32x2){mx, lsum};
#pragma unroll
                for (int db = 0; db < 4; ++db) { *(LAS f32x2*)(mp + db * 4) = o[db].xy; *(LAS f32x2*)(mp + db * 4 + 2) = o[db].zw; } }
            __syncthreads();
            if (moves) { const int slot = (rsn + 7) % 9;
                *(LAS u32x4*)(lds + NA2_V + slot * NA2_SLOT + skey * NA_VSTR + sch * 16) = nv;
                float f[8]; unpack8(nk, f); float sq = 0.f;
#pragma unroll
                for (int j = 0; j < 8; ++j) sq += f[j] * f[j];
                sq = red8(sq); if (sch == 0) *(LAS float*)(lds + NA2_RK + slot * 256 + skey * 4) = __builtin_amdgcn_rsqf(sq * (1.0f / 64.0f) + 1e-6f); }
            if (kh == 0) { const f32x2 ml = *(LAS f32x2*)(mp + 16); const float mm = fmaxf(mx, ml.x); const float f0 = __builtin_amdgcn_exp2f(mx - mm), f1 = __builtin_amdgcn_exp2f(ml.x - mm); const float inv = __builtin_amdgcn_rcpf(lsum * f0 + ml.y * f1);
                const float g0 = f0 * inv, g1 = f1 * inv;
                bf16* dst = MIX + (tokb + (size_t)r * 64 + qcol) * DM + h * 64 + 4 * g;
#pragma unroll
                for (int db = 0; db < 4; ++db) { const f32x2 pa_ = *(LAS f32x2*)(mp + db * 4), pb_ = *(LAS f32x2*)(mp + db * 4 + 2);
                    const f32x2 oa = o[db].xy * g0 + pa_ * g1, ob = o[db].zw * g0 + pb_ * g1;
                    u32x2 ov; ov.x = pk2(oa.x, oa.y); ov.y = pk2(ob.x, ob.y);
                    *(u32x2*)(dst + db * 16) = ov; } }
            __syncthreads();
        }
    }
}

constexpr int PO_SGSTR = 336;
__device__ __forceinline__ void post_phase(const Frame& F, LAS unsigned char* lds) {
    const bf16* PROJ = (const bf16*)(F.ws + WS_PROJ); const bf16* G2T = (const bf16*)(F.ws + WS_G2T); const float* WKV = (const float*)(F.ws + WS_WKV); const float* SB = (const float*)(F.ws + WS_SB);
    bf16* MIX = (bf16*)(F.ws + WS_MIX); const float* mu_prev = gptr(F.in[6]); const float* mu_next = gptr(F.in[7]); const float* lnx_w = gptr(F.in[16]); const float* lnx_b = gptr(F.in[17]);
    const int lane = F.lane, w = F.wave, c16 = lane & 15, g = lane >> 4;
    for (int tile = F.c; tile < MTOK / 64; tile += F.G) {
        const int m0 = tile * 64;
        __syncthreads();
        for (int i = F.tid; i < 64 * (GLORA / 8); i += NTHR) { const int tok = i / (GLORA / 8), ch = i - tok * (GLORA / 8); const int m = m0 + tok, t = m & (SEQ - 1);
            const bf16* p = PROJ + (size_t)m * LDP + PC_RW + 3328 + 8 * ch; float c0[8], pm[8], pn[8]; unpack8(*(const u32x4*)p, c0);
            if (t > 0) unpack8(*(const u32x4*)(p - LDP), pm); else {
#pragma unroll
                for (int j = 0; j < 8; ++j) pm[j] = 0.f; }
            if (t < SEQ - 1) unpack8(*(const u32x4*)(p + LDP), pn); else {
#pragma unroll
                for (int j = 0; j < 8; ++j) pn[j] = 0.f; }
            const f32x4 mpA = *(const f32x4*)(mu_prev + 3328 + 8 * ch), mpB = *(const f32x4*)(mu_prev + 3328 + 8 * ch + 4), mnA = *(const f32x4*)(mu_next + 3328 + 8 * ch), mnB = *(const f32x4*)(mu_next + 3328 + 8 * ch + 4);
            float sg[8];
#pragma unroll
            for (int j = 0; j < 8; ++j) { const float mp = j < 4 ? mpA[j & 3] : mpB[j & 3], mn = j < 4 ? mnA[j & 3] : mnB[j & 3]; sg[j] = sigmoidf_(c0[j] + mp * (pm[j] - c0[j]) + mn * (pn[j] - c0[j])); }
            u32x4 o; o.x = pk2(sg[0], sg[1]); o.y = pk2(sg[2], sg[3]); o.z = pk2(sg[4], sg[5]); o.w = pk2(sg[6], sg[7]);
            *(LAS u32x4*)(lds + tok * PO_SGSTR + ch * 16) = o; }
        __syncthreads();
#pragma unroll 1
        for (int hd = 0; hd < 2; ++hd) {
            const int head = 2 * w + hd;
            f32x4 acc[4][4];
#pragma unroll
            for (int q = 0; q < 4; ++q)
#pragma unroll
                for (int mb = 0; mb < 4; ++mb) acc[q][mb] = (f32x4){0.f, 0.f, 0.f, 0.f};
#pragma unroll
            for (int ks = 0; ks < 5; ++ks) { bf16x8 bfr[4];
#pragma unroll
                for (int mb = 0; mb < 4; ++mb) bfr[mb] = *(LAS bf16x8*)(lds + (16 * mb + c16) * PO_SGSTR + (32 * ks + 8 * g) * 2);
#pragma unroll
                for (int q = 0; q < 4; ++q) { const bf16x8 af = *(const bf16x8*)(G2T + (size_t)(64 * head + 16 * q + c16) * GLORA + 32 * ks + 8 * g);
#pragma unroll
                    for (int mb = 0; mb < 4; ++mb) acc[q][mb] = mfma16(af, bfr[mb], acc[q][mb]); } }
#pragma unroll
            for (int mb = 0; mb < 4; ++mb) { const int m = m0 + 16 * mb + c16, t = m & (SEQ - 1); f32x4 x[4]; float s1 = 0.f;
#pragma unroll
                for (int q = 0; q < 4; ++q) { const int ch = 64 * head + 16 * q + 4 * g; x[q] = __builtin_nontemporal_load((const f32x4*)(WKV + (size_t)m * RWW + ch)) + __builtin_nontemporal_load((const f32x4*)(WKV + ((size_t)MTOK + m) * RWW + ch)); s1 += (x[q][0] + x[q][1]) + (x[q][2] + x[q][3]); }
                s1 += __shfl_xor(s1, 16); s1 += __shfl_xor(s1, 32); const float mean = s1 * (1.0f / 64.0f); float s2 = 0.f;
#pragma unroll
                for (int q = 0; q < 4; ++q) { const f32x4 d = x[q] - mean; s2 += (d[0] * d[0] + d[1] * d[1]) + (d[2] * d[2] + d[3] * d[3]); }
                s2 += __shfl_xor(s2, 16); s2 += __shfl_xor(s2, 32); const float rstd = 1.0f / sqrtf(s2 * (1.0f / 64.0f) + 64e-5f);
                const float sbv = SB[(size_t)m * 16 + head] + SB[((size_t)MTOK + m) * 16 + head];
#pragma unroll
                for (int q = 0; q < 4; ++q) { const int ch = 64 * head + 16 * q + 4 * g;
                    const bf16* pv = PROJ + (size_t)m * LDP + PC_RW + 2048 + ch; const u32x2 c0u = *(const u32x2*)pv; u32x2 pmu = (u32x2){0u, 0u}, pnu = (u32x2){0u, 0u};
                    if (t > 0) pmu = *(const u32x2*)(pv - LDP); if (t < SEQ - 1) pnu = *(const u32x2*)(pv + LDP);
                    const f32x4 c0 = (f32x4){bflo(c0u.x), bfhi(c0u.x), bflo(c0u.y), bfhi(c0u.y)}, pm = (f32x4){bflo(pmu.x), bfhi(pmu.x), bflo(pmu.y), bfhi(pmu.y)}, pn = (f32x4){bflo(pnu.x), bfhi(pnu.x), bflo(pnu.y), bfhi(pnu.y)};
                    const f32x4 mp = *(const f32x4*)(mu_prev + 2048 + ch), mn = *(const f32x4*)(mu_next + 2048 + ch);
                    const f32x4 vs = c0 + mp * (pm - c0) + mn * (pn - c0);
                    const f32x4 lw = *(const f32x4*)(lnx_w + ch), lb = *(const f32x4*)(lnx_b + ch);
                    const f32x4 y = ((x[q] - mean) * rstd * lw + lb + sbv * vs) * acc[q][mb];
                    u32x2 o; o.x = pk2(y[0], y[1]); o.y = pk2(y[2], y[3]); *(u32x2*)(MIX + (size_t)m * DM + NAW + ch) = o; }
                asm volatile("" ::: "memory"); }
        }
    }
}

__device__ __forceinline__ void norm2_router_phase(const Frame& F, LAS unsigned char* lds) {
    LAS float* WR = (LAS float*)lds; const float* wrt = gptr(F.in[20]); const float* gn = gptr(F.in[19]);
    for (int i = F.tid; i < DM * NE; i += NTHR) WR[(i & 15) * DM + (i >> 4)] = wrt[i];
    __syncthreads();
    const bf16* X2 = (const bf16*)(F.ws + WS_X2); unsigned char* H2 = (unsigned char*)(F.ws + WS_H); float* AFF = (float*)(F.ws + WS_AFF);
    const int lane = F.lane, gw = F.c * NWAVES + F.wave, NGW = F.G * NWAVES;
    for (int m = gw; m < MTOK; m += NGW) {
        const u32x2* xr = (const u32x2*)(X2 + (size_t)m * DM) + lane; const f32x4* gr = (const f32x4*)gn + lane;
        f32x4 v[8]; float s = 0.f;
#pragma unroll
        for (int j = 0; j < 8; ++j) { const u32x2 xv = xr[64 * j]; v[j] = (f32x4){bflo(xv.x), bfhi(xv.x), bflo(xv.y), bfhi(xv.y)}; s += (v[j].x * v[j].x + v[j].y * v[j].y) + (v[j].z * v[j].z + v[j].w * v[j].w); }
        const float rstd = 1.0f / sqrtf(wave_sum(s) * (1.0f / DM) + 1e-6f);
        float acc[16];
#pragma unroll
        for (int e = 0; e < 16; ++e) acc[e] = 0.f;
        unsigned* o4 = (unsigned*)(H2 + (size_t)m * DM) + lane;
#pragma unroll
        for (int j = 0; j < 8; ++j) { const f32x4 hv = v[j] * rstd * gr[64 * j]; { int pw = __builtin_amdgcn_cvt_pk_fp8_f32(hv.x, hv.y, 0, false); pw = __builtin_amdgcn_cvt_pk_fp8_f32(hv.z, hv.w, pw, true); o4[64 * j] = (unsigned)pw; }
            LAS float* wj0 = WR + 4 * (64 * j + lane); LAS float* wj1 = wj0 + 8 * DM; asm volatile("" : "+v"(wj0), "+v"(wj1));
#pragma unroll
            for (int e = 0; e < 8; ++e) { const f32x4 wa = *(const LAS f32x4*)(wj0 + e * DM), wb = *(const LAS f32x4*)(wj1 + e * DM);
                acc[e] += (hv[0] * wa[0] + hv[1] * wa[1]) + (hv[2] * wa[2] + hv[3] * wa[3]); acc[8 + e] += (hv[0] * wb[0] + hv[1] * wb[1]) + (hv[2] * wb[2] + hv[3] * wb[3]); }
            asm volatile("" ::: "memory"); }
        float r8[8], r4[4], r2[2], r1;
        { const bool up = (lane & 32) != 0;
#pragma unroll
            for (int i = 0; i < 8; ++i) { const float send = up ? acc[i] : acc[8 + i], keep = up ? acc[8 + i] : acc[i]; r8[i] = keep + __shfl_xor(send, 32); } }
        { const bool up = (lane & 16) != 0;
#pragma unroll
            for (int i = 0; i < 4; ++i) { const float send = up ? r8[i] : r8[4 + i], keep = up ? r8[4 + i] : r8[i]; r4[i] = keep + __shfl_xor(send, 16); } }
        { const bool up = (lane & 8) != 0;
#pragma unroll
            for (int i = 0; i < 2; ++i) { const float send = up ? r4[i] : r4[2 + i], keep = up ? r4[2 + i] : r4[i]; r2[i] = keep + __shfl_xor(send, 8); } }
        { const bool up = (lane & 4) != 0; const float send = up ? r2[0] : r2[1], keep = up ? r2[1] : r2[0]; r1 = keep + __shfl_xor(send, 4); }
        r1 += __shfl_xor(r1, 2); r1 += __shfl_xor(r1, 1);
        float mx = r1;
#pragma unroll
        for (int o = 4; o < 64; o <<= 1) mx = fmaxf(mx, __shfl_xor(mx, o));
        const float ex = __expf(r1 - mx); float sum = ex;
#pragma unroll
        for (int o = 4; o < 64; o <<= 1) sum += __shfl_xor(sum, o);
        if ((lane & 3) == 0) { const int e = (lane >> 2) & 15, b = m >> 11, t = m & (SEQ - 1); AFF[((size_t)b * NE + e) * SEQ + t] = ex / sum; }
    }
}

__device__ __forceinline__ int block_excl_scan(int v, int& total, LAS int* part, int lane, int wave) {
    int inc = v;
#pragma unroll
    for (int o = 1; o < 64; o <<= 1) { const int y = __shfl_up(inc, o); inc += (lane >= o) ? y : 0; }
    if (lane == 63) part[wave] = inc;
    __syncthreads();
    int base = 0, tot = 0;
#pragma unroll
    for (int ww = 0; ww < NWAVES; ++ww) { const int p = part[ww]; base += (ww < wave) ? p : 0; tot += p; }
    __syncthreads();
    total = tot; return base + inc - v;
}
__device__ __forceinline__ void topk_gather_phase(const Frame& F, LAS unsigned char* lds) {
    LAS int* IDX = (LAS int*)lds; LAS int* PART = (LAS int*)(lds + 1024); LAS int* CNT = (LAS int*)(lds + 1024 + 64);
    const float* AFF = (const float*)(F.ws + WS_AFF); float* GATE = (float*)(F.ws + WS_GATE); int* TOKSLOT = (int*)(F.ws + WS_TOKSLOT);
    const unsigned char* H2 = (unsigned char*)(F.ws + WS_H); unsigned char* XE = (unsigned char*)(F.ws + WS_XE);
    const int tid = F.tid, lane = F.lane, wave = F.wave;
    for (int uu = F.c; uu < 2 * NB * NE; uu += F.G) {
        const int u = uu >> 1, half = uu & 1, b = u >> 4, e = u & 15;
        __syncthreads();
        const u32x4 kv = *(const u32x4*)(AFF + (size_t)u * SEQ + 4 * tid);
        unsigned key[4]; key[0] = kv.x; key[1] = kv.y; key[2] = kv.z; key[3] = kv.w;
        asm volatile("" : "+v"(key[0]), "+v"(key[1]), "+v"(key[2]), "+v"(key[3]));
        unsigned T = 0u;
        for (int bit = 31; bit >= 0; --bit) { const unsigned cand = T | (1u << bit);
            int c = 0;
#pragma unroll
            for (int j = 0; j < 4; ++j) c += (key[j] >= cand) ? 1 : 0;
#pragma unroll
            for (int o = 1; o < 64; o <<= 1) c += __shfl_xor(c, o);
            if (lane == 0) CNT[(bit & 1) * 8 + wave] = c;
            __syncthreads();
            int tot = 0;
#pragma unroll
            for (int ww = 0; ww < NWAVES; ++ww) tot += CNT[(bit & 1) * 8 + ww];
            if (tot >= CAP) T = cand; }
        int ngt = 0, neq = 0;
#pragma unroll
        for (int j = 0; j < 4; ++j) { ngt += (key[j] > T) ? 1 : 0; neq += (key[j] == T) ? 1 : 0; }
        int tot_gt, tot_eq; const int eq_before = block_excl_scan(neq, tot_eq, PART, lane, wave); (void)block_excl_scan(ngt, tot_gt, PART, lane, wave);
        const int need = CAP - tot_gt;
        bool sel[4]; int nsel = 0, eqr = eq_before;
#pragma unroll
        for (int j = 0; j < 4; ++j) { const bool iseq = key[j] == T; sel[j] = (key[j] > T) || (iseq && eqr < need); eqr += iseq ? 1 : 0; nsel += sel[j] ? 1 : 0; }
        int tot_sel; int slot = block_excl_scan(nsel, tot_sel, PART, lane, wave);
#pragma unroll
        for (int j = 0; j < 4; ++j) { const int t = 4 * tid + j; const int sl = sel[j] ? slot : -1; if (half == 0) TOKSLOT[((size_t)b * SEQ + t) * NE + e] = sl;
            if (sel[j]) { IDX[slot] = t; if (half == 0) GATE[e * 2048 + b * CAP + slot] = __builtin_bit_cast(float, key[j]); ++slot; } }
        __syncthreads();
        for (int s8 = wave; s8 < CAP / 2; s8 += NWAVES) { const int sl = half * (CAP / 2) + s8; const int t = IDX[sl];
            const u32x4* src = (const u32x4*)(H2 + ((size_t)b * SEQ + t) * DM) + lane; u32x4* dst = (u32x4*)(XE + ((size_t)e * 2048 + b * CAP + sl) * DM) + lane;
#pragma unroll
            for (int j = 0; j < 2; ++j) dst[64 * j] = src[64 * j]; }
    }
}

__device__ __forceinline__ void combine_phase(const Frame& F) {
    const int* TOKSLOT = (const int*)(F.ws + WS_TOKSLOT); const bf16* YE = (const bf16*)(F.ws + WS_XE);
    const int lane = F.lane, gw = F.c * NWAVES + F.wave, NGW = F.G * NWAVES;
    for (int m = gw; m < MTOK; m += NGW) { const int b = m >> 11; const int myslot = lane < NE ? TOKSLOT[(size_t)m * NE + lane] : -1;
        f32x4* orow = (f32x4*)(F.out + (size_t)m * DM) + lane; const u32x2* xrow = (const u32x2*)((const bf16*)(F.ws + WS_X2) + (size_t)m * DM) + lane; f32x4 acc[8];
#pragma unroll
        for (int j = 0; j < 8; ++j) { const u32x2 xv = xrow[64 * j]; acc[j] = (f32x4){bflo(xv.x), bfhi(xv.x), bflo(xv.y), bfhi(xv.y)}; }
#pragma unroll
        for (int e = 0; e < NE; ++e) { const int sl = __builtin_amdgcn_readlane(myslot, e);
            if (sl >= 0) { const u32x2* yr = (const u32x2*)(YE + ((size_t)e * 2048 + b * CAP + sl) * DM) + lane;
#pragma unroll
                for (int j = 0; j < 8; ++j) { const u32x2 v = __builtin_nontemporal_load(&yr[64 * j]); acc[j] += (f32x4){bflo(v.x), bfhi(v.x), bflo(v.y), bfhi(v.y)}; } } }
#pragma unroll
        for (int j = 0; j < 8; ++j) __builtin_nontemporal_store(acc[j], &orow[64 * j]);
    }
}
constexpr int CS_ST = 160, CS_MAT = 64 * CS_ST;
constexpr int CL_LW2 = 0, CL_LA2 = CS_MAT, CL_AT = 2 * CS_MAT, CL_BT = 3 * CS_MAT, CL_KT = 4 * CS_MAT, CL_RT = 5 * CS_MAT, CL_VM = 6 * CS_MAT;
constexpr int CL_NT = 7 * CS_MAT, CL_MK = 8 * CS_MAT, CL_PBM = 9 * CS_MAT, CL_PKM = 10 * CS_MAT, CL_X1 = 11 * CS_MAT, CL_X2 = 12 * CS_MAT;
constexpr int CL_TOT = 13 * CS_MAT, CL_GL = CL_TOT + 2048, CL_CST = CL_GL + 256, CL_MU = CL_CST + 1536, CL_END = CL_MU + 3840;
constexpr int CL_WR = CL_NT, WR_ST = 272, CL_AR = CL_WR + 64 * WR_ST;
static_assert(CL_AR + 64 * WR_ST <= CL_X1 && CL_END <= LDS_BYTES - 16, "scan LDS map");
__device__ __forceinline__ bf16x8 cs_ld_row(LAS unsigned char* M, int row0, int ks, int c16, int g) { return *(LAS bf16x8*)(M + (row0 + c16) * CS_ST + (32 * ks + 8 * g) * 2); }
__device__ __forceinline__ bf16x8 cs_ld_tr(LAS unsigned char* M, int col0, int ks, int c16, int g) {
    LAS unsigned char* p = M + (32 * ks + 8 * g + (c16 >> 2)) * CS_ST + (col0 + 4 * (c16 & 3)) * 2;
    const s16x4 lo = tr_read(p), hi = tr_read(p + 4 * CS_ST);
    return (bf16x8){lo[0], lo[1], lo[2], lo[3], hi[0], hi[1], hi[2], hi[3]};
}
template <bool ATR, bool BTR> __device__ __forceinline__ void cs_mm(f32x4 (&acc)[2], LAS unsigned char* MA, LAS unsigned char* MB, int rb, int cb0, int c16, int g) {
#pragma unroll
    for (int ks = 0; ks < 2; ++ks) { const bf16x8 a = ATR ? cs_ld_tr(MA, 16 * rb, ks, c16, g) : cs_ld_row(MA, 16 * rb, ks, c16, g);
#pragma unroll
        for (int q = 0; q < 2; ++q) { const bf16x8 b = BTR ? cs_ld_tr(MB, 16 * (cb0 + q), ks, c16, g) : cs_ld_row(MB, 16 * (cb0 + q), ks, c16, g); acc[q] = mfma16(b, a, acc[q]); } }
}
__device__ __forceinline__ void cs_st(LAS unsigned char* M, int rb, int cb, const f32x4 v, int c16, int g) {
    u32x2 o; o.x = pk2(v[0], v[1]); o.y = pk2(v[2], v[3]); *(LAS u32x2*)(M + (16 * rb + c16) * CS_ST + (16 * cb + 4 * g) * 2) = o;
}
#define CS_ZERO2(a) do { a[0] = (f32x4){0.f, 0.f, 0.f, 0.f}; a[1] = (f32x4){0.f, 0.f, 0.f, 0.f}; } while (0)

__device__ __forceinline__ bf16x8 cs_ld_perm(LAS unsigned char* M, int row0, int c0, int c16, int g) { LAS unsigned char* p = M + (row0 + c16) * CS_ST + (c0 + 4 * g) * 2;
    const u32x2 lo = *(LAS u32x2*)p, hi = *(LAS u32x2*)(p + 32); return __builtin_bit_cast(bf16x8, (u32x4){lo.x, lo.y, hi.x, hi.y}); }
__device__ __forceinline__ bf16x8 cs_ld_perm16(LAS unsigned char* M, int row0, int c0, int c16, int g) { const u32x2 lo = *(LAS u32x2*)(M + (row0 + c16) * CS_ST + (c0 + 4 * g) * 2); return __builtin_bit_cast(bf16x8, (u32x4){lo.x, lo.y, 0u, 0u}); }
__device__ __forceinline__ bf16x8 cs_ld_trp(LAS unsigned char* M, int r0, int col0, int c16, int g) { LAS unsigned char* p = M + (r0 + 4 * g + (c16 >> 2)) * CS_ST + (col0 + 4 * (c16 & 3)) * 2;
    const s16x4 lo = tr_read(p), hi = tr_read(p + 16 * CS_ST); return (bf16x8){lo[0], lo[1], lo[2], lo[3], hi[0], hi[1], hi[2], hi[3]}; }
__device__ __forceinline__ bf16x8 cs_pack(const f32x4 a, const f32x4 b) { return __builtin_bit_cast(bf16x8, (u32x4){pk2(a[0], a[1]), pk2(a[2], a[3]), pk2(b[0], b[1]), pk2(b[2], b[3])}); }
__device__ __forceinline__ bf16x8 cs_pack1(const f32x4 a) { return __builtin_bit_cast(bf16x8, (u32x4){pk2(a[0], a[1]), pk2(a[2], a[3]), 0u, 0u}); }

__device__ __forceinline__ void scan_phase2(const Frame& F, LAS unsigned char* lds) {
    const bf16* PROJ = (const bf16*)(F.ws + WS_PROJ); float* WKV = (float*)(F.ws + WS_WKV); float* SBG = (float*)(F.ws + WS_SB);
    const float* mu_prev = gptr(F.in[6]); const float* mu_next = gptr(F.in[7]); const float* w0 = gptr(F.in[8]); const float* w2 = gptr(F.in[9]); const float* a0 = gptr(F.in[10]); const float* a2 = gptr(F.in[11]);
    const float* k_k = gptr(F.in[13]); const float* k_a = gptr(F.in[14]); const float* r_k = gptr(F.in[15]);
    const int tid = F.tid, lane = F.lane, w = F.wave;
    const int tl = lane & 7, cg = lane >> 3, trow = 8 * w + tl, cg8 = 8 * cg;
    const int c16 = lane & 15, g = lane >> 4, rb = w >> 1, cb0 = 2 * (w & 1);
    for (int sid = F.c; sid < 256; sid += F.G) {
        const int z = sid >> 7, b = (sid >> 4) & 7, h = sid & 15;
        __syncthreads();
        LAS unsigned char* L1 = lds; asm volatile("" : "+v"(L1));
        for (int i = tid; i < 4096; i += NTHR) { const int l = i >> 6, c = i & 63;
            *(LAS bf16*)(L1 + CL_LW2 + l * CS_ST + c * 2) = (bf16)f2bf(w2[((size_t)z * 64 + l) * RWW + h * 64 + c]);
            *(LAS bf16*)(L1 + CL_LA2 + l * CS_ST + c * 2) = (bf16)f2bf(a2[((size_t)z * 64 + l) * RWW + h * 64 + c]);
        }
        const int fc0 = 64 * h, fc1 = 1024 + 64 * h, fc2 = 2048 + 64 * h, fc3 = 3072 + 64 * z, fc4 = 3200 + 64 * z;
        { LAS float* MU = (LAS float*)(L1 + CL_MU); LAS float* CST = (LAS float*)(L1 + CL_CST);
            if (tid < 64) { const int c = tid; const int fcs[5] = {fc0, fc1, fc2, fc3, fc4};
#pragma unroll
                for (int f = 0; f < 5; ++f) { const float mp_ = mu_prev[fcs[f] + c], mn_ = mu_next[fcs[f] + c]; MU[(3 * f) * 64 + c] = 1.0f - mp_ - mn_; MU[(3 * f + 1) * 64 + c] = mp_; MU[(3 * f + 2) * 64 + c] = mn_; }
                const float ka_ = k_a[64 * h + c];
                CST[c] = w0[z * RWW + 64 * h + c]; CST[64 + c] = a0[z * RWW + 64 * h + c]; CST[128 + c] = k_k[64 * h + c]; CST[192 + c] = ka_; CST[256 + c] = 1.0f - ka_; CST[320 + c] = r_k[h * 64 + c]; } }
        f32x4 SK[4];
#pragma unroll
        for (int kb = 0; kb < 4; ++kb) SK[kb] = (f32x4){0.f, 0.f, 0.f, 0.f};
        u32x4 raw[15];
#define CS_ISSUE_A(cj) do { const int sidx_ = (cj) * 64 + trow; const int t_ = z ? (SEQ - 1 - sidx_) : sidx_; const bf16* p0_ = PROJ + ((size_t)b * SEQ + t_) * LDP + PC_RW + cg8; \
            _Pragma("unroll") for (int f = 0; f < 5; ++f) { const int fc = (f == 0) ? fc0 : (f == 1) ? fc1 : (f == 2) ? fc2 : (f == 3) ? fc3 : fc4; raw[3 * f] = *(const u32x4*)(p0_ + fc); } } while (0)
#define CS_ISSUE_B(cj) do { const int sidx_ = (cj) * 64 + trow; const int t_ = z ? (SEQ - 1 - sidx_) : sidx_; const bf16* p0_ = PROJ + ((size_t)b * SEQ + t_) * LDP + PC_RW + cg8; \
            const int dm_ = t_ > 0 ? -LDP : 0, dn_ = t_ < SEQ - 1 ? LDP : 0; \
            _Pragma("unroll") for (int f = 0; f < 5; ++f) { const int fc = (f == 0) ? fc0 : (f == 1) ? fc1 : (f == 2) ? fc2 : (f == 3) ? fc3 : fc4; \
                raw[3 * f + 1] = *(const u32x4*)(p0_ + fc + dm_); raw[3 * f + 2] = *(const u32x4*)(p0_ + fc + dn_); } } while (0)
        CS_ISSUE_A(0); CS_ISSUE_B(0);
        f32x2 xr[4], xk[4], xv[4];
#define CS_S0(CJ) do { \
            { const int sidx0_ = (CJ) * 64 + trow; const int t0_ = z ? (SEQ - 1 - sidx0_) : sidx0_; const bool edge = ((CJ) == 0) || ((CJ) == 31); const float fpm = t0_ > 0 ? 1.f : 0.f, fpn = t0_ < SEQ - 1 ? 1.f : 0.f; \
            _Pragma("unroll") \
                for (int f = 0; f < 5; ++f) { \
                    f32x2 c0[4], pm[4], pn[4], xs[4]; unpack8v(raw[3 * f], c0); unpack8v(raw[3 * f + 1], pm); unpack8v(raw[3 * f + 2], pn); \
                    if (edge) { \
            _Pragma("unroll") \
                        for (int i = 0; i < 4; ++i) { pm[i] = pm[i] * fpm; pn[i] = pn[i] * fpn; } } \
                    const LAS f32x4* mu = (const LAS f32x4*)&MU[(3 * f) * 64 + cg8];                   \
                    const f32x4 k0A = mu[0], k0B = mu[1], mpA = mu[16], mpB = mu[17], mnA = mu[32], mnB = mu[33]; \
                    xs[0] = c0[0] * k0A.xy + pm[0] * mpA.xy + pn[0] * mnA.xy; xs[1] = c0[1] * k0A.zw + pm[1] * mpA.zw + pn[1] * mnA.zw; \
                    xs[2] = c0[2] * k0B.xy + pm[2] * mpB.xy + pn[2] * mnB.xy; xs[3] = c0[3] * k0B.zw + pm[3] * mpB.zw + pn[3] * mnB.zw; \
                    if (f == 0) { \
            _Pragma("unroll") \
                        for (int i = 0; i < 4; ++i) xr[i] = xs[i]; } \
                    else if (f == 1) { \
            _Pragma("unroll") \
                        for (int i = 0; i < 4; ++i) xk[i] = xs[i]; } \
                    else if (f == 2) { \
            _Pragma("unroll") \
                        for (int i = 0; i < 4; ++i) xv[i] = xs[i]; } \
                    else { if (f == 3) { \
            _Pragma("unroll") \
                            for (int i = 0; i < 4; ++i) { const f32x2 a2 = xs[i] * 2.885390082f; f32x2 e2; e2.x = __builtin_amdgcn_exp2f(a2.x); e2.y = __builtin_amdgcn_exp2f(a2.y); e2 = e2 + 1.0f; \
                                f32x2 rr; rr.x = __builtin_amdgcn_rcpf(e2.x); rr.y = __builtin_amdgcn_rcpf(e2.y); xs[i] = rr * (-2.0f) + 1.0f; } }                    \
                        u32x4 pk; pk.x = pk2(xs[0].x, xs[0].y); pk.y = pk2(xs[1].x, xs[1].y); pk.z = pk2(xs[2].x, xs[2].y); pk.w = pk2(xs[3].x, xs[3].y); \
                        *(LAS u32x4*)(L0 + (f == 3 ? CL_X1 : CL_X2) + trow * CS_ST + cg8 * 2) = pk; } } } \
            } while (0)
        __syncthreads();
        { LAS unsigned char* L0 = lds; asm volatile("" : "+v"(L0)); LAS float* MU = (LAS float*)(L0 + CL_MU); CS_S0(0); }
        __syncthreads();
        for (int ci = 0; ci < 32; ++ci) {
            LAS unsigned char* L0 = lds; asm volatile("" : "+v"(L0));
            LAS float* MU = (LAS float*)(L0 + CL_MU); LAS float* CST = (LAS float*)(L0 + CL_CST);
            { f32x4 wa[2], aa[2]; CS_ZERO2(wa); CS_ZERO2(aa);
                { bf16x8 a1[2], a2_[2], b10[2], b11[2], b20[2], b21[2];
                    a1[0] = cs_ld_row(L0 + CL_X1, 16 * rb, 0, c16, g); a1[1] = cs_ld_row(L0 + CL_X1, 16 * rb, 1, c16, g); a2_[0] = cs_ld_row(L0 + CL_X2, 16 * rb, 0, c16, g); a2_[1] = cs_ld_row(L0 + CL_X2, 16 * rb, 1, c16, g);
                    b10[0] = cs_ld_tr(L0 + CL_LW2, 16 * cb0, 0, c16, g); b10[1] = cs_ld_tr(L0 + CL_LW2, 16 * cb0, 1, c16, g); b11[0] = cs_ld_tr(L0 + CL_LW2, 16 * cb0 + 16, 0, c16, g); b11[1] = cs_ld_tr(L0 + CL_LW2, 16 * cb0 + 16, 1, c16, g);
                    b20[0] = cs_ld_tr(L0 + CL_LA2, 16 * cb0, 0, c16, g); b20[1] = cs_ld_tr(L0 + CL_LA2, 16 * cb0, 1, c16, g); b21[0] = cs_ld_tr(L0 + CL_LA2, 16 * cb0 + 16, 0, c16, g); b21[1] = cs_ld_tr(L0 + CL_LA2, 16 * cb0 + 16, 1, c16, g);
                    __builtin_amdgcn_sched_barrier(0);
                    wa[0] = mfma16(b10[0], a1[0], wa[0]); wa[1] = mfma16(b11[0], a1[0], wa[1]); wa[0] = mfma16(b10[1], a1[1], wa[0]); wa[1] = mfma16(b11[1], a1[1], wa[1]);
                    aa[0] = mfma16(b20[0], a2_[0], aa[0]); aa[1] = mfma16(b21[0], a2_[0], aa[1]); aa[0] = mfma16(b20[1], a2_[1], aa[0]); aa[1] = mfma16(b21[1], a2_[1], aa[1]); }
#pragma unroll
                for (int q = 0; q < 2; ++q) { const int off = (16 * rb + c16) * WR_ST + (16 * (cb0 + q) + 4 * g) * 4; *(LAS f32x4*)(L0 + CL_WR + off) = wa[q]; *(LAS f32x4*)(L0 + CL_AR + off) = aa[q]; } }
            __syncthreads();
            CS_ISSUE_A(ci < 31 ? ci + 1 : 31);
            f32x2 lw[4], av[4], bv[4]; float lam[8];
            { const LAS f32x4* wrp = (const LAS f32x4*)(L0 + CL_WR + trow * WR_ST + cg8 * 4); const LAS f32x4* arp = (const LAS f32x4*)(L0 + CL_AR + trow * WR_ST + cg8 * 4);
                const f32x4 wA = wrp[0], wB = wrp[1], aA = arp[0], aB = arp[1];
                const LAS f32x4* cst = (const LAS f32x4*)&CST[cg8];
                const f32x4 w0A = cst[0], w0B = cst[1], a0A = cst[16], a0B = cst[17], kkA = cst[32], kkB = cst[33], kaA = cst[48], kaB = cst[49], okA = cst[64], okB = cst[65], rkA = cst[80], rkB = cst[81];
                const f32x2 wr_[4] = {wA.xy + w0A.xy, wA.zw + w0A.zw, wB.xy + w0B.xy, wB.zw + w0B.zw}, ar_[4] = {aA.xy + a0A.xy, aA.zw + a0A.zw, aB.xy + a0B.xy, aB.zw + a0B.zw};
                const f32x2 kkc[4] = {kkA.xy, kkA.zw, kkB.xy, kkB.zw}, kac[4] = {kaA.xy, kaA.zw, kaB.xy, kaB.zw}, okc[4] = {okA.xy, okA.zw, okB.xy, okB.zw}, rkc[4] = {rkA.xy, rkA.zw, rkB.xy, rkB.zw};
                f32x2 kk[4], ss2 = (f32x2){0.f, 0.f}, bo2 = (f32x2){0.f, 0.f};
#pragma unroll
                for (int i = 0; i < 4; ++i) { kk[i] = xk[i] * kkc[i]; ss2 = kk[i] * kk[i] + ss2; }
                float ssq = ss2.x + ss2.y;
                ssq += dppf<0x128>(ssq); ssq += __shfl_xor(ssq, 16); ssq += __shfl_xor(ssq, 32);
                const float ninv = -__builtin_amdgcn_rcpf(fmaxf(__builtin_amdgcn_sqrtf(ssq), 1e-12f));
#pragma unroll
                for (int i = 0; i < 4; ++i) { f32x2 ew = wr_[i] * (-1.442695041f), ea = ar_[i] * (-1.442695041f);
                    ew.x = __builtin_amdgcn_exp2f(ew.x); ew.y = __builtin_amdgcn_exp2f(ew.y); ea.x = __builtin_amdgcn_exp2f(ea.x); ea.y = __builtin_amdgcn_exp2f(ea.y); ew = ew + 1.0f; ea = ea + 1.0f;
                    f32x2 sw, as; sw.x = __builtin_amdgcn_rcpf(ew.x); sw.y = __builtin_amdgcn_rcpf(ew.y); as.x = __builtin_amdgcn_rcpf(ea.x); as.y = __builtin_amdgcn_rcpf(ea.y);
                    lw[i] = sw * (-0.6065306597f); av[i] = kk[i] * ninv; bv[i] = -(av[i] * as);
                    const f32x2 kd = xk[i] * (as * kac[i] + okc[i]); bo2 = xr[i] * (kd * rkc[i]) + bo2; xk[i] = kd; }
                float bon = bo2.x + bo2.y;
                bon += dppf<0x128>(bon); bon += __shfl_xor(bon, 16); bon += __shfl_xor(bon, 32);
                if (cg == 0) { const int sidx = ci * 64 + trow; const int t = z ? (SEQ - 1 - sidx) : sidx; SBG[((size_t)z * MTOK + (size_t)b * SEQ + t) * 16 + h] = 0.5f * bon; }
#pragma unroll
                for (int j = 0; j < 8; ++j) { float y = lw[j >> 1][j & 1]; float s1 = dppf<0x111>(y); y += (tl >= 1) ? s1 : 0.f; float s2 = dppf<0x112>(y); y += (tl >= 2) ? s2 : 0.f; float s4 = dppf<0x114>(y); y += (tl >= 4) ? s4 : 0.f; lam[j] = y; }
                if (tl == 7) { LAS float* TOT = (LAS float*)(L0 + CL_TOT) + w * 64 + cg8; *(LAS f32x4*)TOT = (f32x4){lam[0], lam[1], lam[2], lam[3]}; *(LAS f32x4*)(TOT + 4) = (f32x4){lam[4], lam[5], lam[6], lam[7]}; } }
            __syncthreads();
            { f32x2 pre[4];
#pragma unroll
                for (int i = 0; i < 4; ++i) pre[i] = (f32x2){lam[2 * i], lam[2 * i + 1]};
                for (int ww = 0; ww < w; ++ww) { const LAS f32x4* TOT = (const LAS f32x4*)((const LAS float*)(L0 + CL_TOT) + ww * 64 + cg8); const f32x4 tA = TOT[0], tB = TOT[1];
                    pre[0] = pre[0] + tA.xy; pre[1] = pre[1] + tA.zw; pre[2] = pre[2] + tB.xy; pre[3] = pre[3] + tB.zw; }
                u32x4 pA, pB, pK, pR, pV; unsigned* qa = (unsigned*)&pA; unsigned* qb = (unsigned*)&pB; unsigned* qk = (unsigned*)&pK; unsigned* qr = (unsigned*)&pR; unsigned* qv = (unsigned*)&pV;
#pragma unroll
                for (int i = 0; i < 4; ++i) { const f32x2 l2 = pre[i] * 1.442695041f, m2 = (pre[i] - lw[i]) * 1.442695041f; f32x2 E, Em, Ei;
                    E.x = __builtin_amdgcn_exp2f(l2.x); E.y = __builtin_amdgcn_exp2f(l2.y); Em.x = __builtin_amdgcn_exp2f(m2.x); Em.y = __builtin_amdgcn_exp2f(m2.y); Ei.x = __builtin_amdgcn_rcpf(E.x); Ei.y = __builtin_amdgcn_rcpf(E.y);
                    const f32x2 at = av[i] * Em, bt = bv[i] * Ei, kt = xk[i] * Ei, rt = xr[i] * E;
                    qa[i] = pk2(at.x, at.y); qb[i] = pk2(bt.x, bt.y); qk[i] = pk2(kt.x, kt.y); qr[i] = pk2(rt.x, rt.y); qv[i] = pk2(xv[i].x, xv[i].y);
                    if (trow == 63) *(LAS f32x2*)(L0 + CL_GL + (cg8 + 2 * i) * 4) = E; }
                *(LAS u32x4*)(L0 + CL_AT + trow * CS_ST + cg8 * 2) = pA; *(LAS u32x4*)(L0 + CL_BT + trow * CS_ST + cg8 * 2) = pB; *(LAS u32x4*)(L0 + CL_KT + trow * CS_ST + cg8 * 2) = pK;
                *(LAS u32x4*)(L0 + CL_RT + trow * CS_ST + cg8 * 2) = pR; *(LAS u32x4*)(L0 + CL_VM + trow * CS_ST + cg8 * 2) = pV; }
            __syncthreads();
#define LDROW2(dst, M, row0) do { dst[0] = cs_ld_row(M, row0, 0, c16, g); dst[1] = cs_ld_row(M, row0, 1, c16, g); } while (0)
#define LDTR2(dst, M, col0) do { dst[0] = cs_ld_tr(M, col0, 0, c16, g); dst[1] = cs_ld_tr(M, col0, 1, c16, g); } while (0)
#define MM2(acc, a, b0, b1) do { acc[0] = mfma16(b0[0], a[0], acc[0]); acc[1] = mfma16(b1[0], a[0], acc[1]); acc[0] = mfma16(b0[1], a[1], acc[0]); acc[1] = mfma16(b1[1], a[1], acc[1]); } while (0)
#define SB0() __builtin_amdgcn_sched_barrier(0)
            CS_ISSUE_B(ci < 31 ? ci + 1 : 31);
            if (cb0 <= rb) {
                f32x4 nn[2], mk[2], pb[2], pkk[2]; CS_ZERO2(nn); CS_ZERO2(mk); CS_ZERO2(pb); CS_ZERO2(pkk);
                bf16x8 aA[2], aR[2], bB0[2], bB1[2], bK0[2], bK1[2];
                LDROW2(aA, L0 + CL_AT, 16 * rb); LDROW2(aR, L0 + CL_RT, 16 * rb); LDROW2(bB0, L0 + CL_BT, 16 * cb0); LDROW2(bB1, L0 + CL_BT, 16 * cb0 + 16); LDROW2(bK0, L0 + CL_KT, 16 * cb0); LDROW2(bK1, L0 + CL_KT, 16 * cb0 + 16);
                SB0();
                MM2(nn, aA, bB0, bB1); MM2(mk, aA, bK0, bK1); MM2(pb, aR, bB0, bB1); MM2(pkk, aR, bK0, bK1);
                const int qd = rb - cb0;
#pragma unroll
                for (int q = 0; q < 2; ++q) {
#pragma unroll
                    for (int reg = 0; reg < 4; ++reg) { const int tt_ = 16 * rb + c16, ii = 16 * (cb0 + q) + 4 * g + reg; const bool lo = ii < tt_, le = ii <= tt_;
                        nn[q][reg] = lo ? nn[q][reg] : 0.f; mk[q][reg] = lo ? mk[q][reg] : 0.f; pb[q][reg] = le ? pb[q][reg] : 0.f; pkk[q][reg] = le ? pkk[q][reg] : 0.f; }
                    if (q != qd) cs_st(L0 + CL_NT, rb, cb0 + q, nn[q], c16, g);
                    cs_st(L0 + CL_MK, rb, cb0 + q, mk[q], c16, g); cs_st(L0 + CL_PBM, rb, cb0 + q, pb[q], c16, g); cs_st(L0 + CL_PKM, rb, cb0 + q, pkk[q], c16, g); }
                if (qd < 2) {
                    const f32x4 z4 = (f32x4){0.f, 0.f, 0.f, 0.f};
                    const bf16x8 bD0 = qd ? bB1[0] : bB0[0], bD1 = qd ? bB1[1] : bB0[1];
                    f32x4 xX = mfma16(aA[0], bD0, z4); xX = mfma16(aA[1], bD1, xX);
                    const f32x4 xT = qd ? nn[1] : nn[0];
                    f32x4 pT = xT;
#pragma unroll
                    for (int reg = 0; reg < 4; ++reg) { xX[reg] = (c16 < 4 * g + reg) ? xX[reg] : 0.f; pT[reg] += (4 * g + reg == c16) ? 1.0f : 0.f; }
                    bf16x8 pX = cs_pack1(xX), pXT = cs_pack1(xT);
#pragma unroll
                    for (int lvl = 0; lvl < 3; ++lvl) {
                        const f32x4 x2 = mfma16(pXT, pX, z4);
                        const bf16x8 pPT = cs_pack1(pT);
                        f32x4 x2t = z4; if (lvl < 2) x2t = mfma16(pX, pXT, z4);
                        const bf16x8 pXn = cs_pack1(x2);
                        pT = mfma16(pXn, pPT, pT);
                        pX = pXn; if (lvl < 2) pXT = cs_pack1(x2t); }
                    cs_st(L0 + CL_NT, rb, rb, pT, c16, g); } }
            __syncthreads();
            if (w < 4) {
                const int vj = 16 * w; const f32x4 z4 = (f32x4){0.f, 0.f, 0.f, 0.f};
                bf16x8 sb[2], vB[2], ub[2]; f32x4 Zb[4], Ob[4];
                bf16x8 fA[4][2];
                LDTR2(vB, L0 + CL_VM, vj);
#pragma unroll
                for (int tb = 0; tb < 4; ++tb) { fA[tb][0] = cs_ld_perm(L0 + CL_AT, 16 * tb, 0, c16, g); fA[tb][1] = cs_ld_perm(L0 + CL_AT, 16 * tb, 32, c16, g); }
                sb[0] = cs_pack(SK[0], SK[1]); sb[1] = cs_pack(SK[2], SK[3]);
                SB0();
                bf16x8 fM[6];
                fM[0] = cs_ld_row(L0 + CL_MK, 0, 0, c16, g); fM[1] = cs_ld_row(L0 + CL_MK, 16, 0, c16, g); fM[2] = cs_ld_row(L0 + CL_MK, 32, 0, c16, g); fM[3] = cs_ld_row(L0 + CL_MK, 32, 1, c16, g);
                fM[4] = cs_ld_row(L0 + CL_MK, 48, 0, c16, g); fM[5] = cs_ld_row(L0 + CL_MK, 48, 1, c16, g);
                const bf16x8 t00 = cs_ld_perm16(L0 + CL_NT, 0, 0, c16, g), n10 = cs_ld_perm16(L0 + CL_NT, 16, 0, c16, g), t11 = cs_ld_perm16(L0 + CL_NT, 16, 16, c16, g);
                const bf16x8 n2x = cs_ld_perm(L0 + CL_NT, 32, 0, c16, g), n3x = cs_ld_perm(L0 + CL_NT, 48, 0, c16, g), t22 = cs_ld_perm16(L0 + CL_NT, 32, 32, c16, g), n32 = cs_ld_perm16(L0 + CL_NT, 48, 32, c16, g), t33 = cs_ld_perm16(L0 + CL_NT, 48, 48, c16, g);
                SB0();
#pragma unroll
                for (int tb = 0; tb < 4; ++tb) { Zb[tb] = mfma16(fA[tb][0], sb[0], z4); Zb[tb] = mfma16(fA[tb][1], sb[1], Zb[tb]); }
                SB0();
                Zb[0] = mfma16(fM[0], vB[0], Zb[0]); Zb[1] = mfma16(fM[1], vB[0], Zb[1]); Zb[2] = mfma16(fM[2], vB[0], Zb[2]); Zb[3] = mfma16(fM[4], vB[0], Zb[3]);
                Zb[2] = mfma16(fM[3], vB[1], Zb[2]); Zb[3] = mfma16(fM[5], vB[1], Zb[3]);
                { const f32x4 u0 = mfma16(t00, cs_pack1(Zb[0]), z4);
                  const f32x4 z1 = mfma16(n10, cs_pack1(u0), Zb[1]);
                  const f32x4 u1 = mfma16(t11, cs_pack1(z1), z4);
                  ub[0] = cs_pack(u0, u1);
                  const f32x4 z2 = mfma16(n2x, ub[0], Zb[2]);
                  f32x4 z3 = mfma16(n3x, ub[0], Zb[3]);
                  const f32x4 u2 = mfma16(t22, cs_pack1(z2), z4);
                  z3 = mfma16(n32, cs_pack1(u2), z3);
                  const f32x4 u3 = mfma16(t33, cs_pack1(z3), z4);
                  ub[1] = cs_pack(u2, u3); }
                SB0();
                bf16x8 fR[4][2], fP[6];
#pragma unroll
                for (int tb = 0; tb < 4; ++tb) { fR[tb][0] = cs_ld_perm(L0 + CL_RT, 16 * tb, 0, c16, g); fR[tb][1] = cs_ld_perm(L0 + CL_RT, 16 * tb, 32, c16, g); }
                fP[0] = cs_ld_row(L0 + CL_PKM, 0, 0, c16, g); fP[1] = cs_ld_row(L0 + CL_PKM, 16, 0, c16, g); fP[2] = cs_ld_row(L0 + CL_PKM, 32, 0, c16, g); fP[3] = cs_ld_row(L0 + CL_PKM, 32, 1, c16, g);
                fP[4] = cs_ld_row(L0 + CL_PKM, 48, 0, c16, g); fP[5] = cs_ld_row(L0 + CL_PKM, 48, 1, c16, g);
                SB0();
#pragma unroll
                for (int tb = 0; tb < 4; ++tb) { Ob[tb] = mfma16(fR[tb][0], sb[0], z4); Ob[tb] = mfma16(fR[tb][1], sb[1], Ob[tb]); }
                Ob[0] = mfma16(fP[0], vB[0], Ob[0]); Ob[1] = mfma16(fP[1], vB[0], Ob[1]); Ob[2] = mfma16(fP[2], vB[0], Ob[2]); Ob[3] = mfma16(fP[4], vB[0], Ob[3]);
                Ob[2] = mfma16(fP[3], vB[1], Ob[2]); Ob[3] = mfma16(fP[5], vB[1], Ob[3]);
                SB0();
                bf16x8 fB[6], fBt[4][2];
                fB[0] = cs_ld_perm(L0 + CL_PBM, 0, 0, c16, g); fB[1] = cs_ld_perm(L0 + CL_PBM, 16, 0, c16, g); fB[2] = cs_ld_perm(L0 + CL_PBM, 32, 0, c16, g); fB[3] = cs_ld_perm(L0 + CL_PBM, 32, 32, c16, g);
                fB[4] = cs_ld_perm(L0 + CL_PBM, 48, 0, c16, g); fB[5] = cs_ld_perm(L0 + CL_PBM, 48, 32, c16, g);
#pragma unroll
                for (int kb = 0; kb < 4; ++kb) { fBt[kb][0] = cs_ld_trp(L0 + CL_BT, 0, 16 * kb, c16, g); fBt[kb][1] = cs_ld_trp(L0 + CL_BT, 32, 16 * kb, c16, g); }
                SB0();
                Ob[0] = mfma16(fB[0], ub[0], Ob[0]); Ob[1] = mfma16(fB[1], ub[0], Ob[1]); Ob[2] = mfma16(fB[2], ub[0], Ob[2]); Ob[3] = mfma16(fB[4], ub[0], Ob[3]);
                Ob[2] = mfma16(fB[3], ub[1], Ob[2]); Ob[3] = mfma16(fB[5], ub[1], Ob[3]);
#pragma unroll
                for (int kb = 0; kb < 4; ++kb) { SK[kb] = mfma16(fBt[kb][0], ub[0], SK[kb]); SK[kb] = mfma16(fBt[kb][1], ub[1], SK[kb]); }
                SB0();
                bf16x8 fKt[4][2]; f32x4 gl[4];
#pragma unroll
                for (int kb = 0; kb < 4; ++kb) { fKt[kb][0] = cs_ld_tr(L0 + CL_KT, 16 * kb, 0, c16, g); fKt[kb][1] = cs_ld_tr(L0 + CL_KT, 16 * kb, 1, c16, g); gl[kb] = *(LAS f32x4*)(L0 + CL_GL + (16 * kb + 4 * g) * 4); }
#pragma unroll
                for (int tb = 0; tb < 4; ++tb) {
#pragma unroll
                    for (int i = 0; i < 4; ++i) { const int ts = ci * 64 + 16 * tb + 4 * g + i; const int tt_ = z ? (SEQ - 1 - ts) : ts; WKV[((size_t)z * MTOK + (size_t)b * SEQ + tt_) * RWW + h * 64 + vj + c16] = Ob[tb][i]; } }
                SB0();
#pragma unroll
                for (int kb = 0; kb < 4; ++kb) { SK[kb] = mfma16(fKt[kb][0], vB[0], SK[kb]); SK[kb] = mfma16(fKt[kb][1], vB[1], SK[kb]); SK[kb] = SK[kb] * gl[kb]; }
            }
            if (ci < 31) { CS_S0(ci + 1); }
            __syncthreads();
        }
    }
}
#ifndef PROBE_PHASE
#define PROBE_PHASE -1
#endif
#ifdef PROBE_NOBAR
#define PROBE_SEAM() __syncthreads()
#else
#define PROBE_SEAM() xcd_barrier(xbar)
#endif
#define REP(k) for (int rep_ = 0; rep_ < ((k) == PROBE_PHASE ? 2 : 1); ++rep_)
#ifndef SP2
#define SP2 true
#endif
#ifndef FP8_SP2
#define FP8_SP2 true
#endif
#ifndef ALIGN_EPI
#define ALIGN_EPI true
#endif
__global__ void __launch_bounds__(NTHR, 2) fwd_kernel(Args args) {
    extern __shared__ __attribute__((aligned(16))) unsigned char lds_raw[];
    cg::grid_group grid = cg::this_grid();
    LAS unsigned char* lds = (LAS unsigned char*)lds_raw;
#define MKFRAME() Frame F; { int t_ = threadIdx.x; asm volatile("" : "+v"(t_)); unsigned char* w_ = args.ws; asm volatile("" : "+s"(w_)); \
    F.lds = lds_raw; F.tid = t_; F.lane = t_ & 63; F.wave = __builtin_amdgcn_readfirstlane(t_ >> 6); F.G = gridDim.x; F.c = blockIdx.x; F.in = args.in; F.out = gptr(args.out); F.ws = (GAS unsigned char*)w_; } \
    GAS unsigned char* ws = F.ws; (void)ws
    if (args.out == nullptr) grid.sync();
    { volatile LAS unsigned* st = (volatile LAS unsigned*)(lds + LDS_BYTES - 16); if (threadIdx.x < 4) st[threadIdx.x] = 0u; }
    __syncthreads();
    const XcdBarrier xbar = xcd_barrier_post((unsigned*)(args.ws + WS_CTL), (volatile LAS unsigned*)(lds + LDS_BYTES - 16));
#if !defined(ONLY) || ONLY==0
    REP(0) { if (rep_) { __syncthreads(); } MKFRAME(); p0_prologue(F, lds); }
#endif
    xcd_barrier(xbar);
#if !defined(ONLY) || ONLY==1
    REP(1) { if (rep_) xcd_barrier(xbar);
    { MKFRAME();
      const bool even = (F.G == 256);
      { pg8::Gemm g{(const pg8::bf16_t*)(ws + WS_HQ), (const pg8::bf16_t*)(ws + WS_WINQ), MTOK, 3072, DM / 2}; pg8::SplitOrder S; S.init3(MTOK, 3072, F.G, F.c, even ? 2 : (1 << 20), even ? 2 : 0, 128, 256);
        pg8::EpiStoreBf16 E{(pg8::bf16_t*)(ws + WS_PROJ), LDP};
        pg8::gemm_phase<pg8::EpiStoreBf16, pg8::SplitOrder, ALIGN_EPI, FP8_SP2, true, 0x7A7A7A7A>(lds, g, S, E); }
      { pg8::Gemm g{(const pg8::bf16_t*)(ws + WS_H), (const pg8::bf16_t*)(ws + WS_WIN) + (size_t)3072 * DM, MTOK, 3584, DM}; pg8::SplitOrder S; S.init3(MTOK, 3584, F.G, F.c, even ? 3 : (1 << 20), even ? 1 : 0, 0, 128);
        pg8::EpiStoreBf16 E{(pg8::bf16_t*)(ws + WS_PROJ) + 3072, LDP};
        pg8::gemm_phase<pg8::EpiStoreBf16, pg8::SplitOrder, ALIGN_EPI, SP2>(lds, g, S, E); } } }
#endif
    xcd_barrier(xbar);
#if !defined(ONLY) || ONLY==2
    REP(2) { if (rep_) { PROBE_SEAM(); } MKFRAME(); na_phase(F, lds); }
#endif
#if !defined(ONLY) || ONLY==3
    REP(3) { if (rep_) { PROBE_SEAM(); } MKFRAME(); scan_phase2(F, lds); }
#endif
    xcd_barrier(xbar);
#if !defined(ONLY) || ONLY==4
    REP(4) { if (rep_) { PROBE_SEAM(); } MKFRAME(); post_phase(F, lds); }
#endif
    xcd_barrier(xbar);
#if !defined(ONLY) || ONLY==5
    REP(5) { if (rep_) xcd_barrier(xbar);
    { MKFRAME(); pg8::Gemm g{(const pg8::bf16_t*)(ws + WS_MIX), (const pg8::bf16_t*)(ws + WS_WOUT), MTOK, DM, DM}; pg8::StaticOrder S; S.init(MTOK, DM, F.G, F.c);
      pg8::EpiResBf16 E{gptr(args.in[0]), (pg8::bf16_t*)(ws + WS_X2), DM};
      pg8::gemm_phase<pg8::EpiResBf16, pg8::StaticOrder, ALIGN_EPI, SP2>(lds, g, S, E); } }
#endif
    xcd_barrier(xbar);
#if !defined(ONLY) || ONLY==6
    REP(6) { if (rep_) xcd_barrier(xbar); MKFRAME(); norm2_router_phase(F, lds); }
#endif
    xcd_barrier(xbar);
#if !defined(ONLY) || ONLY==7
    REP(7) { if (rep_) xcd_barrier(xbar); MKFRAME(); topk_gather_phase(F, lds); }
#endif
    xcd_barrier(xbar);
#if !defined(ONLY) || ONLY==8
    REP(8) { if (rep_) xcd_barrier(xbar);
    { MKFRAME(); pg8::Gemm g{(const pg8::bf16_t*)(ws + WS_XE), (const pg8::bf16_t*)(ws + WS_WGU), MEXP, 4096, DM / 2}; pg8::MoeOrder S; S.init2(16, F.G, F.c);
      pg8::EpiSwiGLU E{(unsigned char*)(ws + WS_HID)};
      pg8::gemm_phase<pg8::EpiSwiGLU, pg8::MoeOrder, ALIGN_EPI, FP8_SP2, true, 0x7A7A7A7A>(lds, g, S, E); } }
#endif
    xcd_barrier(xbar);
#if !defined(ONLY) || ONLY==9
    REP(9) { if (rep_) xcd_barrier(xbar);
    { MKFRAME(); pg8::Gemm g{(const pg8::bf16_t*)(ws + WS_HID), (const pg8::bf16_t*)(ws + WS_WD), MEXP, 2048, FF / 2}; pg8::MoeOrder S; S.init2(8, F.G, F.c);
      pg8::EpiDownScale E{(pg8::bf16_t*)(ws + WS_XE), (const float*)(ws + WS_GATE)};
      pg8::gemm_phase<pg8::EpiDownScale, pg8::MoeOrder, ALIGN_EPI, FP8_SP2, true, 0x7A7A7A7A>(lds, g, S, E); } }
#endif
    xcd_barrier(xbar);
#ifdef PROBE_BARRIERS
    for (int pb_ = 0; pb_ < PROBE_BARRIERS; ++pb_) xcd_barrier(xbar);
#endif
#if !defined(ONLY) || ONLY==10
    { MKFRAME(); combine_phase(F); }
#endif
}

extern "C" void kernel_launch(void* const* d_in, const int* in_sizes, int n_in, void* d_out, int out_size, void* d_ws, size_t ws_size, hipStream_t stream) {
    static int grid = 0;
    if (grid == 0) {
        if (n_in != 24 || out_size != MTOK * DM || ws_size < WS_END) { fprintf(stderr, "kernel_launch: unexpected shapes (n_in %d, out %d, ws %zu)\n", n_in, out_size, ws_size); grid = -1; return; }
        int dev = 0, cus = 0, per_cu = 0;
        if (hipGetDevice(&dev) != hipSuccess || hipDeviceGetAttribute(&cus, hipDeviceAttributeMultiprocessorCount, dev) != hipSuccess) { grid = -1; return; }
        if (hipFuncSetAttribute((const void*)fwd_kernel, hipFuncAttributeMaxDynamicSharedMemorySize, LDS_BYTES) != hipSuccess) { fprintf(stderr, "kernel_launch: hipFuncSetAttribute failed\n"); grid = -1; return; }
        if (hipOccupancyMaxActiveBlocksPerMultiprocessor(&per_cu, (const void*)fwd_kernel, NTHR, LDS_BYTES) != hipSuccess || per_cu < 1) { fprintf(stderr, "kernel_launch: occupancy query failed (%d)\n", per_cu); (void)hipGetLastError(); per_cu = 1; }
        grid = cus * per_cu;
    }
    if (grid < 0) return;
    if (hipMemsetAsync((char*)d_ws + WS_CTL, 0, 65536, stream) != hipSuccess) { fprintf(stderr, "kernel_launch: memset failed\n"); return; }
    Args a{};
    for (int i = 0; i < 24; ++i) a.in[i] = (const float*)d_in[i];
    a.out = (float*)d_out; a.ws = (unsigned char*)d_ws;
    void* kargs[] = {&a};
    hipError_t e = hipLaunchCooperativeKernel((const void*)fwd_kernel, dim3(grid), dim3(NTHR), kargs, LDS_BYTES, stream);
    if (e != hipSuccess) fprintf(stderr, "kernel_launch: cooperative launch failed: %s (grid %d)\n", hipGetErrorString(e), grid);
}
```
